# Optimizing an MI355X kernel written in HIP

```python
import math
import numpy as np
import jax, jax.numpy as jnp
from jax import lax

D_MODEL = 4096
BATCH = 4
SEQ = 4096
DEPTH = 1

HEAD_DIM = 128
HEADS_PER_GROUP = 8
ATTN_GROUPS = ((128, 1), (512, 4), (2048, 16))
N_ATTN_GROUPS = len(ATTN_GROUPS)
N_ATTN_HEADS = HEADS_PER_GROUP * N_ATTN_GROUPS
GROUP_WIDTH = HEADS_PER_GROUP * HEAD_DIM
ATTN_OUT_WIDTH = GROUP_WIDTH
POOL_WINDOWS = (2, 4, 8, 16)
N_POOL_GROUPS = len(POOL_WINDOWS)
POOL_GROUP_WIDTH = 256
POOL_WIDTH = POOL_GROUP_WIDTH * N_POOL_GROUPS
D_FF = 11008
IN_WIDTH = 3 * GROUP_WIDTH * N_ATTN_GROUPS + POOL_WIDTH + 2 * D_MODEL
RMS_EPS = 1e-6
NEG_INF = -1e30

kernel_name = "hybrid_dilated_attn_pool_macaron_block"


def rms_norm(x, gain):
    x32 = x.astype(jnp.float32)
    y = x32 * lax.rsqrt(jnp.mean(x32 * x32, axis=-1, keepdims=True) + RMS_EPS)
    return (y * gain.astype(jnp.float32)).astype(x.dtype)


def swiglu(x, w_gate, w_up, w_down):
    g = jnp.einsum('bsd,df->bsf', x, w_gate)
    u = jnp.einsum('bsd,df->bsf', x, w_up)
    return jnp.einsum('bsf,fd->bsd', jax.nn.silu(g) * u, w_down)


def alibi_slopes(n):
    def pow2_slopes(k):
        start = 2.0 ** (-8.0 / k)
        return [start ** (i + 1) for i in range(k)]
    if math.log2(n).is_integer():
        s = pow2_slopes(n)
    else:
        c = 2 ** math.floor(math.log2(n))
        s = pow2_slopes(c) + pow2_slopes(2 * c)[0::2][: n - c]
    s = np.asarray(s, dtype=np.float32)
    return -np.sort(-s)


def dilated_window_attention(q, k, v, slopes, window, dilation):
    b, s, h, e = q.shape
    d = dilation
    blk = window // d
    n_sub = s // d
    nb = -(-n_sub // blk)
    lp = nb * blk

    def to_sub(t):
        t = t.reshape(b, n_sub, d, h, e).transpose(0, 2, 3, 1, 4)
        t = jnp.pad(t, ((0, 0), (0, 0), (0, 0), (0, lp - n_sub), (0, 0)))
        return t.reshape(b, d, h, nb, blk, e).astype(jnp.float32)

    qb, kb, vb = to_sub(q), to_sub(k), to_sub(v)

    def with_prev(t):
        prev = jnp.pad(t[:, :, :, :-1], ((0, 0), (0, 0), (0, 0), (1, 0), (0, 0), (0, 0)))
        return jnp.concatenate([prev, t], axis=4)

    kc, vc = with_prev(kb), with_prev(vb)
    scores = jnp.einsum('brhnqe,brhnke->brhnqk', qb, kc) * (e ** -0.5)
    qi = jnp.arange(blk)[:, None]
    kk = jnp.arange(2 * blk)[None, :]
    steps = blk + qi - kk
    in_band = (steps >= 0) & (steps <= blk)
    key_idx = jnp.arange(nb)[:, None, None] * blk - blk + kk[None]
    valid = in_band[None] & (key_idx >= 0)
    dist = (steps * d).astype(jnp.float32)
    scores = scores - slopes.astype(jnp.float32)[None, None, :, None, None, None] * dist
    scores = jnp.where(valid[None, None, None], scores, NEG_INF)
    m = jnp.max(scores, axis=-1, keepdims=True)
    p = jnp.exp(scores - m)
    denom = jnp.sum(p, axis=-1, keepdims=True)
    out = jnp.einsum('brhnqk,brhnke->brhnqe', p, vc) / denom
    lse = (m + jnp.log(denom))[..., 0]
    out = out.reshape(b, d, h, lp, e)[:, :, :, :n_sub].transpose(0, 3, 1, 2, 4).reshape(b, s, h, e)
    lse = lse.reshape(b, d, h, lp)[:, :, :, :n_sub].transpose(0, 3, 1, 2).reshape(b, s, h)
    return out, lse


def multiscale_causal_pool(z, pool_w, pool_scale):
    b, s, _ = z.shape
    zg = z.reshape(b, s, N_POOL_GROUPS, POOL_GROUP_WIDTH).astype(jnp.float32)
    csum = jnp.pad(jnp.cumsum(zg, axis=1), ((0, 0), (1, 0), (0, 0), (0, 0)))
    t = jnp.arange(s)
    means = []
    for g, p in enumerate(POOL_WINDOWS):
        c = csum[:, :, g]
        lower = jnp.pad(c, ((0, 0), (p - 1, 0), (0, 0)))[:, :s]
        count = jnp.minimum(t + 1, p).astype(jnp.float32)[None, :, None]
        means.append((c[:, 1:] - lower) / count)
    mean = jnp.stack(means, axis=2)
    delta = (mean - zg).astype(z.dtype)
    y = jnp.einsum('bsgc,gcd->bsgd', delta, pool_w).reshape(b, s, POOL_WIDTH)
    return y * pool_scale


def hybrid_mixer(u, w_in, pool_w, pool_scale, w_attn_branch, w_pool_branch, w_out):
    b, s, _ = u.shape
    proj = jnp.einsum('bsd,df->bsf', u, w_in)
    slopes = jnp.asarray(alibi_slopes(N_ATTN_HEADS))
    outs, lses = [], []
    off = 0
    for g, (window, dilation) in enumerate(ATTN_GROUPS):
        q = proj[..., off:off + GROUP_WIDTH].reshape(b, s, HEADS_PER_GROUP, HEAD_DIM)
        k = proj[..., off + GROUP_WIDTH:off + 2 * GROUP_WIDTH].reshape(b, s, HEADS_PER_GROUP, HEAD_DIM)
        v = proj[..., off + 2 * GROUP_WIDTH:off + 3 * GROUP_WIDTH].reshape(b, s, HEADS_PER_GROUP, HEAD_DIM)
        off += 3 * GROUP_WIDTH
        o, l = dilated_window_attention(q, k, v, slopes[g * HEADS_PER_GROUP:(g + 1) * HEADS_PER_GROUP], window, dilation)
        outs.append(o)
        lses.append(l)
    wts = jax.nn.softmax(jnp.stack(lses, axis=0), axis=0)
    attn = jnp.einsum('gbsh,gbshe->bshe', wts, jnp.stack(outs, axis=0))
    attn = attn.reshape(b, s, ATTN_OUT_WIDTH).astype(u.dtype)

    pool_in = proj[..., off:off + POOL_WIDTH]
    off += POOL_WIDTH
    gate_attn = jax.nn.sigmoid(proj[..., off:off + D_MODEL])
    off += D_MODEL
    gate_pool = jax.nn.sigmoid(proj[..., off:off + D_MODEL])

    pooled = multiscale_causal_pool(pool_in, pool_w, pool_scale)
    branch_a = jnp.einsum('bsc,cd->bsd', attn, w_attn_branch)
    branch_p = jnp.einsum('bsc,cd->bsd', pooled, w_pool_branch)
    merged = gate_attn * branch_a + gate_pool * branch_p
    return jnp.einsum('bsd,de->bse', merged, w_out)


def setup_inputs(seed: int = 0) -> dict:
    key = jax.random.key(seed)
    ks = jax.random.split(key, 24)
    L = DEPTH

    def w(k, shape, fan_in):
        return jax.random.normal(k, shape, jnp.float32) * (fan_in ** -0.5)

    def gain(k, shape):
        return 1.0 + 0.05 * jax.random.normal(k, shape, jnp.float32)

    return {
        "x": jax.random.normal(ks[0], (BATCH, SEQ, D_MODEL), jnp.float32),
        "ffn1_norm_pre": gain(ks[1], (L, D_MODEL)),
        "ffn1_norm_post": gain(ks[2], (L, D_MODEL)),
        "ffn1_w_gate": w(ks[3], (L, D_MODEL, D_FF), D_MODEL),
        "ffn1_w_up": w(ks[4], (L, D_MODEL, D_FF), D_MODEL),
        "ffn1_w_down": w(ks[5], (L, D_FF, D_MODEL), D_FF),
        "mix_norm_pre": gain(ks[6], (L, D_MODEL)),
        "mix_norm_post": gain(ks[7], (L, D_MODEL)),
        "w_in": w(ks[8], (L, D_MODEL, IN_WIDTH), D_MODEL),
        "pool_w": w(ks[9], (L, N_POOL_GROUPS, POOL_GROUP_WIDTH, POOL_GROUP_WIDTH), POOL_GROUP_WIDTH),
        "pool_scale": gain(ks[10], (L, POOL_WIDTH)),
        "w_attn_branch": w(ks[11], (L, ATTN_OUT_WIDTH, D_MODEL), ATTN_OUT_WIDTH),
        "w_pool_branch": w(ks[12], (L, POOL_WIDTH, D_MODEL), POOL_WIDTH),
        "w_out": w(ks[13], (L, D_MODEL, D_MODEL), D_MODEL),
        "ffn2_norm_pre": gain(ks[14], (L, D_MODEL)),
        "ffn2_norm_post": gain(ks[15], (L, D_MODEL)),
        "ffn2_w_gate": w(ks[16], (L, D_MODEL, D_FF), D_MODEL),
        "ffn2_w_up": w(ks[17], (L, D_MODEL, D_FF), D_MODEL),
        "ffn2_w_down": w(ks[18], (L, D_FF, D_MODEL), D_FF),
    }


def reference(x, ffn1_norm_pre, ffn1_norm_post, ffn1_w_gate, ffn1_w_up, ffn1_w_down,
              mix_norm_pre, mix_norm_post, w_in, pool_w, pool_scale, w_attn_branch,
              w_pool_branch, w_out, ffn2_norm_pre, ffn2_norm_post, ffn2_w_gate,
              ffn2_w_up, ffn2_w_down):
    h = x
    for layer in range(DEPTH):
        f = swiglu(rms_norm(h, ffn1_norm_pre[layer]), ffn1_w_gate[layer], ffn1_w_up[layer], ffn1_w_down[layer])
        h = h + 0.5 * rms_norm(f, ffn1_norm_post[layer])
        m = hybrid_mixer(rms_norm(h, mix_norm_pre[layer]), w_in[layer], pool_w[layer], pool_scale[layer],
                         w_attn_branch[layer], w_pool_branch[layer], w_out[layer])
        h = h + rms_norm(m, mix_norm_post[layer])
        f = swiglu(rms_norm(h, ffn2_norm_pre[layer]), ffn2_w_gate[layer], ffn2_w_up[layer], ffn2_w_down[layer])
        h = h + 0.5 * rms_norm(f, ffn2_norm_post[layer])
    return h
```

```cpp
#include <hip/hip_runtime.h>
#include <cstdio>
#include <cstdint>

#ifndef MK_ONE_LAUNCH
#define MK_ONE_LAUNCH 1
#endif

#define LAS __attribute__((address_space(3)))
#define GAS __attribute__((address_space(1)))
typedef unsigned short bf16_t;
typedef short bf16x8 __attribute__((ext_vector_type(8)));
typedef float f32x4 __attribute__((ext_vector_type(4)));
typedef float f32x2 __attribute__((ext_vector_type(2)));
typedef unsigned u32x4 __attribute__((ext_vector_type(4)));
typedef unsigned u32x2 __attribute__((ext_vector_type(2)));

constexpr int BATCH = 4, SEQ = 4096, M = BATCH * SEQ, D = 4096, FF = 11008, NIN = 18432;
constexpr int POOL_OFF = 9216, GA_OFF = 10240, GP_OFF = 14336;
constexpr float RMS_EPS = 1e-6f;
constexpr int NWAVES = 8, NTHREADS = 512;

constexpr size_t MiB = (size_t)1 << 20;
constexpr size_t WS_CTL = 0, CTL_ZERO_BYTES = 1 * MiB;
constexpr size_t WS_WGU1 = 1 * MiB;
constexpr size_t WS_WD1 = 173 * MiB;
constexpr size_t WS_WIN = 259 * MiB;
constexpr size_t WS_WOUT = 403 * MiB;
constexpr size_t WS_WBA = 435 * MiB;
constexpr size_t WS_WBP = 443 * MiB;
constexpr size_t WS_WPL = 451 * MiB;
constexpr size_t WS_WGU2 = 452 * MiB;
constexpr size_t WS_WD2 = 624 * MiB;
constexpr size_t WS_XN = 710 * MiB;
constexpr size_t WS_ACT = 838 * MiB;
constexpr size_t WS_F = 1182 * MiB;
constexpr size_t WS_PROJ = 838 * MiB;
constexpr size_t WS_ATTN = 1438 * MiB;
constexpr size_t WS_DELTA = 1470 * MiB;
constexpr size_t WS_POOLED = 1502 * MiB;
constexpr size_t WS_T1 = 1534 * MiB;
constexpr size_t WS_OUTG = WS_XN;
constexpr size_t WS_LSE = WS_XN + 96 * MiB;
constexpr size_t WS_END = 1598 * MiB;
static_assert(WS_PROJ + (size_t)M * NIN * 2 <= WS_ATTN, "proj overlay");
constexpr int CW_BAR = 4096;

__device__ __forceinline__ unsigned cvt_pk_bf16(float lo, float hi) { unsigned r; asm volatile("v_cvt_pk_bf16_f32 %0, %1, %2" : "=v"(r) : "v"(lo), "v"(hi)); return r; }
__device__ __forceinline__ float bf_lo(unsigned w) { return __uint_as_float(w << 16); }
__device__ __forceinline__ float bf_hi(unsigned w) { return __uint_as_float(w & 0xffff0000u); }
__device__ __forceinline__ float wave_sum(float v) {
#pragma unroll
    for (int o = 1; o < 64; o <<= 1) v += __shfl_xor(v, o);
    return v;
}
__device__ __forceinline__ float fast_sigmoid(float x) { return __builtin_amdgcn_rcpf(1.0f + __builtin_amdgcn_exp2f(-1.4426950408889634f * x)); }

#define XB_TMO      128
#define XB_XCNT(j)  (256  + 64 * (j))
#define XB_XSUB(j)  (1280 + 64 * (j))
#define XB_XGEN(j)  (2304 + 64 * (j))
#define XB_TOP      3328
#define XB_TOPGEN   3392
#define XCD_BAR_WORDS 3456
#define XB_SPIN_CAP (1u << 18)

__device__ __forceinline__ unsigned xb_ld(unsigned* p)              { return __hip_atomic_load(p, __ATOMIC_RELAXED, __HIP_MEMORY_SCOPE_AGENT); }
__device__ __forceinline__ unsigned xb_add(unsigned* p, unsigned v) { return __hip_atomic_fetch_add(p, v, __ATOMIC_RELAXED, __HIP_MEMORY_SCOPE_AGENT); }
__device__ __forceinline__ unsigned xb_xcc_id() { return (unsigned)__builtin_amdgcn_s_getreg((3 << 11) | 20) & 0xFu; }
#define XB_SPIN(cond, bar) do { unsigned _sp = 0; while (cond) { __builtin_amdgcn_s_sleep(1); \
    if ((++_sp & 255u) == 0u) { if (xb_ld(&(bar)[XB_TMO])) break; if (_sp > XB_SPIN_CAP) { atomicAdd(&(bar)[XB_TMO], 1u); break; } } } } while (0)

struct XcdBarrier { unsigned* bar; unsigned x; volatile LAS unsigned* st; };

__device__ __forceinline__ XcdBarrier xcd_barrier_post(unsigned* bar, volatile LAS unsigned* st) {
    XcdBarrier b; b.bar = bar; b.x = xb_xcc_id(); b.st = st;
    if (threadIdx.x == 0) (void)xb_add(&bar[XB_XCNT(b.x)], 1u);
    return b;
}
__device__ __forceinline__ void xcd_barrier_complete(unsigned* bar, unsigned x, unsigned& nloc, unsigned& nx) {
    const unsigned G = gridDim.x * gridDim.y * gridDim.z;
    unsigned sum, cnt, mine, sp = 0u;
    for (;;) {
        sum = 0u; cnt = 0u; mine = 0u;
#pragma unroll
        for (unsigned j = 0; j < 16; ++j) { const unsigned c = xb_ld(&bar[XB_XCNT(j)]); sum += c; cnt += (c > 0u) ? 1u : 0u; mine = (j == x) ? c : mine; }
        if (sum == G) break;
        __builtin_amdgcn_s_sleep(1);
        if ((++sp & 255u) == 0u) { if (xb_ld(&bar[XB_TMO])) break; if (sp > XB_SPIN_CAP) { atomicAdd(&bar[XB_TMO], 1u); break; } }
    }
    nloc = mine > 0u ? mine : 1u; nx = cnt > 0u ? cnt : 1u;
}
__device__ __forceinline__ void xcd_barrier(const XcdBarrier& b) {
    asm volatile("s_waitcnt vmcnt(0)" ::: "memory");
    __syncthreads();
    if (threadIdx.x == 0) {
        unsigned* bar = b.bar;
        __builtin_amdgcn_s_waitcnt(0);
        unsigned nloc = b.st[0], nx = b.st[1];
        if (nloc == 0u) { xcd_barrier_complete(bar, b.x, nloc, nx); b.st[0] = nloc; b.st[1] = nx; }
        const unsigned old = xb_add(&bar[XB_XSUB(b.x)], 1u);
        const unsigned gen = old / nloc;
        if (old + 1u == (gen + 1u) * nloc) {
            __builtin_amdgcn_fence(__ATOMIC_RELEASE, "agent");
            asm volatile("s_waitcnt vmcnt(0)" ::: "memory");
            const unsigned og = xb_add(&bar[XB_TOP], 1u);
            const unsigned tg = og / nx;
            if (og + 1u == (tg + 1u) * nx) xb_add(&bar[XB_TOPGEN], 1u);
            else XB_SPIN(xb_ld(&bar[XB_TOPGEN]) == tg, bar);
            __builtin_amdgcn_fence(__ATOMIC_ACQUIRE, "agent");
            xb_add(&bar[XB_XGEN(b.x)], 1u);
            asm volatile("s_waitcnt vmcnt(0)" ::: "memory");
        } else {
            XB_SPIN(xb_ld(&bar[XB_XGEN(b.x)]) == gen, bar);
            __builtin_amdgcn_fence(__ATOMIC_ACQUIRE, "agent");
            asm volatile("s_waitcnt vmcnt(0)" ::: "memory");
        }
    }
    __syncthreads();
}

namespace pg8 {
constexpr int BM = 256, BK = 64, HALF = 128, HTB = HALF * BK * 2, STAGE_BYTES = 8 * HTB, NXCD = 8, WGM = 8;
__host__ __device__ __forceinline__ int lds_byte(int r, int c) { const int st = (r >> 4) * 2 + (c >> 5), rr = r & 15, cc = c & 31, ob = rr * 64 + cc * 2; return st * 1024 + (ob ^ (((ob >> 9) & 1) << 5)); }
__host__ __device__ __forceinline__ void stage_rc(int b, int& R, int& C) { const int st = b / 1024, sb = b % 1024, swz = sb ^ (((sb >> 9) & 1) << 5); R = (st >> 1) * 16 + swz / 64; C = (st & 1) * 32 + (swz % 64) / 2; }
__host__ __device__ __forceinline__ int perm32(int rho) { const int n = rho >> 4, i = rho & 15; return 8 * (i >> 2) + 4 * n + (i & 3); }

struct Unit { int pm, pn, sub; };
struct TileOrder {
    int nM, nN, nwg, G, c, wgm;
    __device__ __forceinline__ void init(int Mr, int Nc, int G_, int c_, int wgm_ = WGM) { nM = Mr / BM; nN = Nc / BM; nwg = nM * nN; G = G_; c = c_; wgm = wgm_; }
    __device__ __forceinline__ bool at(long L, int& pm, int& pn) const {
        if (L >= nwg) return false;
        int wgid = (int)L; { const int q = nwg / NXCD, r = nwg % NXCD, xcd = wgid % NXCD, off = wgid / NXCD; wgid = (xcd < r ? xcd * (q + 1) : r * (q + 1) + (xcd - r) * q) + off; }
        const int nig = wgm * nN, gid = wgid / nig, fm = gid * wgm, gsz = (nM - fm) < wgm ? (nM - fm) : wgm;
        pm = fm + ((wgid % nig) % gsz); pn = (wgid % nig) / gsz; return true;
    }
};
struct PlainSched {
    TileOrder T; const char* A; const char* B; size_t tstep;
    __device__ __forceinline__ bool next(int i, Unit& u) const { u.sub = 0; return T.at((long)i * T.G + T.c, u.pm, u.pn); }
    __device__ __forceinline__ const char* aptr(const Unit& u) const { return A + (size_t)u.pm * tstep; }
    __device__ __forceinline__ const char* bptr(const Unit& u) const { return B + (size_t)u.pn * tstep; }
};
struct BranchSched {
    TileOrder T; const char* A0; const char* B0; const char* A1; const char* B1; size_t tstep;
    __device__ __forceinline__ bool next(int i, Unit& u) const { u.sub = i & 1; return T.at((long)(i >> 1) * T.G + T.c, u.pm, u.pn); }
    __device__ __forceinline__ const char* aptr(const Unit& u) const { return (u.sub ? A1 : A0) + (size_t)u.pm * tstep; }
    __device__ __forceinline__ const char* bptr(const Unit& u) const { return (u.sub ? B1 : B0) + (size_t)u.pn * tstep; }
};
struct PoolSched {
    TileOrder T; const char* A; const char* B; size_t tstep, gstride;
    __device__ __forceinline__ bool next(int i, Unit& u) const { u.sub = 0; return T.at((long)i * T.G + T.c, u.pm, u.pn); }
    __device__ __forceinline__ const char* aptr(const Unit& u) const { return A + (size_t)u.pn * gstride + (size_t)u.pm * tstep; }
    __device__ __forceinline__ const char* bptr(const Unit& u) const { return B + (size_t)u.pn * tstep; }
};

struct EpiSwiGLU {
    static constexpr bool PERM = true;
    bf16_t* O; int ldc;
    __device__ __forceinline__ void operator()(const f32x4 (&acc)[2][2][4][2], const Unit& u, int wr, int wc, int fr, int fq) const {
        const int row0 = u.pm * BM + wr * 64 + fr, col0 = u.pn * HALF + wc * 32 + 8 * fq;
#pragma unroll
        for (int ai = 0; ai < 2; ++ai)
#pragma unroll
            for (int m = 0; m < 4; ++m) { bf16_t* rowp = O + (size_t)(row0 + ai * HALF + m * 16) * ldc + col0;
                float o[8];
#pragma unroll
                for (int n = 0; n < 2; ++n)
#pragma unroll
                    for (int j = 0; j < 4; ++j) { const float g = acc[ai][0][m][n][j], uu = acc[ai][1][m][n][j]; o[n * 4 + j] = g * fast_sigmoid(g) * uu; }
                u32x4 w; w.x = cvt_pk_bf16(o[0], o[1]); w.y = cvt_pk_bf16(o[2], o[3]); w.z = cvt_pk_bf16(o[4], o[5]); w.w = cvt_pk_bf16(o[6], o[7]);
                *(u32x4*)rowp = w; }
    }
};
struct EpiBf16 {
    static constexpr bool PERM = true;
    bf16_t* O; int ldc;
    __device__ __forceinline__ void operator()(const f32x4 (&acc)[2][2][4][2], const Unit& u, int wr, int wc, int fr, int fq) const {
        const int row0 = u.pm * BM + wr * 64 + fr, col0 = u.pn * BM + wc * 32 + 8 * fq;
#pragma unroll
        for (int ai = 0; ai < 2; ++ai)
#pragma unroll
            for (int m = 0; m < 4; ++m) { bf16_t* rowp = O + (size_t)(row0 + ai * HALF + m * 16) * ldc + col0;
#pragma unroll
                for (int bj = 0; bj < 2; ++bj) { const f32x4 v0 = acc[ai][bj][m][0], v1 = acc[ai][bj][m][1];
                    u32x4 w; w.x = cvt_pk_bf16(v0[0], v0[1]); w.y = cvt_pk_bf16(v0[2], v0[3]); w.z = cvt_pk_bf16(v1[0], v1[1]); w.w = cvt_pk_bf16(v1[2], v1[3]);
                    *(u32x4*)(rowp + bj * HALF) = w; } }
    }
};
struct EpiBf16Sig {
    static constexpr bool PERM = true;
    bf16_t* O; int ldc; int sig_from;
    __device__ __forceinline__ void operator()(const f32x4 (&acc)[2][2][4][2], const Unit& u, int wr, int wc, int fr, int fq) const {
        const int row0 = u.pm * BM + wr * 64 + fr, col0 = u.pn * BM + wc * 32 + 8 * fq; const bool sg = u.pn >= sig_from;
#pragma unroll
        for (int ai = 0; ai < 2; ++ai)
#pragma unroll
            for (int m = 0; m < 4; ++m) { bf16_t* rowp = O + (size_t)(row0 + ai * HALF + m * 16) * ldc + col0;
#pragma unroll
                for (int bj = 0; bj < 2; ++bj) { f32x4 v0 = acc[ai][bj][m][0], v1 = acc[ai][bj][m][1];
                    if (sg) {
#pragma unroll
                        for (int j = 0; j < 4; ++j) { v0[j] = fast_sigmoid(v0[j]); v1[j] = fast_sigmoid(v1[j]); } }
                    u32x4 w; w.x = cvt_pk_bf16(v0[0], v0[1]); w.y = cvt_pk_bf16(v0[2], v0[3]); w.z = cvt_pk_bf16(v1[0], v1[1]); w.w = cvt_pk_bf16(v1[2], v1[3]);
                    *(u32x4*)(rowp + bj * HALF) = w; } }
    }
};
struct EpiPool {
    static constexpr bool PERM = true;
    bf16_t* O; int ldc; const float* scale;
    __device__ __forceinline__ void operator()(const f32x4 (&acc)[2][2][4][2], const Unit& u, int, int, int, int) const {
        int tz = threadIdx.x; asm volatile("" : "+v"(tz));
        const int wid = tz >> 6, lane = tz & 63, wr = wid >> 2, wc = wid & 3, fr = lane & 15, fq = lane >> 4;
        const int row0 = u.pm * BM + wr * 64 + fr, col0 = u.pn * BM + wc * 32 + 8 * fq;
#pragma unroll
        for (int bj = 0; bj < 2; ++bj) { const f32x4 sv0 = *(const f32x4*)(scale + col0 + bj * HALF), sv1 = *(const f32x4*)(scale + col0 + bj * HALF + 4);
#pragma unroll
            for (int ai = 0; ai < 2; ++ai)
#pragma unroll
                for (int m = 0; m < 4; ++m) { bf16_t* rowp = O + (size_t)(row0 + ai * HALF + m * 16) * ldc + col0;
                    const f32x4 v0 = acc[ai][bj][m][0] * sv0, v1 = acc[ai][bj][m][1] * sv1;
                    u32x4 w; w.x = cvt_pk_bf16(v0[0], v0[1]); w.y = cvt_pk_bf16(v0[2], v0[3]); w.z = cvt_pk_bf16(v1[0], v1[1]); w.w = cvt_pk_bf16(v1[2], v1[3]);
                    *(u32x4*)(rowp + bj * HALF) = w; } }
    }
};
struct EpiBranch {
    static constexpr bool PERM = true;
    bf16_t* O; int ldc; const bf16_t* proj; f32x4* t1wg;
    __device__ __forceinline__ void operator()(const f32x4 (&acc)[2][2][4][2], const Unit& u, int, int, int, int) const {
        int tz = threadIdx.x; asm volatile("" : "+v"(tz));
        const int wid = tz >> 6, lane = tz & 63, wr = wid >> 2, wc = wid & 3, fr = lane & 15, fq = lane >> 4;
        const int row0 = u.pm * BM + wr * 64 + fr, col0 = u.pn * BM + wc * 32 + 8 * fq;
        f32x4* const t1 = t1wg + tz;
        if (u.sub == 0) {
#pragma unroll
            for (int ai = 0; ai < 2; ++ai)
#pragma unroll
                for (int m = 0; m < 4; ++m) { const size_t row = (size_t)(row0 + ai * HALF + m * 16);
#pragma unroll
                    for (int bj = 0; bj < 2; ++bj) {
                        const u32x4 gw = *(const u32x4*)(proj + row * NIN + GA_OFF + col0 + bj * HALF);
                        f32x4 g0, g1; g0[0] = bf_lo(gw.x); g0[1] = bf_hi(gw.x); g0[2] = bf_lo(gw.y); g0[3] = bf_hi(gw.y); g1[0] = bf_lo(gw.z); g1[1] = bf_hi(gw.z); g1[2] = bf_lo(gw.w); g1[3] = bf_hi(gw.w);
                        f32x4* sp = t1 + (size_t)(((ai * 4 + m) * 2 + bj) * 2) * NTHREADS;
                        sp[0] = acc[ai][bj][m][0] * g0; sp[NTHREADS] = acc[ai][bj][m][1] * g1; }
                    asm volatile("" ::: "memory"); }
        } else {
#pragma unroll
            for (int ai = 0; ai < 2; ++ai)
#pragma unroll
                for (int m = 0; m < 4; ++m) { const size_t row = (size_t)(row0 + ai * HALF + m * 16);
#pragma unroll
                    for (int bj = 0; bj < 2; ++bj) {
                        const u32x4 gw = *(const u32x4*)(proj + row * NIN + GP_OFF + col0 + bj * HALF);
                        f32x4 g0, g1; g0[0] = bf_lo(gw.x); g0[1] = bf_hi(gw.x); g0[2] = bf_lo(gw.y); g0[3] = bf_hi(gw.y); g1[0] = bf_lo(gw.z); g1[1] = bf_hi(gw.z); g1[2] = bf_lo(gw.w); g1[3] = bf_hi(gw.w);
                        const f32x4* sp = t1 + (size_t)(((ai * 4 + m) * 2 + bj) * 2) * NTHREADS;
                        const f32x4 v0 = acc[ai][bj][m][0] * g0 + sp[0], v1 = acc[ai][bj][m][1] * g1 + sp[NTHREADS];
                        u32x4 w; w.x = cvt_pk_bf16(v0[0], v0[1]); w.y = cvt_pk_bf16(v0[2], v0[3]); w.z = cvt_pk_bf16(v1[0], v1[1]); w.w = cvt_pk_bf16(v1[2], v1[3]);
                        *(u32x4*)(O + row * ldc + col0 + bj * HALF) = w; }
                    asm volatile("" ::: "memory"); }
        }
    }
};

template <class Epi, class Sched, bool ALIGN_EPI, bool SP2>
__device__ __forceinline__ void gemm_phase(LAS unsigned char* lds, const int K, const Sched& S, const Epi& E) {
    int tid = threadIdx.x; asm volatile("" : "+v"(tid));
    const int wid = __builtin_amdgcn_readfirstlane(tid >> 6), lane = tid & 63, wr = wid >> 2, wc = wid & 3, fr = lane & 15, fq = lane >> 4;
    const int nt = K / BK;
    unsigned voffA[2], voffB[2];
#pragma unroll
    for (int i = 0; i < 2; ++i) { int R, C; stage_rc(tid * 16 + i * 8192, R, C);
        voffA[i] = (unsigned)(R * K + C) * 2u; voffB[i] = (unsigned)(tid * 16 + i * 8192); }
    const size_t kstep = (size_t)(BK * 2), kstepB = (size_t)HTB;
    const size_t hstep = (size_t)HALF * K * 2;
    const unsigned ldsw = (unsigned)wid * 1024u;
    const int aoff = lds_byte(wr * 64 + fr, fq * 8), boff = lds_byte(wc * 32 + fr, fq * 8);
#define PG8_SA(b, h) (((b) * 2 + (h)) * HTB)
#define PG8_SB(b, h) ((4 + (b) * 2 + (h)) * HTB)
#define PG8_STAGE(bufoff, gbase, voff) do { _Pragma("unroll") for (int _i = 0; _i < 2; ++_i) \
        __builtin_amdgcn_global_load_lds((const unsigned*)((const char*)(gbase) + (voff)[_i]), (LAS unsigned*)(lds + (bufoff) + ldsw + _i * 8192), 16, 0, 0); } while (0)
#define PG8_LDA(dst, b, h) do { _Pragma("unroll") for (int m = 0; m < 4; ++m) _Pragma("unroll") for (int k = 0; k < 2; ++k) dst[m][k] = *(const LAS bf16x8*)(lds + PG8_SA(b, h) + aoff + m * 2048 + k * 1024); } while (0)
#define PG8_LDB(dst, b, h) do { _Pragma("unroll") for (int n = 0; n < 2; ++n) _Pragma("unroll") for (int k = 0; k < 2; ++k) dst[n][k] = *(const LAS bf16x8*)(lds + PG8_SB(b, h) + boff + n * 2048 + k * 1024); } while (0)
#define PG8_MMA(ai, bj, At, Bt) do { __builtin_amdgcn_s_setprio(1); _Pragma("unroll") for (int m = 0; m < 4; ++m) _Pragma("unroll") for (int n = 0; n < 2; ++n) _Pragma("unroll") for (int k = 0; k < 2; ++k) \
        acc[ai][bj][m][n] = __builtin_amdgcn_mfma_f32_16x16x32_bf16(Bt[n][k], At[m][k], acc[ai][bj][m][n], 0, 0, 0); __builtin_amdgcn_s_setprio(0); } while (0)
#define PG8_WAIT_V(n) asm volatile("s_waitcnt vmcnt(" #n ")" ::: "memory")
#define PG8_WAIT_L(n) asm volatile("s_waitcnt lgkmcnt(" #n ")" ::: "memory")
#define PG8_BAR __builtin_amdgcn_s_barrier()
#define PG8_SCHED __builtin_amdgcn_sched_barrier(0)
    Unit cur, nxt; int ui = 0;
    if (!S.next(0, cur)) return;
    f32x4 acc[2][2][4][2];
#pragma unroll
    for (int a = 0; a < 2; ++a)
#pragma unroll
        for (int b = 0; b < 2; ++b)
#pragma unroll
            for (int m = 0; m < 4; ++m)
#pragma unroll
                for (int n = 0; n < 2; ++n) acc[a][b][m][n] = (f32x4){0.f, 0.f, 0.f, 0.f};
    bf16x8 At[4][2], B0[2][2], B1[2][2];
    const char* cA = S.aptr(cur); const char* cB = S.bptr(cur);
    if constexpr (SP2) {
        PG8_STAGE(PG8_SB(0, 0), cB, voffB); PG8_STAGE(PG8_SB(0, 1), cB + hstep, voffB); PG8_STAGE(PG8_SA(0, 0), cA, voffA); PG8_STAGE(PG8_SA(0, 1), cA + hstep, voffA);
        if (wr == 1) PG8_BAR;
        PG8_WAIT_V(2); PG8_BAR;
        PG8_STAGE(PG8_SB(1, 0), cB + kstepB, voffB); PG8_STAGE(PG8_SA(1, 0), cA + kstep, voffA); PG8_STAGE(PG8_SB(1, 1), cB + hstep + kstepB, voffB);
        PG8_WAIT_V(6); PG8_BAR;
    } else {
        PG8_STAGE(PG8_SB(0, 0), cB, voffB); PG8_STAGE(PG8_SA(0, 0), cA, voffA); PG8_STAGE(PG8_SB(0, 1), cB + hstep, voffB); PG8_STAGE(PG8_SA(0, 1), cA + hstep, voffA);
        if (wr == 1) PG8_BAR;
        PG8_WAIT_V(4); PG8_BAR;
        PG8_STAGE(PG8_SB(1, 0), cB + kstepB, voffB); PG8_STAGE(PG8_SA(1, 0), cA + kstep, voffA); PG8_STAGE(PG8_SB(1, 1), cB + hstep + kstepB, voffB);
        PG8_WAIT_V(6); PG8_BAR;
    }
    for (;;) {
        const bool has_next = S.next(ui + 1, nxt);
        const char* nA = has_next ? S.aptr(nxt) : cA; const char* nB = has_next ? S.bptr(nxt) : cB;
#pragma unroll 1
        for (int t = 0; t < nt; t += 2) {
            const bool last = (t == nt - 2);
            const char* a1 = cA + (size_t)(t + 1) * kstep;
            const char* a2 = last ? nA : cA + (size_t)(t + 2) * kstep; const char* b2 = last ? nB : cB + (size_t)(t + 2) * kstepB;
            const char* a3 = a2 + kstep; const char* b3 = b2 + kstepB;
            if constexpr (SP2) {
            PG8_LDB(B0, 0, 0); PG8_LDB(B1, 0, 1); PG8_SCHED; PG8_LDA(At, 0, 0); PG8_STAGE(PG8_SA(1, 1), a1 + hstep, voffA);
            PG8_WAIT_V(8); PG8_WAIT_L(0); PG8_BAR; PG8_MMA(0, 0, At, B0); PG8_MMA(0, 1, At, B1); PG8_BAR; PG8_SCHED;
            PG8_LDA(At, 0, 1); PG8_STAGE(PG8_SB(0, 0), b2, voffB); PG8_STAGE(PG8_SB(0, 1), b2 + hstep, voffB); PG8_STAGE(PG8_SA(0, 0), a2, voffA);
            PG8_WAIT_V(8); PG8_WAIT_L(0); PG8_BAR; PG8_MMA(1, 0, At, B0); PG8_MMA(1, 1, At, B1); PG8_BAR; PG8_SCHED;
            PG8_LDB(B0, 1, 0); PG8_LDB(B1, 1, 1); PG8_SCHED; PG8_LDA(At, 1, 0); PG8_STAGE(PG8_SA(0, 1), a2 + hstep, voffA);
            PG8_WAIT_V(8); PG8_WAIT_L(0); PG8_BAR; PG8_MMA(0, 0, At, B0); PG8_MMA(0, 1, At, B1); PG8_BAR; PG8_SCHED;
            PG8_LDA(At, 1, 1); PG8_STAGE(PG8_SB(1, 0), b3, voffB); PG8_STAGE(PG8_SB(1, 1), b3 + hstep, voffB); PG8_STAGE(PG8_SA(1, 0), a3, voffA);
            PG8_WAIT_V(8); PG8_WAIT_L(0); PG8_BAR; PG8_MMA(1, 0, At, B0); PG8_MMA(1, 1, At, B1); PG8_BAR; PG8_SCHED;
            } else {
            PG8_LDB(B0, 0, 0); PG8_SCHED; PG8_LDA(At, 0, 0); PG8_STAGE(PG8_SA(1, 1), a1 + hstep, voffA);
            PG8_WAIT_L(8); PG8_BAR; PG8_WAIT_L(0); PG8_MMA(0, 0, At, B0); PG8_BAR; PG8_SCHED;
            PG8_LDB(B1, 0, 1); PG8_STAGE(PG8_SB(0, 0), b2, voffB);
            PG8_BAR; PG8_WAIT_L(0); PG8_MMA(0, 1, At, B1); PG8_BAR;
            PG8_LDA(At, 0, 1); PG8_STAGE(PG8_SA(0, 0), a2, voffA);
            PG8_BAR; PG8_WAIT_L(0); PG8_MMA(1, 0, At, B0); PG8_BAR; PG8_SCHED;
            PG8_STAGE(PG8_SB(0, 1), b2 + hstep, voffB);
            PG8_WAIT_V(6); PG8_BAR; PG8_MMA(1, 1, At, B1); PG8_BAR;
            PG8_LDB(B0, 1, 0); PG8_SCHED; PG8_LDA(At, 1, 0); PG8_STAGE(PG8_SA(0, 1), a2 + hstep, voffA);
            PG8_WAIT_L(8); PG8_BAR; PG8_WAIT_L(0); PG8_MMA(0, 0, At, B0); PG8_BAR; PG8_SCHED;
            PG8_LDB(B1, 1, 1); PG8_STAGE(PG8_SB(1, 0), b3, voffB);
            PG8_BAR; PG8_WAIT_L(0); PG8_MMA(0, 1, At, B1); PG8_BAR;
            PG8_LDA(At, 1, 1); PG8_STAGE(PG8_SA(1, 0), a3, voffA);
            PG8_BAR; PG8_WAIT_L(0); PG8_MMA(1, 0, At, B0); PG8_BAR; PG8_SCHED;
            PG8_STAGE(PG8_SB(1, 1), b3 + hstep, voffB);
            PG8_WAIT_V(6); PG8_BAR; PG8_MMA(1, 1, At, B1); PG8_BAR;
            }
        }
        if constexpr (ALIGN_EPI) { if (wr == 0) PG8_BAR; }
        E(acc, cur, wr, wc, fr, fq);
        if (!has_next) break;
#pragma unroll
        for (int a = 0; a < 2; ++a)
#pragma unroll
            for (int b = 0; b < 2; ++b)
#pragma unroll
                for (int m = 0; m < 4; ++m)
#pragma unroll
                    for (int n = 0; n < 2; ++n) acc[a][b][m][n] = (f32x4){0.f, 0.f, 0.f, 0.f};
        cur = nxt; cA = nA; cB = nB; ++ui;
        if constexpr (ALIGN_EPI) { if (wr == 1) PG8_BAR; }
    }
    PG8_WAIT_V(0);
    if constexpr (!ALIGN_EPI) { if (wr == 0) PG8_BAR; }
    PG8_BAR;
#undef PG8_SA
#undef PG8_SB
#undef PG8_STAGE
#undef PG8_LDA
#undef PG8_LDB
#undef PG8_MMA
#undef PG8_WAIT_V
#undef PG8_WAIT_L
#undef PG8_BAR
#undef PG8_SCHED
}
}

#ifndef WGM_G
#define WGM_G 8
#endif
#ifndef WGM_D
#define WGM_D 4
#endif
#ifndef PG8_SP2
#define PG8_SP2 true
#endif
#ifndef PG8_ALIGN
#define PG8_ALIGN true
#endif

constexpr int RING_BYTES = 131072;
constexpr int LDS_BYTES = 147456;
constexpr int MISC_OFF = LDS_BYTES - 256;

struct Args {
    const float* x; const float* n1pre; const float* n1post; const float* w1g; const float* w1u; const float* w1d;
    const float* nmpre; const float* nmpost; const float* win; const float* poolw; const float* poolscale; const float* wab; const float* wpb; const float* wout;
    const float* n2pre; const float* n2post; const float* w2g; const float* w2u; const float* w2d;
    float* out; unsigned char* ws; int ph_lo, ph_hi;
};

struct CvtItem { const float* W; bf16_t* WT; int K, N, mode, r; };
template <int SET> __device__ __forceinline__ CvtItem cvt_item(const Args& a, int it) {
    constexpr int I_GU = (D / 64) * (FF / 32), I_DN = (FF / 64) * (D / 32), I_OUT = (D / 64) * (D / 32), I_BR = (1024 / 64) * (D / 32), I_PL = (256 / 64) * (256 / 32);
    unsigned char* ws = a.ws; CvtItem c; c.mode = 0; int r = it;
    if (SET == 1) { c.W = a.win; c.K = D; c.N = NIN; c.WT = (bf16_t*)(ws + WS_WIN); }
    else if (SET == 2) { c.W = a.w2d; c.K = FF; c.N = D; c.WT = (bf16_t*)(ws + WS_WD2); }
    else if (r < I_GU) { c.W = a.w1g; c.K = D; c.N = FF; c.WT = (bf16_t*)(ws + WS_WGU1); c.mode = 1; }
    else if ((r -= I_GU) < I_GU) { c.W = a.w1u; c.K = D; c.N = FF; c.WT = (bf16_t*)(ws + WS_WGU1); c.mode = 2; }
    else if ((r -= I_GU) < I_GU) { c.W = a.w2g; c.K = D; c.N = FF; c.WT = (bf16_t*)(ws + WS_WGU2); c.mode = 1; }
    else if ((r -= I_GU) < I_GU) { c.W = a.w2u; c.K = D; c.N = FF; c.WT = (bf16_t*)(ws + WS_WGU2); c.mode = 2; }
    else if ((r -= I_GU) < I_DN) { c.W = a.w1d; c.K = FF; c.N = D; c.WT = (bf16_t*)(ws + WS_WD1); }
    else if ((r -= I_DN) < I_OUT) { c.W = a.wout; c.K = D; c.N = D; c.WT = (bf16_t*)(ws + WS_WOUT); }
    else if ((r -= I_OUT) < I_BR) { c.W = a.wab; c.K = 1024; c.N = D; c.WT = (bf16_t*)(ws + WS_WBA); }
    else if ((r -= I_BR) < I_BR) { c.W = a.wpb; c.K = 1024; c.N = D; c.WT = (bf16_t*)(ws + WS_WBP); }
    else { r -= I_BR; const int g = r / I_PL; r -= g * I_PL; c.W = a.poolw + (size_t)g * 65536; c.K = 256; c.N = 256; c.WT = (bf16_t*)(ws + WS_WPL) + (size_t)g * 65536; }
    c.r = r; return c;
}
__device__ __forceinline__ void cvt_load(const CvtItem& c, int lane, float (&wv)[32]) {
    const int nblk = c.N / 32, kb = c.r / nblk, nb = c.r % nblk;
    const float* p = c.W + (size_t)(64 * kb + (lane >> 5)) * c.N + 32 * nb + (lane & 31);
#pragma unroll
    for (int i = 0; i < 32; ++i) wv[i] = p[(size_t)(2 * i) * c.N];
}
__device__ __forceinline__ void cvt_store(const CvtItem& c, LAS float* scr, int lane, const float (&wv)[32]) {
    const int nblk = c.N / 32, kb = c.r / nblk, nb = c.r % nblk, n0 = 32 * nb;
    int drow = n0;
    if (c.mode == 1) drow = (n0 >> 7) * 256 + (n0 & 127);
    else if (c.mode == 2) drow = (n0 >> 7) * 256 + 128 + (n0 & 127);
#pragma unroll
    for (int i = 0; i < 32; ++i) { const int kk = 2 * i + (lane >> 5); scr[kk * 33 + (lane & 31)] = wv[i]; }
    asm volatile("s_waitcnt lgkmcnt(0)" ::: "memory");
    const int cc = lane & 7;
    unsigned char* blk = (unsigned char*)c.WT + ((size_t)(drow >> 7) * (c.K / 64) + kb) * 16384;
#pragma unroll
    for (int j = 0; j < 4; ++j) { const int n = (lane >> 3) + 8 * j; const LAS float* sp = scr + (8 * cc) * 33 + n;
        u32x4 o; o.x = cvt_pk_bf16(sp[0 * 33], sp[1 * 33]); o.y = cvt_pk_bf16(sp[2 * 33], sp[3 * 33]); o.z = cvt_pk_bf16(sp[4 * 33], sp[5 * 33]); o.w = cvt_pk_bf16(sp[6 * 33], sp[7 * 33]);
        const int slot = 16 * ((n >> 2) & 1) + 4 * (n >> 3) + (n & 3);
        *(u32x4*)(blk + pg8::lds_byte((drow & 127) + slot, 8 * cc)) = o; }
    asm volatile("s_waitcnt lgkmcnt(0)" ::: "memory");
}
template <int SET> __device__ __forceinline__ void p0_weights(const Args& a, LAS unsigned char* lds, int gw, int NGW, int wave, int lane) {
    asm volatile("" : "+v"(lane));
    LAS float* scr = (LAS float*)(lds + wave * 16384);
    constexpr int I_GU = (D / 64) * (FF / 32), I_DN = (FF / 64) * (D / 32), I_IN = (D / 64) * (NIN / 32), I_OUT = (D / 64) * (D / 32), I_BR = (1024 / 64) * (D / 32), I_PL = (256 / 64) * (256 / 32);
    constexpr int NITEMS = SET == 0 ? 4 * I_GU + I_DN + I_OUT + 2 * I_BR + 4 * I_PL : (SET == 1 ? I_IN : I_DN);
    if (gw >= NITEMS) return;
    float wv[32]; CvtItem cur = cvt_item<SET>(a, gw); cvt_load(cur, lane, wv);
    for (int it = gw; it < NITEMS; it += NGW) {
        const int nx = it + NGW; float wn[32]; CvtItem nxt = cur;
        if (nx < NITEMS) { nxt = cvt_item<SET>(a, nx); cvt_load(nxt, lane, wn); }
        else {
#pragma unroll
            for (int i = 0; i < 32; ++i) wn[i] = 0.f; }
        cvt_store(cur, scr, lane, wv);
        cur = nxt;
#pragma unroll
        for (int i = 0; i < 32; ++i) wv[i] = wn[i];
    }
}

__device__ __forceinline__ void p0_norm(const float* x, const float* gain, bf16_t* xn, int gw, int NGW, int lane) {
    asm volatile("" : "+v"(lane));
    for (int m = gw; m < M; m += NGW) {
        const f32x4* xr = (const f32x4*)(x + (size_t)m * D) + lane; const f32x4* gr = (const f32x4*)gain + lane;
        f32x4 v[16]; float s = 0.f;
#pragma unroll
        for (int j = 0; j < 16; ++j) { v[j] = xr[64 * j]; s += (v[j][0] * v[j][0] + v[j][1] * v[j][1]) + (v[j][2] * v[j][2] + v[j][3] * v[j][3]); }
        const float rstd = 1.0f / sqrtf(wave_sum(s) * (1.0f / D) + RMS_EPS);
        u32x2* o = (u32x2*)(xn + (size_t)m * D) + lane;
#pragma unroll
        for (int j = 0; j < 16; ++j) { const f32x4 g = gr[64 * j]; u32x2 w; w.x = cvt_pk_bf16(v[j][0] * rstd * g[0], v[j][1] * rstd * g[1]); w.y = cvt_pk_bf16(v[j][2] * rstd * g[2], v[j][3] * rstd * g[3]); o[64 * j] = w; }
    }
}

__device__ __forceinline__ void norm_phase(const bf16_t* f, const float* base, float* hout, bf16_t* xn, const float* gpost, const float* gpre, float coef, int gw, int NGW, int lane) {
    asm volatile("" : "+v"(lane));
    for (int m = gw; m < M; m += NGW) {
        const u32x2* fr_ = (const u32x2*)(f + (size_t)m * D) + lane; const f32x4* br = (const f32x4*)(base + (size_t)m * D) + lane;
        const f32x4* g1 = (const f32x4*)gpost + lane;
        f32x4 v[16]; float s = 0.f;
#pragma unroll
        for (int j = 0; j < 16; ++j) { const u32x2 w = fr_[64 * j]; v[j][0] = bf_lo(w.x); v[j][1] = bf_hi(w.x); v[j][2] = bf_lo(w.y); v[j][3] = bf_hi(w.y); s += (v[j][0] * v[j][0] + v[j][1] * v[j][1]) + (v[j][2] * v[j][2] + v[j][3] * v[j][3]); }
        const float rstd = coef / sqrtf(wave_sum(s) * (1.0f / D) + RMS_EPS);
        float s2 = 0.f; f32x4* ho = (f32x4*)(hout + (size_t)m * D) + lane;
#pragma unroll
        for (int j = 0; j < 16; ++j) { const f32x4 g = g1[64 * j]; const f32x4 b = br[64 * j]; f32x4 h;
            h[0] = b[0] + v[j][0] * rstd * g[0]; h[1] = b[1] + v[j][1] * rstd * g[1]; h[2] = b[2] + v[j][2] * rstd * g[2]; h[3] = b[3] + v[j][3] * rstd * g[3];
            v[j] = h; ho[64 * j] = h; s2 += (h[0] * h[0] + h[1] * h[1]) + (h[2] * h[2] + h[3] * h[3]);
            if ((j & 3) == 3) asm volatile("" ::: "memory"); }
        if (xn) {
            const float r2 = 1.0f / sqrtf(wave_sum(s2) * (1.0f / D) + RMS_EPS);
            const f32x4* g2 = (const f32x4*)gpre + lane; u32x2* o = (u32x2*)(xn + (size_t)m * D) + lane;
#pragma unroll
            for (int j = 0; j < 16; ++j) { const f32x4 g = g2[64 * j]; u32x2 w; w.x = cvt_pk_bf16(v[j][0] * r2 * g[0], v[j][1] * r2 * g[1]); w.y = cvt_pk_bf16(v[j][2] * r2 * g[2], v[j][3] * r2 * g[3]); o[64 * j] = w;
                if ((j & 7) == 7) asm volatile("" ::: "memory"); }
        }
    }
}

template <int P> __device__ __forceinline__ void pool_delta_task(const bf16_t* proj, bf16_t* delta, int g, int mp, int lane) {
    const int m = 2 * mp + (lane >> 5), c = 8 * (lane & 31), t = m & (SEQ - 1);
    const bf16_t* zp = proj + (size_t)m * NIN + POOL_OFF + g * 256 + c;
    u32x4 w[P];
#pragma unroll
    for (int j = 0; j < P; ++j) w[j] = (j <= t) ? *(const u32x4*)(zp - (size_t)j * NIN) : (u32x4){0u, 0u, 0u, 0u};
    float s[8];
#pragma unroll
    for (int k = 0; k < 8; ++k) s[k] = 0.f;
#pragma unroll
    for (int j = 0; j < P; ++j) { s[0] += bf_lo(w[j].x); s[1] += bf_hi(w[j].x); s[2] += bf_lo(w[j].y); s[3] += bf_hi(w[j].y); s[4] += bf_lo(w[j].z); s[5] += bf_hi(w[j].z); s[6] += bf_lo(w[j].w); s[7] += bf_hi(w[j].w); }
    const int cnt = (t + 1) < P ? (t + 1) : P; const float ic = 1.0f / (float)cnt;
    u32x4 o; o.x = cvt_pk_bf16(s[0] * ic - bf_lo(w[0].x), s[1] * ic - bf_hi(w[0].x)); o.y = cvt_pk_bf16(s[2] * ic - bf_lo(w[0].y), s[3] * ic - bf_hi(w[0].y));
    o.z = cvt_pk_bf16(s[4] * ic - bf_lo(w[0].z), s[5] * ic - bf_hi(w[0].z)); o.w = cvt_pk_bf16(s[6] * ic - bf_lo(w[0].w), s[7] * ic - bf_hi(w[0].w));
    *(u32x4*)(delta + ((size_t)g * M + m) * 256 + c) = o;
}
__device__ __forceinline__ void pool_delta(const bf16_t* proj, bf16_t* delta, int gw, int NGW, int lane) {
    asm volatile("" : "+v"(lane));
    for (int task = gw; task < 2 * M; task += NGW) {
        const int g = task & 3, mp = task >> 2;
        if (g == 0) pool_delta_task<2>(proj, delta, 0, mp, lane);
        else if (g == 1) pool_delta_task<4>(proj, delta, 1, mp, lane);
        else if (g == 2) pool_delta_task<8>(proj, delta, 2, mp, lane);
        else pool_delta_task<16>(proj, delta, 3, mp, lane);
    }
}

namespace att {
__device__ __forceinline__ void attn_merge(const bf16_t* outg, const float* lse, bf16_t* attn, int gtid, int NT) {
    asm volatile("" : "+v"(gtid));
    for (int idx = gtid; idx < M * 128; idx += NT) {
        const int m = idx >> 7, c8 = (idx & 127) * 8, h = c8 >> 7;
        const float l0 = lse[(size_t)m * 8 + h], l1 = lse[((size_t)M + m) * 8 + h], l2 = lse[((size_t)2 * M + m) * 8 + h];
        const float mm = fmaxf(l0, fmaxf(l1, l2));
        float w0 = __expf(l0 - mm), w1 = __expf(l1 - mm), w2 = __expf(l2 - mm); const float inv = 1.0f / (w0 + w1 + w2); w0 *= inv; w1 *= inv; w2 *= inv;
        const u32x4 a = *(const u32x4*)(outg + (size_t)m * 1024 + c8), bq = *(const u32x4*)(outg + ((size_t)M + m) * 1024 + c8), c = *(const u32x4*)(outg + ((size_t)2 * M + m) * 1024 + c8);
        u32x4 o;
#pragma unroll
        for (int k = 0; k < 4; ++k) o[k] = cvt_pk_bf16(w0 * bf_lo(a[k]) + w1 * bf_lo(bq[k]) + w2 * bf_lo(c[k]), w0 * bf_hi(a[k]) + w1 * bf_hi(bq[k]) + w2 * bf_hi(c[k]));
        *(u32x4*)(attn + (size_t)m * 1024 + c8) = o;
    }
}
}


namespace att2 {
constexpr int VROW = 272, KBYTES = 32768, STG = KBYTES + 128 * VROW, N_UNITS = 3 * BATCH * 8 * 32;
static_assert(2 * STG <= MISC_OFF, "attention LDS");
struct Lane { int kR[2], kC[2]; unsigned ldsw; int koff, v_ch, v_kg, vcol, fr, fq, qbw, qi; };
struct UDec { const bf16_t* base; size_t rs; int qb, d, g, h, b, r; };
__device__ __forceinline__ UDec decode(const bf16_t* proj, int u) {
    UDec x; const int sub = u & 31; x.h = (u >> 5) & 7; x.b = (u >> 8) & 3; x.g = u >> 10;
    const int dsh = 2 * x.g, nbsh = 5 - dsh; x.d = 1 << dsh; x.qb = sub & ((1 << nbsh) - 1); x.r = sub >> nbsh;
    x.rs = (size_t)x.d * NIN; x.base = proj + ((size_t)x.b * SEQ + x.r) * NIN + x.g * 3072 + x.h * 128; return x;
}
__device__ __forceinline__ int first_half(int u) { const int g = u >> 10, nbsh = 5 - 2 * g; return ((u & 31) & ((1 << nbsh) - 1)) == 0 ? 1 : 0; }
template <int PAR> __device__ __forceinline__ void issue(LAS unsigned char* lds, const bf16_t* proj, int u, int half, const Lane& L, u32x4 (&vr)[4]) {
    const UDec x = decode(proj, u);
    const int i0 = 128 * x.qb - 128 * (1 - half);
    const bf16_t* kb = x.base + 1024 + (size_t)i0 * x.rs;
#pragma unroll
    for (int eh = 0; eh < 2; ++eh)
#pragma unroll
        for (int i = 0; i < 2; ++i)
            __builtin_amdgcn_global_load_lds((const unsigned*)(kb + 64 * eh + (size_t)L.kR[i] * x.rs + L.kC[i]), (LAS unsigned*)(lds + PAR * STG + eh * 16384 + L.ldsw + i * 8192), 16, 0, 0);
    const bf16_t* vp = x.base + 2048 + (size_t)(i0 + 4 * L.v_kg) * x.rs + 8 * L.v_ch;
#pragma unroll
    for (int c = 0; c < 4; ++c) vr[c] = *(const u32x4*)(vp + (size_t)c * x.rs);
}
template <int PAR> __device__ __forceinline__ void store_v(LAS unsigned char* lds, const Lane& L, const u32x4 (&vr)[4]) {
    LAS unsigned char* vdst = lds + PAR * STG + KBYTES + (8 * L.v_ch) * VROW + L.vcol;
#pragma unroll
    for (int wi = 0; wi < 4; ++wi) {
        u32x2 ev, od;
        ev.x = (vr[0][wi] & 0xffffu) | (vr[1][wi] << 16); ev.y = (vr[2][wi] & 0xffffu) | (vr[3][wi] << 16);
        od.x = (vr[0][wi] >> 16) | (vr[1][wi] & 0xffff0000u); od.y = (vr[2][wi] >> 16) | (vr[3][wi] & 0xffff0000u);
        *(LAS u32x2*)(vdst + (2 * wi) * VROW) = ev; *(LAS u32x2*)(vdst + (2 * wi + 1) * VROW) = od; }
}
__device__ __forceinline__ void load_q(const bf16_t* proj, int u, const Lane& L, bf16x8 (&q)[4]) {
    const UDec x = decode(proj, u);
    const bf16_t* qp = x.base + (size_t)(128 * x.qb + L.qi) * x.rs + 8 * L.fq;
#pragma unroll
    for (int ks = 0; ks < 4; ++ks) q[ks] = *(const bf16x8*)(qp + 32 * ks);
}
template <int PAR> __device__ __forceinline__ void compute(LAS unsigned char* lds, int u, int half, const Lane& L, const bf16x8 (&qf)[4], float& mrun, float& lrun, f32x4 (&o)[8]) {
    const int g = u >> 10, h = (u >> 5) & 7, d = 1 << (2 * g);
    const int qbw = L.qbw;
    f32x4 s[8];
#pragma unroll
    for (int kt = 0; kt < 8; ++kt) {
        const bool act = half ? (kt <= qbw) : (kt >= qbw);
        s[kt] = (f32x4){0.f, 0.f, 0.f, 0.f};
        if (act) {
#pragma unroll
            for (int ks = 0; ks < 4; ++ks) { const bf16x8 kf = *(const LAS bf16x8*)(lds + PAR * STG + (ks >> 1) * 16384 + L.koff + kt * 2048 + (ks & 1) * 1024);
                s[kt] = __builtin_amdgcn_mfma_f32_16x16x32_bf16(kf, qf[ks], s[kt], 0, 0, 0); } }
    }
    const float slope = (g < 2) ? exp2f(-0.25f * (float)(g * 8 + h + 1)) : exp2f(-(4.5f + 0.5f * (float)h));
    const float sld = slope * (float)d;
    int bi = L.qi + 128 * (1 - half) - 4 * L.fq; asm volatile("" : "+v"(bi));
    const float c0 = -sld * (float)bi;
    float mloc = -1e30f;
#pragma unroll
    for (int kt = 0; kt < 8; ++kt)
#pragma unroll
        for (int j = 0; j < 4; ++j) { const int kc = 16 * kt + j;
            const bool valid = (kc <= bi) && (kc >= bi - 128);
            float v = s[kt][j] * 0.08838834764831845f + (c0 + sld * (float)kc); v = valid ? v : -1e30f; s[kt][j] = v; mloc = fmaxf(mloc, v); }
    mloc = fmaxf(mloc, __shfl_xor(mloc, 16)); mloc = fmaxf(mloc, __shfl_xor(mloc, 32));
    const float mnew = fmaxf(mrun, mloc), alpha = __expf(mrun - mnew);
    float lsum = 0.f;
#pragma unroll
    for (int kt = 0; kt < 8; ++kt)
#pragma unroll
        for (int j = 0; j < 4; ++j) { const float p = __expf(s[kt][j] - mnew); s[kt][j] = p; lsum += p; }
    lrun = lrun * alpha + lsum; mrun = mnew;
#pragma unroll
    for (int et = 0; et < 8; ++et) o[et] = o[et] * alpha;
#pragma unroll
    for (int ss = 0; ss < 4; ++ss) {
        const bool act = half ? (2 * ss <= qbw) : (2 * ss + 1 >= qbw);
        if (act) {
            u32x4 pw; pw.x = cvt_pk_bf16(s[2 * ss][0], s[2 * ss][1]); pw.y = cvt_pk_bf16(s[2 * ss][2], s[2 * ss][3]); pw.z = cvt_pk_bf16(s[2 * ss + 1][0], s[2 * ss + 1][1]); pw.w = cvt_pk_bf16(s[2 * ss + 1][2], s[2 * ss + 1][3]);
            const bf16x8 pf = __builtin_bit_cast(bf16x8, pw);
#pragma unroll
            for (int et = 0; et < 8; ++et) { const bf16x8 vf = *(const LAS bf16x8*)(lds + PAR * STG + KBYTES + (16 * et + L.fr) * VROW + 64 * ss + 16 * L.fq);
                o[et] = __builtin_amdgcn_mfma_f32_16x16x32_bf16(vf, pf, o[et], 0, 0, 0); } }
    }
}
__device__ __forceinline__ void finalize(const bf16_t* proj, int u, const Lane& L, float mrun, float lrun, const f32x4 (&o)[8], bf16_t* outg, float* lse) {
    const UDec x = decode(proj, u);
    float l = lrun; l += __shfl_xor(l, 16); l += __shfl_xor(l, 32);
    const float inv = 1.0f / l;
    const size_t mrow = (size_t)x.g * M + (size_t)x.b * SEQ + (size_t)(128 * x.qb + L.qi) * x.d + x.r;
    bf16_t* op = outg + mrow * 1024 + x.h * 128 + 4 * L.fq;
#pragma unroll
    for (int et = 0; et < 8; ++et) { u32x2 w; w.x = cvt_pk_bf16(o[et][0] * inv, o[et][1] * inv); w.y = cvt_pk_bf16(o[et][2] * inv, o[et][3] * inv); *(u32x2*)(op + 16 * et) = w; }
    if (L.fq == 0) lse[mrow * 8 + x.h] = mrun + __logf(l);
}
template <int PAR> __device__ __forceinline__ bool step(LAS unsigned char* lds, const bf16_t* proj, bf16_t* outg, float* lse, int G, const Lane& L, int& u, int& half, bf16x8 (&qf)[4], float& mrun, float& lrun, f32x4 (&o)[8]) {
    int nu, nh; if (half == 0) { nu = u; nh = 1; } else { nu = u + G; nh = nu < N_UNITS ? first_half(nu) : 0; }
    const bool has_next = nu < N_UNITS, new_unit = has_next && (nu != u);
    u32x4 vr[4]; bf16x8 qn[4];
    if (has_next) issue<PAR ^ 1>(lds, proj, nu, nh, L, vr);
    if (new_unit) load_q(proj, nu, L, qn);
    __builtin_amdgcn_sched_barrier(0);
    compute<PAR>(lds, u, half, L, qf, mrun, lrun, o);
    if (half == 1) { finalize(proj, u, L, mrun, lrun, o, outg, lse); mrun = -1e30f; lrun = 0.f;
#pragma unroll
        for (int et = 0; et < 8; ++et) o[et] = (f32x4){0.f, 0.f, 0.f, 0.f}; }
    __builtin_amdgcn_sched_barrier(0);
    if (has_next) store_v<PAR ^ 1>(lds, L, vr);
    if (new_unit) {
#pragma unroll
        for (int ks = 0; ks < 4; ++ks) qf[ks] = qn[ks]; }
    __builtin_amdgcn_s_waitcnt(0); asm volatile("" ::: "memory"); __builtin_amdgcn_s_barrier(); asm volatile("" ::: "memory");
    u = nu; half = nh;
    return has_next;
}
__device__ __forceinline__ void attn_phase(LAS unsigned char* lds, const bf16_t* proj, bf16_t* outg, float* lse, int vcu, int G) {
    int tid = threadIdx.x; asm volatile("" : "+v"(tid));
    const int lane = tid & 63, wid = __builtin_amdgcn_readfirstlane(tid >> 6);
    Lane L;
#pragma unroll
    for (int i = 0; i < 2; ++i) pg8::stage_rc(tid * 16 + i * 8192, L.kR[i], L.kC[i]);
    L.fr = lane & 15; L.fq = lane >> 4; L.ldsw = (unsigned)wid * 1024u; L.koff = pg8::lds_byte(L.fr, L.fq * 8);
    L.v_ch = (lane & 3) + 4 * ((lane >> 4) & 3); L.v_kg = ((lane >> 2) & 3) + 4 * wid;
    L.vcol = 64 * (wid >> 1) + 16 * ((lane >> 2) & 3) + 8 * (wid & 1);
    L.qbw = wid < 4 ? wid : 11 - wid; L.qi = 16 * L.qbw + L.fr;
    int u = vcu; if (u >= N_UNITS) return;
    int half = first_half(u);
    bf16x8 qf[4]; f32x4 o[8]; float mrun = -1e30f, lrun = 0.f;
#pragma unroll
    for (int et = 0; et < 8; ++et) o[et] = (f32x4){0.f, 0.f, 0.f, 0.f};
    { u32x4 vr[4]; issue<0>(lds, proj, u, half, L, vr); load_q(proj, u, L, qf); store_v<0>(lds, L, vr); }
    __builtin_amdgcn_s_waitcnt(0); asm volatile("" ::: "memory"); __builtin_amdgcn_s_barrier(); asm volatile("" ::: "memory");
    for (;;) {
        if (!step<0>(lds, proj, outg, lse, G, L, u, half, qf, mrun, lrun, o)) break;
        if (!step<1>(lds, proj, outg, lse, G, L, u, half, qf, mrun, lrun, o)) break;
    }
}
}

constexpr int NPHASE = 13;
__global__ void __launch_bounds__(NTHREADS, 2) mk_fwd(Args a) {
    extern __shared__ __attribute__((aligned(16))) unsigned char lds_raw[];
    LAS unsigned char* lds = (LAS unsigned char*)lds_raw;
    const int tid = threadIdx.x, lane = tid & 63, wave = __builtin_amdgcn_readfirstlane(tid >> 6);
    const int G = gridDim.x, bx = blockIdx.x;
    const int vcu = (G % 8 == 0) ? (bx % 8) * (G / 8) + bx / 8 : bx;
    const int gw = vcu * NWAVES + wave, NGW = G * NWAVES;
    unsigned char* ws = a.ws;
    unsigned* ctl = (unsigned*)(ws + WS_CTL);
    volatile LAS unsigned* MISC = (volatile LAS unsigned*)(lds + MISC_OFF);
    if (tid < 32) MISC[tid] = 0u;
    __syncthreads();
    XcdBarrier bar; bar.bar = ctl + CW_BAR; bar.x = 0; bar.st = nullptr;
    if (MK_ONE_LAUNCH) bar = xcd_barrier_post(ctl + CW_BAR, MISC + 8);
    const int lo = a.ph_lo, hi = a.ph_hi;
#ifdef DBG_ONLY
#define IN(k) ((k) == DBG_ONLY && lo <= (k) && (k) < hi)
#else
#define IN(k) (lo <= (k) && (k) < hi)
#endif
#define SEAM(k) do { if (MK_ONE_LAUNCH && IN(k) && IN((k) + 1)) xcd_barrier(bar); } while (0)

    bf16_t* XN = (bf16_t*)(ws + WS_XN); bf16_t* ACT = (bf16_t*)(ws + WS_ACT); bf16_t* Fb = (bf16_t*)(ws + WS_F); bf16_t* PROJ = (bf16_t*)(ws + WS_PROJ);
    bf16_t* ATT = (bf16_t*)(ws + WS_ATTN); bf16_t* DELTA = (bf16_t*)(ws + WS_DELTA); bf16_t* POOLED = (bf16_t*)(ws + WS_POOLED); bf16_t* MERGED = XN;

    const bool tail_cvt = (G == 256);
    if (IN(0)) { p0_weights<0>(a, lds, gw, NGW, wave, lane);
        if (!tail_cvt) { p0_weights<1>(a, lds, gw, NGW, wave, lane); p0_weights<2>(a, lds, gw, NGW, wave, lane); }
        p0_norm(a.x, a.n1pre, XN, gw, NGW, lane); }
    SEAM(0);
    if (IN(1)) { pg8::PlainSched S; S.T.init(M, 2 * FF, G, bx, WGM_G); S.A = (const char*)XN; S.B = (const char*)(ws + WS_WGU1); S.tstep = (size_t)256 * D * 2;
        pg8::EpiSwiGLU E{ACT, FF};
        pg8::gemm_phase<pg8::EpiSwiGLU, pg8::PlainSched, PG8_ALIGN, PG8_SP2>(lds, D, S, E);
        if (tail_cvt && bx >= 128) p0_weights<1>(a, lds, (bx - 128) * NWAVES + wave, 128 * NWAVES, wave, lane); }
    SEAM(1);
    if (IN(2)) { pg8::PlainSched S; S.T.init(M, D, G, bx, WGM_D); S.A = (const char*)ACT; S.B = (const char*)(ws + WS_WD1); S.tstep = (size_t)256 * FF * 2;
        pg8::EpiBf16 E{Fb, D};
        pg8::gemm_phase<pg8::EpiBf16, pg8::PlainSched, PG8_ALIGN, PG8_SP2>(lds, FF, S, E); }
    SEAM(2);
    if (IN(3)) norm_phase(Fb, a.x, a.out, XN, a.n1post, a.nmpre, 0.5f, gw, NGW, lane);
    SEAM(3);
    if (IN(4)) { pg8::PlainSched S; S.T.init(M, NIN, G, bx, WGM_G); S.A = (const char*)XN; S.B = (const char*)(ws + WS_WIN); S.tstep = (size_t)256 * D * 2;
        pg8::EpiBf16Sig E{PROJ, NIN, GA_OFF / 256};
        pg8::gemm_phase<pg8::EpiBf16Sig, pg8::PlainSched, PG8_ALIGN, PG8_SP2>(lds, D, S, E); }
    SEAM(4);
    if (IN(5)) { att2::attn_phase(lds, PROJ, (bf16_t*)(ws + WS_OUTG), (float*)(ws + WS_LSE), vcu, G); pool_delta(PROJ, DELTA, gw, NGW, lane); }
    SEAM(5);
    if (IN(6)) { att::attn_merge((const bf16_t*)(ws + WS_OUTG), (const float*)(ws + WS_LSE), ATT, vcu * NTHREADS + tid, G * NTHREADS);
        pg8::PoolSched S; S.T.init(M, 1024, G, bx); S.A = (const char*)DELTA; S.B = (const char*)(ws + WS_WPL); S.tstep = (size_t)256 * 256 * 2; S.gstride = (size_t)M * 256 * 2;
        pg8::EpiPool E{POOLED, 1024, a.poolscale};
        pg8::gemm_phase<pg8::EpiPool, pg8::PoolSched, PG8_ALIGN, PG8_SP2>(lds, 256, S, E); }
    SEAM(6);
    if (IN(7)) { pg8::BranchSched S; S.T.init(M, D, G, bx); S.A0 = (const char*)ATT; S.B0 = (const char*)(ws + WS_WBA); S.A1 = (const char*)POOLED; S.B1 = (const char*)(ws + WS_WBP); S.tstep = (size_t)256 * 1024 * 2;
        pg8::EpiBranch E{MERGED, D, PROJ, (f32x4*)(ws + WS_T1) + (size_t)bx * (32 * NTHREADS)};
        pg8::gemm_phase<pg8::EpiBranch, pg8::BranchSched, PG8_ALIGN, PG8_SP2>(lds, 1024, S, E); }
    SEAM(7);
    if (IN(8)) { pg8::PlainSched S; S.T.init(M, D, G, bx); S.A = (const char*)MERGED; S.B = (const char*)(ws + WS_WOUT); S.tstep = (size_t)256 * D * 2;
        pg8::EpiBf16 E{Fb, D};
        pg8::gemm_phase<pg8::EpiBf16, pg8::PlainSched, PG8_ALIGN, PG8_SP2>(lds, D, S, E); }
    SEAM(8);
    if (IN(9)) norm_phase(Fb, a.out, a.out, XN, a.nmpost, a.n2pre, 1.0f, gw, NGW, lane);
    SEAM(9);
    if (IN(10)) { pg8::PlainSched S; S.T.init(M, 2 * FF, G, bx, WGM_G); S.A = (const char*)XN; S.B = (const char*)(ws + WS_WGU2); S.tstep = (size_t)256 * D * 2;
        pg8::EpiSwiGLU E{ACT, FF};
        pg8::gemm_phase<pg8::EpiSwiGLU, pg8::PlainSched, PG8_ALIGN, PG8_SP2>(lds, D, S, E);
        if (tail_cvt && bx >= 128) p0_weights<2>(a, lds, (bx - 128) * NWAVES + wave, 128 * NWAVES, wave, lane); }
    SEAM(10);
    if (IN(11)) { pg8::PlainSched S; S.T.init(M, D, G, bx, WGM_D); S.A = (const char*)ACT; S.B = (const char*)(ws + WS_WD2); S.tstep = (size_t)256 * FF * 2;
        pg8::EpiBf16 E{Fb, D};
        pg8::gemm_phase<pg8::EpiBf16, pg8::PlainSched, PG8_ALIGN, PG8_SP2>(lds, FF, S, E); }
    SEAM(11);
    if (IN(12)) norm_phase(Fb, a.out, a.out, nullptr, a.n2post, nullptr, 0.5f, gw, NGW, lane);
#undef IN
#undef SEAM
}

extern "C" void kernel_launch(void* const* d_in, const int* in_sizes, int n_in, void* d_out, int out_size, void* d_ws, size_t ws_size, hipStream_t stream) {
    static int grid = 0;
    if (grid == 0) {
        if (n_in != 19 || in_sizes[0] != M * D || out_size != M * D || ws_size < WS_END) { fprintf(stderr, "kernel_launch: unexpected shapes (n_in %d, in0 %d, out %d, ws %zu < %zu)\n", n_in, n_in > 0 ? in_sizes[0] : -1, out_size, ws_size, (size_t)WS_END); grid = -1; return; }
        int dev = 0, cus = 0, per_cu = 0;
        if (hipGetDevice(&dev) != hipSuccess || hipDeviceGetAttribute(&cus, hipDeviceAttributeMultiprocessorCount, dev) != hipSuccess) { grid = -1; return; }
        if (hipFuncSetAttribute((const void*)mk_fwd, hipFuncAttributeMaxDynamicSharedMemorySize, LDS_BYTES) != hipSuccess) { fprintf(stderr, "kernel_launch: hipFuncSetAttribute failed\n"); grid = -1; return; }
        if (hipOccupancyMaxActiveBlocksPerMultiprocessor(&per_cu, (const void*)mk_fwd, NTHREADS, LDS_BYTES) != hipSuccess || per_cu < 1) { fprintf(stderr, "kernel_launch: occupancy query says %d\n", per_cu); }
        (void)hipGetLastError();
        grid = cus;
    }
    if (grid < 0) return;
    (void)hipMemsetAsync((char*)d_ws + WS_CTL, 0, CTL_ZERO_BYTES, stream);
    Args a{};
    a.x = (const float*)d_in[0]; a.n1pre = (const float*)d_in[1]; a.n1post = (const float*)d_in[2]; a.w1g = (const float*)d_in[3]; a.w1u = (const float*)d_in[4]; a.w1d = (const float*)d_in[5];
    a.nmpre = (const float*)d_in[6]; a.nmpost = (const float*)d_in[7]; a.win = (const float*)d_in[8]; a.poolw = (const float*)d_in[9]; a.poolscale = (const float*)d_in[10];
    a.wab = (const float*)d_in[11]; a.wpb = (const float*)d_in[12]; a.wout = (const float*)d_in[13];
    a.n2pre = (const float*)d_in[14]; a.n2post = (const float*)d_in[15]; a.w2g = (const float*)d_in[16]; a.w2u = (const float*)d_in[17]; a.w2d = (const float*)d_in[18];
    a.out = (float*)d_out; a.ws = (unsigned char*)d_ws;
#if MK_ONE_LAUNCH
    a.ph_lo = 0; a.ph_hi = NPHASE;
    hipLaunchKernelGGL(mk_fwd, dim3(grid), dim3(NTHREADS), LDS_BYTES, stream, a);
#else
    for (int p = 0; p < NPHASE; ++p) { a.ph_lo = p; a.ph_hi = p + 1; hipLaunchKernelGGL(mk_fwd, dim3(grid), dim3(NTHREADS), LDS_BYTES, stream, a); }
#endif
}
```

```cpp
#include <hip/hip_runtime.h>
#include <cstdio>
#include <cstdint>

#ifndef MK_ONE_LAUNCH
#define MK_ONE_LAUNCH 1
#endif

#define LAS __attribute__((address_space(3)))
#define GAS __attribute__((address_space(1)))
typedef unsigned short bf16_t;
typedef short bf16x8 __attribute__((ext_vector_type(8)));
typedef float f32x4 __attribute__((ext_vector_type(4)));
typedef float f32x2 __attribute__((ext_vector_type(2)));
typedef unsigned u32x4 __attribute__((ext_vector_type(4)));
typedef unsigned u32x2 __attribute__((ext_vector_type(2)));

constexpr int BATCH = 4, SEQ = 4096, M = BATCH * SEQ, D = 4096, FF = 11008, NIN = 18432;
constexpr int POOL_OFF = 9216, GA_OFF = 10240, GP_OFF = 14336;
constexpr float RMS_EPS = 1e-6f;
constexpr int NWAVES = 8, NTHREADS = 512;

constexpr size_t MiB = (size_t)1 << 20;
constexpr size_t WS_CTL = 0, CTL_ZERO_BYTES = 1 * MiB;
constexpr size_t WS_WGU1 = 1 * MiB;
constexpr size_t WS_WD1 = 173 * MiB;
constexpr size_t WS_WIN = 259 * MiB;
constexpr size_t WS_WOUT = 403 * MiB;
constexpr size_t WS_WBA = 435 * MiB;
constexpr size_t WS_WBP = 443 * MiB;
constexpr size_t WS_WPL = 451 * MiB;
constexpr size_t WS_WGU2 = 452 * MiB;
constexpr size_t WS_WD2 = 624 * MiB;
constexpr size_t WS_XN = 710 * MiB;
constexpr size_t WS_ACT = 838 * MiB;
constexpr size_t WS_F = 1182 * MiB;
constexpr size_t WS_PROJ = 838 * MiB;
constexpr size_t WS_ATTN = 1438 * MiB;
constexpr size_t WS_DELTA = 1470 * MiB;
constexpr size_t WS_POOLED = 1502 * MiB;
constexpr size_t WS_T1 = 1534 * MiB;
constexpr size_t WS_OUTG = WS_XN;
constexpr size_t WS_LSE = WS_XN + 96 * MiB;
constexpr size_t WS_END = 1598 * MiB;
static_assert(WS_PROJ + (size_t)M * NIN * 2 <= WS_ATTN, "proj overlay");
constexpr int CW_BAR = 4096;

__device__ __forceinline__ unsigned cvt_pk_bf16(float lo, float hi) { unsigned r; asm volatile("v_cvt_pk_bf16_f32 %0, %1, %2" : "=v"(r) : "v"(lo), "v"(hi)); return r; }
__device__ __forceinline__ float bf_lo(unsigned w) { return __uint_as_float(w << 16); }
__device__ __forceinline__ float bf_hi(unsigned w) { return __uint_as_float(w & 0xffff0000u); }
__device__ __forceinline__ float wave_sum(float v) {
#pragma unroll
    for (int o = 1; o < 64; o <<= 1) v += __shfl_xor(v, o);
    return v;
}
__device__ __forceinline__ float fast_sigmoid(float x) { return __builtin_amdgcn_rcpf(1.0f + __builtin_amdgcn_exp2f(-1.4426950408889634f * x)); }

#define XB_TMO      128
#define XB_XCNT(j)  (256  + 64 * (j))
#define XB_XSUB(j)  (1280 + 64 * (j))
#define XB_XGEN(j)  (2304 + 64 * (j))
#define XB_TOP      3328
#define XB_TOPGEN   3392
#define XCD_BAR_WORDS 3456
#define XB_SPIN_CAP (1u << 18)

__device__ __forceinline__ unsigned xb_ld(unsigned* p)              { return __hip_atomic_load(p, __ATOMIC_RELAXED, __HIP_MEMORY_SCOPE_AGENT); }
__device__ __forceinline__ unsigned xb_add(unsigned* p, unsigned v) { return __hip_atomic_fetch_add(p, v, __ATOMIC_RELAXED, __HIP_MEMORY_SCOPE_AGENT); }
__device__ __forceinline__ unsigned xb_xcc_id() { return (unsigned)__builtin_amdgcn_s_getreg((3 << 11) | 20) & 0xFu; }
#define XB_SPIN(cond, bar) do { unsigned _sp = 0; while (cond) { __builtin_amdgcn_s_sleep(1); \
    if ((++_sp & 255u) == 0u) { if (xb_ld(&(bar)[XB_TMO])) break; if (_sp > XB_SPIN_CAP) { atomicAdd(&(bar)[XB_TMO], 1u); break; } } } } while (0)

struct XcdBarrier { unsigned* bar; unsigned x; volatile LAS unsigned* st; };

__device__ __forceinline__ XcdBarrier xcd_barrier_post(unsigned* bar, volatile LAS unsigned* st) {
    XcdBarrier b; b.bar = bar; b.x = xb_xcc_id(); b.st = st;
    if (threadIdx.x == 0) (void)xb_add(&bar[XB_XCNT(b.x)], 1u);
    return b;
}
__device__ __forceinline__ void xcd_barrier_complete(unsigned* bar, unsigned x, unsigned& nloc, unsigned& nx) {
    const unsigned G = gridDim.x * gridDim.y * gridDim.z;
    unsigned sum, cnt, mine, sp = 0u;
    for (;;) {
        sum = 0u; cnt = 0u; mine = 0u;
#pragma unroll
        for (unsigned j = 0; j < 16; ++j) { const unsigned c = xb_ld(&bar[XB_XCNT(j)]); sum += c; cnt += (c > 0u) ? 1u : 0u; mine = (j == x) ? c : mine; }
        if (sum == G) break;
        __builtin_amdgcn_s_sleep(1);
        if ((++sp & 255u) == 0u) { if (xb_ld(&bar[XB_TMO])) break; if (sp > XB_SPIN_CAP) { atomicAdd(&bar[XB_TMO], 1u); break; } }
    }
    nloc = mine > 0u ? mine : 1u; nx = cnt > 0u ? cnt : 1u;
}
__device__ __forceinline__ void xcd_barrier(const XcdBarrier& b) {
    asm volatile("s_waitcnt vmcnt(0)" ::: "memory");
    __syncthreads();
    if (threadIdx.x == 0) {
        unsigned* bar = b.bar;
        __builtin_amdgcn_s_waitcnt(0);
        unsigned nloc = b.st[0], nx = b.st[1];
        if (nloc == 0u) { xcd_barrier_complete(bar, b.x, nloc, nx); b.st[0] = nloc; b.st[1] = nx; }
        const unsigned old = xb_add(&bar[XB_XSUB(b.x)], 1u);
        const unsigned gen = old / nloc;
        if (old + 1u == (gen + 1u) * nloc) {
            __builtin_amdgcn_fence(__ATOMIC_RELEASE, "agent");
            asm volatile("s_waitcnt vmcnt(0)" ::: "memory");
            const unsigned og = xb_add(&bar[XB_TOP], 1u);
            const unsigned tg = og / nx;
            if (og + 1u == (tg + 1u) * nx) xb_add(&bar[XB_TOPGEN], 1u);
            else XB_SPIN(xb_ld(&bar[XB_TOPGEN]) == tg, bar);
            __builtin_amdgcn_fence(__ATOMIC_ACQUIRE, "agent");
            xb_add(&bar[XB_XGEN(b.x)], 1u);
            asm volatile("s_waitcnt vmcnt(0)" ::: "memory");
        } else {
            XB_SPIN(xb_ld(&bar[XB_XGEN(b.x)]) == gen, bar);
            __builtin_amdgcn_fence(__ATOMIC_ACQUIRE, "agent");
            asm volatile("s_waitcnt vmcnt(0)" ::: "memory");
        }
    }
    __syncthreads();
}

namespace pg8 {
constexpr int BM = 256, BK = 64, HALF = 128, HTB = HALF * BK * 2, STAGE_BYTES = 8 * HTB, NXCD = 8, WGM = 8;
__host__ __device__ __forceinline__ int lds_byte(int r, int c) { const int st = (r >> 4) * 2 + (c >> 5), rr = r & 15, cc = c & 31, ob = rr * 64 + cc * 2; return st * 1024 + (ob ^ (((ob >> 9) & 1) << 5)); }
__host__ __device__ __forceinline__ void stage_rc(int b, int& R, int& C) { const int st = b / 1024, sb = b % 1024, swz = sb ^ (((sb >> 9) & 1) << 5); R = (st >> 1) * 16 + swz / 64; C = (st & 1) * 32 + (swz % 64) / 2; }
__host__ __device__ __forceinline__ int perm32(int rho) { const int n = rho >> 4, i = rho & 15; return 8 * (i >> 2) + 4 * n + (i & 3); }

struct Unit { int pm, pn, sub; };
struct TileOrder {
    int nM, nN, nwg, G, c, wgm;
    __device__ __forceinline__ void init(int Mr, int Nc, int G_, int c_, int wgm_ = WGM) { nM = Mr / BM; nN = Nc / BM; nwg = nM * nN; G = G_; c = c_; wgm = wgm_; }
    __device__ __forceinline__ bool at(long L, int& pm, int& pn) const {
        if (L >= nwg) return false;
        int wgid = (int)L; { const int q = nwg / NXCD, r = nwg % NXCD, xcd = wgid % NXCD, off = wgid / NXCD; wgid = (xcd < r ? xcd * (q + 1) : r * (q + 1) + (xcd - r) * q) + off; }
        const int nig = wgm * nN, gid = wgid / nig, fm = gid * wgm, gsz = (nM - fm) < wgm ? (nM - fm) : wgm;
        pm = fm + ((wgid % nig) % gsz); pn = (wgid % nig) / gsz; return true;
    }
};
struct PlainSched {
    TileOrder T; const char* A; const char* B; size_t tstep;
    __device__ __forceinline__ bool next(int i, Unit& u) const { u.sub = 0; return T.at((long)i * T.G + T.c, u.pm, u.pn); }
    __device__ __forceinline__ const char* aptr(const Unit& u) const { return A + (size_t)u.pm * tstep; }
    __device__ __forceinline__ const char* bptr(const Unit& u) const { return B + (size_t)u.pn * tstep; }
};
struct BranchSched {
    TileOrder T; const char* A0; const char* B0; const char* A1; const char* B1; size_t tstep;
    __device__ __forceinline__ bool next(int i, Unit& u) const { u.sub = i & 1; return T.at((long)(i >> 1) * T.G + T.c, u.pm, u.pn); }
    __device__ __forceinline__ const char* aptr(const Unit& u) const { return (u.sub ? A1 : A0) + (size_t)u.pm * tstep; }
    __device__ __forceinline__ const char* bptr(const Unit& u) const { return (u.sub ? B1 : B0) + (size_t)u.pn * tstep; }
};
struct PoolSched {
    TileOrder T; const char* A; const char* B; size_t tstep, gstride;
    __device__ __forceinline__ bool next(int i, Unit& u) const { u.sub = 0; return T.at((long)i * T.G + T.c, u.pm, u.pn); }
    __device__ __forceinline__ const char* aptr(const Unit& u) const { return A + (size_t)u.pn * gstride + (size_t)u.pm * tstep; }
    __device__ __forceinline__ const char* bptr(const Unit& u) const { return B + (size_t)u.pn * tstep; }
};

struct EpiSwiGLU {
    static constexpr bool PERM = true;
    bf16_t* O; int ldc;
    __device__ __forceinline__ void operator()(const f32x4 (&acc)[2][2][4][2], const Unit& u, int wr, int wc, int fr, int fq) const {
        const int row0 = u.pm * BM + wr * 64 + fr, col0 = u.pn * HALF + wc * 32 + 8 * fq;
#pragma unroll
        for (int ai = 0; ai < 2; ++ai)
#pragma unroll
            for (int m = 0; m < 4; ++m) { bf16_t* rowp = O + (size_t)(row0 + ai * HALF + m * 16) * ldc + col0;
                float o[8];
#pragma unroll
                for (int n = 0; n < 2; ++n)
#pragma unroll
                    for (int j = 0; j < 4; ++j) { const float g = acc[ai][0][m][n][j], uu = acc[ai][1][m][n][j]; o[n * 4 + j] = g * fast_sigmoid(g) * uu; }
                u32x4 w; w.x = cvt_pk_bf16(o[0], o[1]); w.y = cvt_pk_bf16(o[2], o[3]); w.z = cvt_pk_bf16(o[4], o[5]); w.w = cvt_pk_bf16(o[6], o[7]);
                *(u32x4*)rowp = w; }
    }
};
struct EpiBf16 {
    static constexpr bool PERM = true;
    bf16_t* O; int ldc;
    __device__ __forceinline__ void operator()(const f32x4 (&acc)[2][2][4][2], const Unit& u, int wr, int wc, int fr, int fq) const {
        const int row0 = u.pm * BM + wr * 64 + fr, col0 = u.pn * BM + wc * 32 + 8 * fq;
#pragma unroll
        for (int ai = 0; ai < 2; ++ai)
#pragma unroll
            for (int m = 0; m < 4; ++m) { bf16_t* rowp = O + (size_t)(row0 + ai * HALF + m * 16) * ldc + col0;
#pragma unroll
                for (int bj = 0; bj < 2; ++bj) { const f32x4 v0 = acc[ai][bj][m][0], v1 = acc[ai][bj][m][1];
                    u32x4 w; w.x = cvt_pk_bf16(v0[0], v0[1]); w.y = cvt_pk_bf16(v0[2], v0[3]); w.z = cvt_pk_bf16(v1[0], v1[1]); w.w = cvt_pk_bf16(v1[2], v1[3]);
                    *(u32x4*)(rowp + bj * HALF) = w; } }
    }
};
struct EpiBf16Sig {
    static constexpr bool PERM = true;
    bf16_t* O; int ldc; int sig_from;
    __device__ __forceinline__ void operator()(const f32x4 (&acc)[2][2][4][2], const Unit& u, int wr, int wc, int fr, int fq) const {
        const int row0 = u.pm * BM + wr * 64 + fr, col0 = u.pn * BM + wc * 32 + 8 * fq; const bool sg = u.pn >= sig_from;
#pragma unroll
        for (int ai = 0; ai < 2; ++ai)
#pragma unroll
            for (int m = 0; m < 4; ++m) { bf16_t* rowp = O + (size_t)(row0 + ai * HALF + m * 16) * ldc + col0;
#pragma unroll
                for (int bj = 0; bj < 2; ++bj) { f32x4 v0 = acc[ai][bj][m][0], v1 = acc[ai][bj][m][1];
                    if (sg) {
#pragma unroll
                        for (int j = 0; j < 4; ++j) { v0[j] = fast_sigmoid(v0[j]); v1[j] = fast_sigmoid(v1[j]); } }
                    u32x4 w; w.x = cvt_pk_bf16(v0[0], v0[1]); w.y = cvt_pk_bf16(v0[2], v0[3]); w.z = cvt_pk_bf16(v1[0], v1[1]); w.w = cvt_pk_bf16(v1[2], v1[3]);
                    *(u32x4*)(rowp + bj * HALF) = w; } }
    }
};
struct EpiPool {
    static constexpr bool PERM = true;
    bf16_t* O; int ldc; const float* scale;
    __device__ __forceinline__ void operator()(const f32x4 (&acc)[2][2][4][2], const Unit& u, int, int, int, int) const {
        int tz = threadIdx.x; asm volatile("" : "+v"(tz));
        const int wid = tz >> 6, lane = tz & 63, wr = wid >> 2, wc = wid & 3, fr = lane & 15, fq = lane >> 4;
        const int row0 = u.pm * BM + wr * 64 + fr, col0 = u.pn * BM + wc * 32 + 8 * fq;
#pragma unroll
        for (int bj = 0; bj < 2; ++bj) { const f32x4 sv0 = *(const f32x4*)(scale + col0 + bj * HALF), sv1 = *(const f32x4*)(scale + col0 + bj * HALF + 4);
#pragma unroll
            for (int ai = 0; ai < 2; ++ai)
#pragma unroll
                for (int m = 0; m < 4; ++m) { bf16_t* rowp = O + (size_t)(row0 + ai * HALF + m * 16) * ldc + col0;
                    const f32x4 v0 = acc[ai][bj][m][0] * sv0, v1 = acc[ai][bj][m][1] * sv1;
                    u32x4 w; w.x = cvt_pk_bf16(v0[0], v0[1]); w.y = cvt_pk_bf16(v0[2], v0[3]); w.z = cvt_pk_bf16(v1[0], v1[1]); w.w = cvt_pk_bf16(v1[2], v1[3]);
                    *(u32x4*)(rowp + bj * HALF) = w; } }
    }
};
struct EpiBranch {
    static constexpr bool PERM = true;
    bf16_t* O; int ldc; const bf16_t* proj; f32x4* t1wg;
    __device__ __forceinline__ void operator()(const f32x4 (&acc)[2][2][4][2], const Unit& u, int, int, int, int) const {
        int tz = threadIdx.x; asm volatile("" : "+v"(tz));
        const int wid = tz >> 6, lane = tz & 63, wr = wid >> 2, wc = wid & 3, fr = lane & 15, fq = lane >> 4;
        const int row0 = u.pm * BM + wr * 64 + fr, col0 = u.pn * BM + wc * 32 + 8 * fq;
        f32x4* const t1 = t1wg + tz;
        if (u.sub == 0) {
#pragma unroll
            for (int ai = 0; ai < 2; ++ai)
#pragma unroll
                for (int m = 0; m < 4; ++m) { const size_t row = (size_t)(row0 + ai * HALF + m * 16);
#pragma unroll
                    for (int bj = 0; bj < 2; ++bj) {
                        const u32x4 gw = *(const u32x4*)(proj + row * NIN + GA_OFF + col0 + bj * HALF);
                        f32x4 g0, g1; g0[0] = bf_lo(gw.x); g0[1] = bf_hi(gw.x); g0[2] = bf_lo(gw.y); g0[3] = bf_hi(gw.y); g1[0] = bf_lo(gw.z); g1[1] = bf_hi(gw.z); g1[2] = bf_lo(gw.w); g1[3] = bf_hi(gw.w);
                        f32x4* sp = t1 + (size_t)(((ai * 4 + m) * 2 + bj) * 2) * NTHREADS;
                        sp[0] = acc[ai][bj][m][0] * g0; sp[NTHREADS] = acc[ai][bj][m][1] * g1; }
                    asm volatile("" ::: "memory"); }
        } else {
#pragma unroll
            for (int ai = 0; ai < 2; ++ai)
#pragma unroll
                for (int m = 0; m < 4; ++m) { const size_t row = (size_t)(row0 + ai * HALF + m * 16);
#pragma unroll
                    for (int bj = 0; bj < 2; ++bj) {
                        const u32x4 gw = *(const u32x4*)(proj + row * NIN + GP_OFF + col0 + bj * HALF);
                        f32x4 g0, g1; g0[0] = bf_lo(gw.x); g0[1] = bf_hi(gw.x); g0[2] = bf_lo(gw.y); g0[3] = bf_hi(gw.y); g1[0] = bf_lo(gw.z); g1[1] = bf_hi(gw.z); g1[2] = bf_lo(gw.w); g1[3] = bf_hi(gw.w);
                        const f32x4* sp = t1 + (size_t)(((ai * 4 + m) * 2 + bj) * 2) * NTHREADS;
                        const f32x4 v0 = acc[ai][bj][m][0] * g0 + sp[0], v1 = acc[ai][bj][m][1] * g1 + sp[NTHREADS];
                        u32x4 w; w.x = cvt_pk_bf16(v0[0], v0[1]); w.y = cvt_pk_bf16(v0[2], v0[3]); w.z = cvt_pk_bf16(v1[0], v1[1]); w.w = cvt_pk_bf16(v1[2], v1[3]);
                        *(u32x4*)(O + row * ldc + col0 + bj * HALF) = w; }
                    asm volatile("" ::: "memory"); }
        }
    }
};

template <class Epi, class Sched, bool ALIGN_EPI, bool SP2>
__device__ __forceinline__ void gemm_phase(LAS unsigned char* lds, const int K, const Sched& S, const Epi& E) {
    int tid = threadIdx.x; asm volatile("" : "+v"(tid));
    const int wid = __builtin_amdgcn_readfirstlane(tid >> 6), lane = tid & 63, wr = wid >> 2, wc = wid & 3, fr = lane & 15, fq = lane >> 4;
    const int nt = K / BK;
    unsigned voffA[2], voffB[2];
#pragma unroll
    for (int i = 0; i < 2; ++i) { int R, C; stage_rc(tid * 16 + i * 8192, R, C);
        voffA[i] = (unsigned)(R * K + C) * 2u; voffB[i] = (unsigned)(tid * 16 + i * 8192); }
    const size_t kstep = (size_t)(BK * 2), kstepB = (size_t)HTB;
    const size_t hstep = (size_t)HALF * K * 2;
    const unsigned ldsw = (unsigned)wid * 1024u;
    const int aoff = lds_byte(wr * 64 + fr, fq * 8), boff = lds_byte(wc * 32 + fr, fq * 8);
#define PG8_SA(b, h) (((b) * 2 + (h)) * HTB)
#define PG8_SB(b, h) ((4 + (b) * 2 + (h)) * HTB)
#define PG8_STAGE(bufoff, gbase, voff) do { _Pragma("unroll") for (int _i = 0; _i < 2; ++_i) \
        __builtin_amdgcn_global_load_lds((const unsigned*)((const char*)(gbase) + (voff)[_i]), (LAS unsigned*)(lds + (bufoff) + ldsw + _i * 8192), 16, 0, 0); } while (0)
#define PG8_LDA(dst, b, h) do { _Pragma("unroll") for (int m = 0; m < 4; ++m) _Pragma("unroll") for (int k = 0; k < 2; ++k) dst[m][k] = *(const LAS bf16x8*)(lds + PG8_SA(b, h) + aoff + m * 2048 + k * 1024); } while (0)
#define PG8_LDB(dst, b, h) do { _Pragma("unroll") for (int n = 0; n < 2; ++n) _Pragma("unroll") for (int k = 0; k < 2; ++k) dst[n][k] = *(const LAS bf16x8*)(lds + PG8_SB(b, h) + boff + n * 2048 + k * 1024); } while (0)
#define PG8_MMA(ai, bj, At, Bt) do { __builtin_amdgcn_s_setprio(1); _Pragma("unroll") for (int m = 0; m < 4; ++m) _Pragma("unroll") for (int n = 0; n < 2; ++n) _Pragma("unroll") for (int k = 0; k < 2; ++k) \
        acc[ai][bj][m][n] = __builtin_amdgcn_mfma_f32_16x16x32_bf16(Bt[n][k], At[m][k], acc[ai][bj][m][n], 0, 0, 0); __builtin_amdgcn_s_setprio(0); } while (0)
#define PG8_WAIT_V(n) asm volatile("s_waitcnt vmcnt(" #n ")" ::: "memory")
#define PG8_WAIT_L(n) asm volatile("s_waitcnt lgkmcnt(" #n ")" ::: "memory")
#define PG8_BAR __builtin_amdgcn_s_barrier()
#define PG8_SCHED __builtin_amdgcn_sched_barrier(0)
    Unit cur, nxt; int ui = 0;
    if (!S.next(0, cur)) return;
    f32x4 acc[2][2][4][2];
#pragma unroll
    for (int a = 0; a < 2; ++a)
#pragma unroll
        for (int b = 0; b < 2; ++b)
#pragma unroll
            for (int m = 0; m < 4; ++m)
#pragma unroll
                for (int n = 0; n < 2; ++n) acc[a][b][m][n] = (f32x4){0.f, 0.f, 0.f, 0.f};
    bf16x8 At[4][2], B0[2][2], B1[2][2];
    const char* cA = S.aptr(cur); const char* cB = S.bptr(cur);
    if constexpr (SP2) {
        PG8_STAGE(PG8_SB(0, 0), cB, voffB); PG8_STAGE(PG8_SB(0, 1), cB + hstep, voffB); PG8_STAGE(PG8_SA(0, 0), cA, voffA); PG8_STAGE(PG8_SA(0, 1), cA + hstep, voffA);
        if (wr == 1) PG8_BAR;
        PG8_WAIT_V(2); PG8_BAR;
        PG8_STAGE(PG8_SB(1, 0), cB + kstepB, voffB); PG8_STAGE(PG8_SA(1, 0), cA + kstep, voffA); PG8_STAGE(PG8_SB(1, 1), cB + hstep + kstepB, voffB);
        PG8_WAIT_V(6); PG8_BAR;
    } else {
        PG8_STAGE(PG8_SB(0, 0), cB, voffB); PG8_STAGE(PG8_SA(0, 0), cA, voffA); PG8_STAGE(PG8_SB(0, 1), cB + hstep, voffB); PG8_STAGE(PG8_SA(0, 1), cA + hstep, voffA);
        if (wr == 1) PG8_BAR;
        PG8_WAIT_V(4); PG8_BAR;
        PG8_STAGE(PG8_SB(1, 0), cB + kstepB, voffB); PG8_STAGE(PG8_SA(1, 0), cA + kstep, voffA); PG8_STAGE(PG8_SB(1, 1), cB + hstep + kstepB, voffB);
        PG8_WAIT_V(6); PG8_BAR;
    }
    for (;;) {
        const bool has_next = S.next(ui + 1, nxt);
        const char* nA = has_next ? S.aptr(nxt) : cA; const char* nB = has_next ? S.bptr(nxt) : cB;
#pragma unroll 1
        for (int t = 0; t < nt; t += 2) {
            const bool last = (t == nt - 2);
            const char* a1 = cA + (size_t)(t + 1) * kstep;
            const char* a2 = last ? nA : cA + (size_t)(t + 2) * kstep; const char* b2 = last ? nB : cB + (size_t)(t + 2) * kstepB;
            const char* a3 = a2 + kstep; const char* b3 = b2 + kstepB;
            if constexpr (SP2) {
            PG8_LDB(B0, 0, 0); PG8_LDB(B1, 0, 1); PG8_SCHED; PG8_LDA(At, 0, 0); PG8_STAGE(PG8_SA(1, 1), a1 + hstep, voffA);
            PG8_WAIT_V(8); PG8_WAIT_L(0); PG8_BAR; PG8_MMA(0, 0, At, B0); PG8_MMA(0, 1, At, B1); PG8_BAR; PG8_SCHED;
            PG8_LDA(At, 0, 1); PG8_STAGE(PG8_SB(0, 0), b2, voffB); PG8_STAGE(PG8_SB(0, 1), b2 + hstep, voffB); PG8_STAGE(PG8_SA(0, 0), a2, voffA);
            PG8_WAIT_V(8); PG8_WAIT_L(0); PG8_BAR; PG8_MMA(1, 0, At, B0); PG8_MMA(1, 1, At, B1); PG8_BAR; PG8_SCHED;
            PG8_LDB(B0, 1, 0); PG8_LDB(B1, 1, 1); PG8_SCHED; PG8_LDA(At, 1, 0); PG8_STAGE(PG8_SA(0, 1), a2 + hstep, voffA);
            PG8_WAIT_V(8); PG8_WAIT_L(0); PG8_BAR; PG8_MMA(0, 0, At, B0); PG8_MMA(0, 1, At, B1); PG8_BAR; PG8_SCHED;
            PG8_LDA(At, 1, 1); PG8_STAGE(PG8_SB(1, 0), b3, voffB); PG8_STAGE(PG8_SB(1, 1), b3 + hstep, voffB); PG8_STAGE(PG8_SA(1, 0), a3, voffA);
            PG8_WAIT_V(8); PG8_WAIT_L(0); PG8_BAR; PG8_MMA(1, 0, At, B0); PG8_MMA(1, 1, At, B1); PG8_BAR; PG8_SCHED;
            } else {
            PG8_LDB(B0, 0, 0); PG8_SCHED; PG8_LDA(At, 0, 0); PG8_STAGE(PG8_SA(1, 1), a1 + hstep, voffA);
            PG8_WAIT_L(8); PG8_BAR; PG8_WAIT_L(0); PG8_MMA(0, 0, At, B0); PG8_BAR; PG8_SCHED;
            PG8_LDB(B1, 0, 1); PG8_STAGE(PG8_SB(0, 0), b2, voffB);
            PG8_BAR; PG8_WAIT_L(0); PG8_MMA(0, 1, At, B1); PG8_BAR;
            PG8_LDA(At, 0, 1); PG8_STAGE(PG8_SA(0, 0), a2, voffA);
            PG8_BAR; PG8_WAIT_L(0); PG8_MMA(1, 0, At, B0); PG8_BAR; PG8_SCHED;
            PG8_STAGE(PG8_SB(0, 1), b2 + hstep, voffB);
            PG8_WAIT_V(6); PG8_BAR; PG8_MMA(1, 1, At, B1); PG8_BAR;
            PG8_LDB(B0, 1, 0); PG8_SCHED; PG8_LDA(At, 1, 0); PG8_STAGE(PG8_SA(0, 1), a2 + hstep, voffA);
            PG8_WAIT_L(8); PG8_BAR; PG8_WAIT_L(0); PG8_MMA(0, 0, At, B0); PG8_BAR; PG8_SCHED;
            PG8_LDB(B1, 1, 1); PG8_STAGE(PG8_SB(1, 0), b3, voffB);
            PG8_BAR; PG8_WAIT_L(0); PG8_MMA(0, 1, At, B1); PG8_BAR;
            PG8_LDA(At, 1, 1); PG8_STAGE(PG8_SA(1, 0), a3, voffA);
            PG8_BAR; PG8_WAIT_L(0); PG8_MMA(1, 0, At, B0); PG8_BAR; PG8_SCHED;
            PG8_STAGE(PG8_SB(1, 1), b3 + hstep, voffB);
            PG8_WAIT_V(6); PG8_BAR; PG8_MMA(1, 1, At, B1); PG8_BAR;
            }
        }
        if constexpr (ALIGN_EPI) { if (wr == 0) PG8_BAR; }
        E(acc, cur, wr, wc, fr, fq);
        if (!has_next) break;
#pragma unroll
        for (int a = 0; a < 2; ++a)
#pragma unroll
            for (int b = 0; b < 2; ++b)
#pragma unroll
                for (int m = 0; m < 4; ++m)
#pragma unroll
                    for (int n = 0; n < 2; ++n) acc[a][b][m][n] = (f32x4){0.f, 0.f, 0.f, 0.f};
        cur = nxt; cA = nA; cB = nB; ++ui;
        if constexpr (ALIGN_EPI) { if (wr == 1) PG8_BAR; }
    }
    PG8_WAIT_V(0);
    if constexpr (!ALIGN_EPI) { if (wr == 0) PG8_BAR; }
    PG8_BAR;
#undef PG8_SA
#undef PG8_SB
#undef PG8_STAGE
#undef PG8_LDA
#undef PG8_LDB
#undef PG8_MMA
#undef PG8_WAIT_V
#undef PG8_WAIT_L
#undef PG8_BAR
#undef PG8_SCHED
}
}

#ifndef WGM_G
#define WGM_G 8
#endif
#ifndef WGM_D
#define WGM_D 4
#endif
#ifndef PG8_SP2
#define PG8_SP2 true
#endif
#ifndef PG8_ALIGN
#define PG8_ALIGN true
#endif

constexpr int RING_BYTES = 131072;
constexpr int LDS_BYTES = 147456;
constexpr int MISC_OFF = LDS_BYTES - 256;

struct Args {
    const float* x; const float* n1pre; const float* n1post; const float* w1g; const float* w1u; const float* w1d;
    const float* nmpre; const float* nmpost; const float* win; const float* poolw; const float* poolscale; const float* wab; const float* wpb; const float* wout;
    const float* n2pre; const float* n2post; const float* w2g; const float* w2u; const float* w2d;
    float* out; unsigned char* ws; int ph_lo, ph_hi;
};

__device__ __forceinline__ void transpose_item(const float* W, int K, int N, bf16_t* WT, int mode, LAS float* scr, int item, int lane) {
    const int nblk = N / 32, kb = item / nblk, nb = item % nblk, k0 = 64 * kb, n0 = 32 * nb;
    int drow = n0;
    if (mode == 1) drow = (n0 >> 7) * 256 + (n0 & 127);
    else if (mode == 2) drow = (n0 >> 7) * 256 + 128 + (n0 & 127);
#pragma unroll 8
    for (int i = 0; i < 32; ++i) { const int kk = 2 * i + (lane >> 5); scr[kk * 33 + (lane & 31)] = W[(size_t)(k0 + kk) * N + n0 + (lane & 31)]; }
    asm volatile("s_waitcnt lgkmcnt(0)" ::: "memory");
    const int c = lane & 7;
    unsigned char* blk = (unsigned char*)WT + ((size_t)(drow >> 7) * (K / 64) + kb) * 16384;
#pragma unroll
    for (int j = 0; j < 4; ++j) { const int n = (lane >> 3) + 8 * j; const LAS float* s = scr + (8 * c) * 33 + n;
        u32x4 o; o.x = cvt_pk_bf16(s[0 * 33], s[1 * 33]); o.y = cvt_pk_bf16(s[2 * 33], s[3 * 33]); o.z = cvt_pk_bf16(s[4 * 33], s[5 * 33]); o.w = cvt_pk_bf16(s[6 * 33], s[7 * 33]);
        const int slot = 16 * ((n >> 2) & 1) + 4 * (n >> 3) + (n & 3);
        *(u32x4*)(blk + pg8::lds_byte((drow & 127) + slot, 8 * c)) = o; }
    asm volatile("s_waitcnt lgkmcnt(0)" ::: "memory");
}

template <int SET> __device__ __forceinline__ void p0_weights(const Args& a, LAS unsigned char* lds, int gw, int NGW, int wave, int lane) {
    asm volatile("" : "+v"(lane));
    LAS float* scr = (LAS float*)(lds + wave * 16384);
    unsigned char* ws = a.ws;
    constexpr int I_GU = (D / 64) * (FF / 32), I_DN = (FF / 64) * (D / 32), I_IN = (D / 64) * (NIN / 32), I_OUT = (D / 64) * (D / 32), I_BR = (1024 / 64) * (D / 32), I_PL = (256 / 64) * (256 / 32);
    constexpr int NITEMS = SET == 0 ? 4 * I_GU + I_DN + I_OUT + 2 * I_BR + 4 * I_PL : (SET == 1 ? I_IN : I_DN);
    for (int it = gw; it < NITEMS; it += NGW) {
        int r = it; const float* W; int K, N, mode = 0; bf16_t* WT;
        if (SET == 1) { W = a.win; K = D; N = NIN; WT = (bf16_t*)(ws + WS_WIN); }
        else if (SET == 2) { W = a.w2d; K = FF; N = D; WT = (bf16_t*)(ws + WS_WD2); }
        else if (r < I_GU) { W = a.w1g; K = D; N = FF; WT = (bf16_t*)(ws + WS_WGU1); mode = 1; }
        else if ((r -= I_GU) < I_GU) { W = a.w1u; K = D; N = FF; WT = (bf16_t*)(ws + WS_WGU1); mode = 2; }
        else if ((r -= I_GU) < I_GU) { W = a.w2g; K = D; N = FF; WT = (bf16_t*)(ws + WS_WGU2); mode = 1; }
        else if ((r -= I_GU) < I_GU) { W = a.w2u; K = D; N = FF; WT = (bf16_t*)(ws + WS_WGU2); mode = 2; }
        else if ((r -= I_GU) < I_DN) { W = a.w1d; K = FF; N = D; WT = (bf16_t*)(ws + WS_WD1); }
        else if ((r -= I_DN) < I_OUT) { W = a.wout; K = D; N = D; WT = (bf16_t*)(ws + WS_WOUT); }
        else if ((r -= I_OUT) < I_BR) { W = a.wab; K = 1024; N = D; WT = (bf16_t*)(ws + WS_WBA); }
        else if ((r -= I_BR) < I_BR) { W = a.wpb; K = 1024; N = D; WT = (bf16_t*)(ws + WS_WBP); }
        else { r -= I_BR; const int g = r / I_PL; r -= g * I_PL; W = a.poolw + (size_t)g * 65536; K = 256; N = 256; WT = (bf16_t*)(ws + WS_WPL) + (size_t)g * 65536; }
        transpose_item(W, K, N, WT, mode, scr, r, lane);
    }
}

__device__ __forceinline__ void p0_norm(const float* x, const float* gain, bf16_t* xn, int gw, int NGW, int lane) {
    asm volatile("" : "+v"(lane));
    for (int m = gw; m < M; m += NGW) {
        const f32x4* xr = (const f32x4*)(x + (size_t)m * D) + lane; const f32x4* gr = (const f32x4*)gain + lane;
        f32x4 v[16]; float s = 0.f;
#pragma unroll
        for (int j = 0; j < 16; ++j) { v[j] = xr[64 * j]; s += (v[j][0] * v[j][0] + v[j][1] * v[j][1]) + (v[j][2] * v[j][2] + v[j][3] * v[j][3]); }
        const float rstd = 1.0f / sqrtf(wave_sum(s) * (1.0f / D) + RMS_EPS);
        u32x2* o = (u32x2*)(xn + (size_t)m * D) + lane;
#pragma unroll
        for (int j = 0; j < 16; ++j) { const f32x4 g = gr[64 * j]; u32x2 w; w.x = cvt_pk_bf16(v[j][0] * rstd * g[0], v[j][1] * rstd * g[1]); w.y = cvt_pk_bf16(v[j][2] * rstd * g[2], v[j][3] * rstd * g[3]); o[64 * j] = w; }
    }
}

__device__ __forceinline__ void norm_phase(LAS unsigned char* lds, const bf16_t* f, const float* base, float* hout, bf16_t* xn, const float* gpost, const float* gpre, float coef, int gw, int NGW, int tid) {
    asm volatile("" : "+v"(tid));
    const int lane = tid & 63;
    LAS f32x4* G1 = (LAS f32x4*)lds; LAS f32x4* G2 = (LAS f32x4*)(lds + 16384);
    for (int i = tid; i < D / 4; i += NTHREADS) { G1[i] = ((const f32x4*)gpost)[i]; if (xn) G2[i] = ((const f32x4*)gpre)[i]; }
    __syncthreads();
    for (int m = gw; m < M; m += NGW) {
        const u32x2* fr_ = (const u32x2*)(f + (size_t)m * D) + lane; const f32x4* br = (const f32x4*)(base + (size_t)m * D) + lane;
        u32x2 fw[16]; f32x4 v[16];
#pragma unroll
        for (int j = 0; j < 16; ++j) fw[j] = fr_[64 * j];
#pragma unroll
        for (int j = 0; j < 16; ++j) v[j] = br[64 * j];
        float s = 0.f;
#pragma unroll
        for (int j = 0; j < 16; ++j) { const float a0 = bf_lo(fw[j].x), a1 = bf_hi(fw[j].x), a2 = bf_lo(fw[j].y), a3 = bf_hi(fw[j].y); s += (a0 * a0 + a1 * a1) + (a2 * a2 + a3 * a3); }
        const float rstd = coef / sqrtf(wave_sum(s) * (1.0f / D) + RMS_EPS);
        float s2 = 0.f; f32x4* ho = (f32x4*)(hout + (size_t)m * D) + lane;
#pragma unroll
        for (int j = 0; j < 16; ++j) { const f32x4 g = G1[64 * j + lane]; f32x4 h;
            h[0] = v[j][0] + bf_lo(fw[j].x) * rstd * g[0]; h[1] = v[j][1] + bf_hi(fw[j].x) * rstd * g[1]; h[2] = v[j][2] + bf_lo(fw[j].y) * rstd * g[2]; h[3] = v[j][3] + bf_hi(fw[j].y) * rstd * g[3];
            v[j] = h; ho[64 * j] = h; s2 += (h[0] * h[0] + h[1] * h[1]) + (h[2] * h[2] + h[3] * h[3]); }
        if (xn) {
            const float r2 = 1.0f / sqrtf(wave_sum(s2) * (1.0f / D) + RMS_EPS);
            u32x2* o = (u32x2*)(xn + (size_t)m * D) + lane;
#pragma unroll
            for (int j = 0; j < 16; ++j) { const f32x4 g = G2[64 * j + lane]; u32x2 w; w.x = cvt_pk_bf16(v[j][0] * r2 * g[0], v[j][1] * r2 * g[1]); w.y = cvt_pk_bf16(v[j][2] * r2 * g[2], v[j][3] * r2 * g[3]); o[64 * j] = w; }
        }
    }
    __syncthreads();
}

template <int P> __device__ __forceinline__ void pool_delta_task(const bf16_t* proj, bf16_t* delta, int g, int mp, int lane) {
    const int m = 2 * mp + (lane >> 5), c = 8 * (lane & 31), t = m & (SEQ - 1);
    const bf16_t* zp = proj + (size_t)m * NIN + POOL_OFF + g * 256 + c;
    u32x4 w[P];
#pragma unroll
    for (int j = 0; j < P; ++j) w[j] = (j <= t) ? *(const u32x4*)(zp - (size_t)j * NIN) : (u32x4){0u, 0u, 0u, 0u};
    float s[8];
#pragma unroll
    for (int k = 0; k < 8; ++k) s[k] = 0.f;
#pragma unroll
    for (int j = 0; j < P; ++j) { s[0] += bf_lo(w[j].x); s[1] += bf_hi(w[j].x); s[2] += bf_lo(w[j].y); s[3] += bf_hi(w[j].y); s[4] += bf_lo(w[j].z); s[5] += bf_hi(w[j].z); s[6] += bf_lo(w[j].w); s[7] += bf_hi(w[j].w); }
    const int cnt = (t + 1) < P ? (t + 1) : P; const float ic = 1.0f / (float)cnt;
    u32x4 o; o.x = cvt_pk_bf16(s[0] * ic - bf_lo(w[0].x), s[1] * ic - bf_hi(w[0].x)); o.y = cvt_pk_bf16(s[2] * ic - bf_lo(w[0].y), s[3] * ic - bf_hi(w[0].y));
    o.z = cvt_pk_bf16(s[4] * ic - bf_lo(w[0].z), s[5] * ic - bf_hi(w[0].z)); o.w = cvt_pk_bf16(s[6] * ic - bf_lo(w[0].w), s[7] * ic - bf_hi(w[0].w));
    *(u32x4*)(delta + ((size_t)g * M + m) * 256 + c) = o;
}
__device__ __forceinline__ void pool_delta(const bf16_t* proj, bf16_t* delta, int gw, int NGW, int lane) {
    asm volatile("" : "+v"(lane));
    for (int task = gw; task < 2 * M; task += NGW) {
        const int g = task & 3, mp = task >> 2;
        if (g == 0) pool_delta_task<2>(proj, delta, 0, mp, lane);
        else if (g == 1) pool_delta_task<4>(proj, delta, 1, mp, lane);
        else if (g == 2) pool_delta_task<8>(proj, delta, 2, mp, lane);
        else pool_delta_task<16>(proj, delta, 3, mp, lane);
    }
}

namespace att {
__device__ __forceinline__ void attn_merge(const bf16_t* outg, const float* lse, bf16_t* attn, int gtid, int NT) {
    asm volatile("" : "+v"(gtid));
    for (int idx = gtid; idx < M * 128; idx += NT) {
        const int m = idx >> 7, c8 = (idx & 127) * 8, h = c8 >> 7;
        const float l0 = lse[(size_t)m * 8 + h], l1 = lse[((size_t)M + m) * 8 + h], l2 = lse[((size_t)2 * M + m) * 8 + h];
        const float mm = fmaxf(l0, fmaxf(l1, l2));
        float w0 = __expf(l0 - mm), w1 = __expf(l1 - mm), w2 = __expf(l2 - mm); const float inv = 1.0f / (w0 + w1 + w2); w0 *= inv; w1 *= inv; w2 *= inv;
        const u32x4 a = *(const u32x4*)(outg + (size_t)m * 1024 + c8), bq = *(const u32x4*)(outg + ((size_t)M + m) * 1024 + c8), c = *(const u32x4*)(outg + ((size_t)2 * M + m) * 1024 + c8);
        u32x4 o;
#pragma unroll
        for (int k = 0; k < 4; ++k) o[k] = cvt_pk_bf16(w0 * bf_lo(a[k]) + w1 * bf_lo(bq[k]) + w2 * bf_lo(c[k]), w0 * bf_hi(a[k]) + w1 * bf_hi(bq[k]) + w2 * bf_hi(c[k]));
        *(u32x4*)(attn + (size_t)m * 1024 + c8) = o;
    }
}
}


namespace att2 {
constexpr int VROW = 272, KBYTES = 32768, STG = KBYTES + 128 * VROW, N_UNITS = 3 * BATCH * 8 * 32;
static_assert(2 * STG <= MISC_OFF, "attention LDS");
struct Lane { int kR[2], kC[2]; unsigned ldsw; int koff, v_ch, v_kg, vcol, fr, fq, qbw, qi; };
struct UDec { const bf16_t* base; size_t rs; int qb, d, g, h, b, r; };
__device__ __forceinline__ UDec decode(const bf16_t* proj, int u) {
    UDec x; const int sub = u & 31; x.h = (u >> 5) & 7; x.b = (u >> 8) & 3; x.g = u >> 10;
    const int dsh = 2 * x.g, nbsh = 5 - dsh; x.d = 1 << dsh; x.qb = sub & ((1 << nbsh) - 1); x.r = sub >> nbsh;
    x.rs = (size_t)x.d * NIN; x.base = proj + ((size_t)x.b * SEQ + x.r) * NIN + x.g * 3072 + x.h * 128; return x;
}
__device__ __forceinline__ int first_half(int u) { const int g = u >> 10, nbsh = 5 - 2 * g; return ((u & 31) & ((1 << nbsh) - 1)) == 0 ? 1 : 0; }
template <int PAR> __device__ __forceinline__ void issue(LAS unsigned char* lds, const bf16_t* proj, int u, int half, const Lane& L, u32x4 (&vr)[4]) {
    const UDec x = decode(proj, u);
    const int i0 = 128 * x.qb - 128 * (1 - half);
    const bf16_t* kb = x.base + 1024 + (size_t)i0 * x.rs;
#pragma unroll
    for (int eh = 0; eh < 2; ++eh)
#pragma unroll
        for (int i = 0; i < 2; ++i)
            __builtin_amdgcn_global_load_lds((const unsigned*)(kb + 64 * eh + (size_t)L.kR[i] * x.rs + L.kC[i]), (LAS unsigned*)(lds + PAR * STG + eh * 16384 + L.ldsw + i * 8192), 16, 0, 0);
    const bf16_t* vp = x.base + 2048 + (size_t)(i0 + 4 * L.v_kg) * x.rs + 8 * L.v_ch;
#pragma unroll
    for (int c = 0; c < 4; ++c) vr[c] = *(const u32x4*)(vp + (size_t)c * x.rs);
}
template <int PAR> __device__ __forceinline__ void store_v(LAS unsigned char* lds, const Lane& L, const u32x4 (&vr)[4]) {
    LAS unsigned char* vdst = lds + PAR * STG + KBYTES + (8 * L.v_ch) * VROW + L.vcol;
#pragma unroll
    for (int wi = 0; wi < 4; ++wi) {
        u32x2 ev, od;
        ev.x = (vr[0][wi] & 0xffffu) | (vr[1][wi] << 16); ev.y = (vr[2][wi] & 0xffffu) | (vr[3][wi] << 16);
        od.x = (vr[0][wi] >> 16) | (vr[1][wi] & 0xffff0000u); od.y = (vr[2][wi] >> 16) | (vr[3][wi] & 0xffff0000u);
        *(LAS u32x2*)(vdst + (2 * wi) * VROW) = ev; *(LAS u32x2*)(vdst + (2 * wi + 1) * VROW) = od; }
}
__device__ __forceinline__ void load_q(const bf16_t* proj, int u, const Lane& L, bf16x8 (&q)[4]) {
    const UDec x = decode(proj, u);
    const bf16_t* qp = x.base + (size_t)(128 * x.qb + L.qi) * x.rs + 8 * L.fq;
#pragma unroll
    for (int ks = 0; ks < 4; ++ks) q[ks] = *(const bf16x8*)(qp + 32 * ks);
}
template <int PAR> __device__ __forceinline__ void compute(LAS unsigned char* lds, int u, int half, const Lane& L, const bf16x8 (&qf)[4], float& mrun, float& lrun, f32x4 (&o)[8]) {
    const int g = u >> 10, h = (u >> 5) & 7, d = 1 << (2 * g);
    const int qbw = L.qbw;
    f32x4 s[8];
#pragma unroll
    for (int kt = 0; kt < 8; ++kt) {
        const bool act = half ? (kt <= qbw) : (kt >= qbw);
        s[kt] = (f32x4){0.f, 0.f, 0.f, 0.f};
        if (act) {
#pragma unroll
            for (int ks = 0; ks < 4; ++ks) { const bf16x8 kf = *(const LAS bf16x8*)(lds + PAR * STG + (ks >> 1) * 16384 + L.koff + kt * 2048 + (ks & 1) * 1024);
                s[kt] = __builtin_amdgcn_mfma_f32_16x16x32_bf16(kf, qf[ks], s[kt], 0, 0, 0); } }
    }
    const float slope = (g < 2) ? exp2f(-0.25f * (float)(g * 8 + h + 1)) : exp2f(-(4.5f + 0.5f * (float)h));
    const float sld = slope * (float)d;
    int bi = L.qi + 128 * (1 - half) - 4 * L.fq; asm volatile("" : "+v"(bi));
    const float c0 = -sld * (float)bi;
    float mloc = -1e30f;
#pragma unroll
    for (int kt = 0; kt < 8; ++kt)
#pragma unroll
        for (int j = 0; j < 4; ++j) { const int kc = 16 * kt + j;
            const bool valid = (kc <= bi) && (kc >= bi - 128);
            float v = s[kt][j] * 0.08838834764831845f + (c0 + sld * (float)kc); v = valid ? v : -1e30f; s[kt][j] = v; mloc = fmaxf(mloc, v); }
    mloc = fmaxf(mloc, __shfl_xor(mloc, 16)); mloc = fmaxf(mloc, __shfl_xor(mloc, 32));
    const float mnew = fmaxf(mrun, mloc), alpha = __expf(mrun - mnew);
    float lsum = 0.f;
#pragma unroll
    for (int kt = 0; kt < 8; ++kt)
#pragma unroll
        for (int j = 0; j < 4; ++j) { const float p = __expf(s[kt][j] - mnew); s[kt][j] = p; lsum += p; }
    lrun = lrun * alpha + lsum; mrun = mnew;
#pragma unroll
    for (int et = 0; et < 8; ++et) o[et] = o[et] * alpha;
#pragma unroll
    for (int ss = 0; ss < 4; ++ss) {
        const bool act = half ? (2 * ss <= qbw) : (2 * ss + 1 >= qbw);
        if (act) {
            u32x4 pw; pw.x = cvt_pk_bf16(s[2 * ss][0], s[2 * ss][1]); pw.y = cvt_pk_bf16(s[2 * ss][2], s[2 * ss][3]); pw.z = cvt_pk_bf16(s[2 * ss + 1][0], s[2 * ss + 1][1]); pw.w = cvt_pk_bf16(s[2 * ss + 1][2], s[2 * ss + 1][3]);
            const bf16x8 pf = __builtin_bit_cast(bf16x8, pw);
#pragma unroll
            for (int et = 0; et < 8; ++et) { const bf16x8 vf = *(const LAS bf16x8*)(lds + PAR * STG + KBYTES + (16 * et + L.fr) * VROW + 64 * ss + 16 * L.fq);
                o[et] = __builtin_amdgcn_mfma_f32_16x16x32_bf16(vf, pf, o[et], 0, 0, 0); } }
    }
}
__device__ __forceinline__ void finalize(const bf16_t* proj, int u, const Lane& L, float mrun, float lrun, const f32x4 (&o)[8], bf16_t* outg, float* lse) {
    const UDec x = decode(proj, u);
    float l = lrun; l += __shfl_xor(l, 16); l += __shfl_xor(l, 32);
    const float inv = 1.0f / l;
    const size_t mrow = (size_t)x.g * M + (size_t)x.b * SEQ + (size_t)(128 * x.qb + L.qi) * x.d + x.r;
    bf16_t* op = outg + mrow * 1024 + x.h * 128 + 4 * L.fq;
#pragma unroll
    for (int et = 0; et < 8; ++et) { u32x2 w; w.x = cvt_pk_bf16(o[et][0] * inv, o[et][1] * inv); w.y = cvt_pk_bf16(o[et][2] * inv, o[et][3] * inv); *(u32x2*)(op + 16 * et) = w; }
    if (L.fq == 0) lse[mrow * 8 + x.h] = mrun + __logf(l);
}
template <int PAR> __device__ __forceinline__ bool step(LAS unsigned char* lds, const bf16_t* proj, bf16_t* outg, float* lse, int G, const Lane& L, int& u, int& half, bf16x8 (&qf)[4], float& mrun, float& lrun, f32x4 (&o)[8]) {
    int nu, nh; if (half == 0) { nu = u; nh = 1; } else { nu = u + G; nh = nu < N_UNITS ? first_half(nu) : 0; }
    const bool has_next = nu < N_UNITS, new_unit = has_next && (nu != u);
    u32x4 vr[4]; bf16x8 qn[4];
    if (has_next) issue<PAR ^ 1>(lds, proj, nu, nh, L, vr);
    if (new_unit) load_q(proj, nu, L, qn);
    __builtin_amdgcn_sched_barrier(0);
    compute<PAR>(lds, u, half, L, qf, mrun, lrun, o);
    if (half == 1) { finalize(proj, u, L, mrun, lrun, o, outg, lse); mrun = -1e30f; lrun = 0.f;
#pragma unroll
        for (int et = 0; et < 8; ++et) o[et] = (f32x4){0.f, 0.f, 0.f, 0.f}; }
    __builtin_amdgcn_sched_barrier(0);
    if (has_next) store_v<PAR ^ 1>(lds, L, vr);
    if (new_unit) {
#pragma unroll
        for (int ks = 0; ks < 4; ++ks) qf[ks] = qn[ks]; }
    __builtin_amdgcn_s_waitcnt(0); asm volatile("" ::: "memory"); __builtin_amdgcn_s_barrier(); asm volatile("" ::: "memory");
    u = nu; half = nh;
    return has_next;
}
__device__ __forceinline__ void attn_phase(LAS unsigned char* lds, const bf16_t* proj, bf16_t* outg, float* lse, int vcu, int G) {
    int tid = threadIdx.x; asm volatile("" : "+v"(tid));
    const int lane = tid & 63, wid = __builtin_amdgcn_readfirstlane(tid >> 6);
    Lane L;
#pragma unroll
    for (int i = 0; i < 2; ++i) pg8::stage_rc(tid * 16 + i * 8192, L.kR[i], L.kC[i]);
    L.fr = lane & 15; L.fq = lane >> 4; L.ldsw = (unsigned)wid * 1024u; L.koff = pg8::lds_byte(L.fr, L.fq * 8);
    L.v_ch = (lane & 3) + 4 * ((lane >> 4) & 3); L.v_kg = ((lane >> 2) & 3) + 4 * wid;
    L.vcol = 64 * (wid >> 1) + 16 * ((lane >> 2) & 3) + 8 * (wid & 1);
    L.qbw = wid < 4 ? wid : 11 - wid; L.qi = 16 * L.qbw + L.fr;
    int u = vcu; if (u >= N_UNITS) return;
    int half = first_half(u);
    bf16x8 qf[4]; f32x4 o[8]; float mrun = -1e30f, lrun = 0.f;
#pragma unroll
    for (int et = 0; et < 8; ++et) o[et] = (f32x4){0.f, 0.f, 0.f, 0.f};
    { u32x4 vr[4]; issue<0>(lds, proj, u, half, L, vr); load_q(proj, u, L, qf); store_v<0>(lds, L, vr); }
    __builtin_amdgcn_s_waitcnt(0); asm volatile("" ::: "memory"); __builtin_amdgcn_s_barrier(); asm volatile("" ::: "memory");
    for (;;) {
        if (!step<0>(lds, proj, outg, lse, G, L, u, half, qf, mrun, lrun, o)) break;
        if (!step<1>(lds, proj, outg, lse, G, L, u, half, qf, mrun, lrun, o)) break;
    }
}
}

constexpr int NPHASE = 13;
__global__ void __launch_bounds__(NTHREADS, 2) mk_fwd(Args a) {
    extern __shared__ __attribute__((aligned(16))) unsigned char lds_raw[];
    LAS unsigned char* lds = (LAS unsigned char*)lds_raw;
    const int tid = threadIdx.x, lane = tid & 63, wave = __builtin_amdgcn_readfirstlane(tid >> 6);
    const int G = gridDim.x, bx = blockIdx.x;
    const int vcu = (G % 8 == 0) ? (bx % 8) * (G / 8) + bx / 8 : bx;
    const int gw = vcu * NWAVES + wave, NGW = G * NWAVES;
    unsigned char* ws = a.ws;
    unsigned* ctl = (unsigned*)(ws + WS_CTL);
    volatile LAS unsigned* MISC = (volatile LAS unsigned*)(lds + MISC_OFF);
    if (tid < 32) MISC[tid] = 0u;
    __syncthreads();
    XcdBarrier bar; bar.bar = ctl + CW_BAR; bar.x = 0; bar.st = nullptr;
    if (MK_ONE_LAUNCH) bar = xcd_barrier_post(ctl + CW_BAR, MISC + 8);
    const int lo = a.ph_lo, hi = a.ph_hi;
#ifdef DBG_ONLY
#define IN(k) ((k) == DBG_ONLY && lo <= (k) && (k) < hi)
#else
#define IN(k) (lo <= (k) && (k) < hi)
#endif
#define SEAM(k) do { if (MK_ONE_LAUNCH && IN(k) && IN((k) + 1)) xcd_barrier(bar); } while (0)

    bf16_t* XN = (bf16_t*)(ws + WS_XN); bf16_t* ACT = (bf16_t*)(ws + WS_ACT); bf16_t* Fb = (bf16_t*)(ws + WS_F); bf16_t* PROJ = (bf16_t*)(ws + WS_PROJ);
    bf16_t* ATT = (bf16_t*)(ws + WS_ATTN); bf16_t* DELTA = (bf16_t*)(ws + WS_DELTA); bf16_t* POOLED = (bf16_t*)(ws + WS_POOLED); bf16_t* MERGED = XN;

    const bool tail_cvt = (G == 256);
    if (IN(0)) { p0_weights<0>(a, lds, gw, NGW, wave, lane);
        if (!tail_cvt) { p0_weights<1>(a, lds, gw, NGW, wave, lane); p0_weights<2>(a, lds, gw, NGW, wave, lane); }
        p0_norm(a.x, a.n1pre, XN, gw, NGW, lane); }
    SEAM(0);
    if (IN(1)) { pg8::PlainSched S; S.T.init(M, 2 * FF, G, bx, WGM_G); S.A = (const char*)XN; S.B = (const char*)(ws + WS_WGU1); S.tstep = (size_t)256 * D * 2;
        pg8::EpiSwiGLU E{ACT, FF};
        pg8::gemm_phase<pg8::EpiSwiGLU, pg8::PlainSched, PG8_ALIGN, PG8_SP2>(lds, D, S, E);
        if (tail_cvt && bx >= 128) p0_weights<1>(a, lds, (bx - 128) * NWAVES + wave, 128 * NWAVES, wave, lane); }
    SEAM(1);
    if (IN(2)) { pg8::PlainSched S; S.T.init(M, D, G, bx, WGM_D); S.A = (const char*)ACT; S.B = (const char*)(ws + WS_WD1); S.tstep = (size_t)256 * FF * 2;
        pg8::EpiBf16 E{Fb, D};
        pg8::gemm_phase<pg8::EpiBf16, pg8::PlainSched, PG8_ALIGN, PG8_SP2>(lds, FF, S, E); }
    SEAM(2);
    if (IN(3)) norm_phase(lds, Fb, a.x, a.out, XN, a.n1post, a.nmpre, 0.5f, gw, NGW, tid);
    SEAM(3);
    if (IN(4)) { pg8::PlainSched S; S.T.init(M, NIN, G, bx, WGM_G); S.A = (const char*)XN; S.B = (const char*)(ws + WS_WIN); S.tstep = (size_t)256 * D * 2;
        pg8::EpiBf16Sig E{PROJ, NIN, GA_OFF / 256};
        pg8::gemm_phase<pg8::EpiBf16Sig, pg8::PlainSched, PG8_ALIGN, PG8_SP2>(lds, D, S, E); }
    SEAM(4);
    if (IN(5)) { att2::attn_phase(lds, PROJ, (bf16_t*)(ws + WS_OUTG), (float*)(ws + WS_LSE), vcu, G); pool_delta(PROJ, DELTA, gw, NGW, lane); }
    SEAM(5);
    if (IN(6)) { att::attn_merge((const bf16_t*)(ws + WS_OUTG), (const float*)(ws + WS_LSE), ATT, vcu * NTHREADS + tid, G * NTHREADS);
        pg8::PoolSched S; S.T.init(M, 1024, G, bx); S.A = (const char*)DELTA; S.B = (const char*)(ws + WS_WPL); S.tstep = (size_t)256 * 256 * 2; S.gstride = (size_t)M * 256 * 2;
        pg8::EpiPool E{POOLED, 1024, a.poolscale};
        pg8::gemm_phase<pg8::EpiPool, pg8::PoolSched, PG8_ALIGN, PG8_SP2>(lds, 256, S, E); }
    SEAM(6);
    if (IN(7)) { pg8::BranchSched S; S.T.init(M, D, G, bx); S.A0 = (const char*)ATT; S.B0 = (const char*)(ws + WS_WBA); S.A1 = (const char*)POOLED; S.B1 = (const char*)(ws + WS_WBP); S.tstep = (size_t)256 * 1024 * 2;
        pg8::EpiBranch E{MERGED, D, PROJ, (f32x4*)(ws + WS_T1) + (size_t)bx * (32 * NTHREADS)};
        pg8::gemm_phase<pg8::EpiBranch, pg8::BranchSched, PG8_ALIGN, PG8_SP2>(lds, 1024, S, E); }
    SEAM(7);
    if (IN(8)) { pg8::PlainSched S; S.T.init(M, D, G, bx); S.A = (const char*)MERGED; S.B = (const char*)(ws + WS_WOUT); S.tstep = (size_t)256 * D * 2;
        pg8::EpiBf16 E{Fb, D};
        pg8::gemm_phase<pg8::EpiBf16, pg8::PlainSched, PG8_ALIGN, PG8_SP2>(lds, D, S, E); }
    SEAM(8);
    if (IN(9)) norm_phase(lds, Fb, a.out, a.out, XN, a.nmpost, a.n2pre, 1.0f, gw, NGW, tid);
    SEAM(9);
    if (IN(10)) { pg8::PlainSched S; S.T.init(M, 2 * FF, G, bx, WGM_G); S.A = (const char*)XN; S.B = (const char*)(ws + WS_WGU2); S.tstep = (size_t)256 * D * 2;
        pg8::EpiSwiGLU E{ACT, FF};
        pg8::gemm_phase<pg8::EpiSwiGLU, pg8::PlainSched, PG8_ALIGN, PG8_SP2>(lds, D, S, E);
        if (tail_cvt && bx >= 128) p0_weights<2>(a, lds, (bx - 128) * NWAVES + wave, 128 * NWAVES, wave, lane); }
    SEAM(10);
    if (IN(11)) { pg8::PlainSched S; S.T.init(M, D, G, bx, WGM_D); S.A = (const char*)ACT; S.B = (const char*)(ws + WS_WD2); S.tstep = (size_t)256 * FF * 2;
        pg8::EpiBf16 E{Fb, D};
        pg8::gemm_phase<pg8::EpiBf16, pg8::PlainSched, PG8_ALIGN, PG8_SP2>(lds, FF, S, E); }
    SEAM(11);
    if (IN(12)) norm_phase(lds, Fb, a.out, a.out, nullptr, a.n2post, nullptr, 0.5f, gw, NGW, tid);
#undef IN
#undef SEAM
}

extern "C" void kernel_launch(void* const* d_in, const int* in_sizes, int n_in, void* d_out, int out_size, void* d_ws, size_t ws_size, hipStream_t stream) {
    static int grid = 0;
    if (grid == 0) {
        if (n_in != 19 || in_sizes[0] != M * D || out_size != M * D || ws_size < WS_END) { fprintf(stderr, "kernel_launch: unexpected shapes (n_in %d, in0 %d, out %d, ws %zu < %zu)\n", n_in, n_in > 0 ? in_sizes[0] : -1, out_size, ws_size, (size_t)WS_END); grid = -1; return; }
        int dev = 0, cus = 0, per_cu = 0;
        if (hipGetDevice(&dev) != hipSuccess || hipDeviceGetAttribute(&cus, hipDeviceAttributeMultiprocessorCount, dev) != hipSuccess) { grid = -1; return; }
        if (hipFuncSetAttribute((const void*)mk_fwd, hipFuncAttributeMaxDynamicSharedMemorySize, LDS_BYTES) != hipSuccess) { fprintf(stderr, "kernel_launch: hipFuncSetAttribute failed\n"); grid = -1; return; }
        if (hipOccupancyMaxActiveBlocksPerMultiprocessor(&per_cu, (const void*)mk_fwd, NTHREADS, LDS_BYTES) != hipSuccess || per_cu < 1) { fprintf(stderr, "kernel_launch: occupancy query says %d\n", per_cu); }
        (void)hipGetLastError();
        grid = cus;
    }
    if (grid < 0) return;
    (void)hipMemsetAsync((char*)d_ws + WS_CTL, 0, CTL_ZERO_BYTES, stream);
    Args a{};
    a.x = (const float*)d_in[0]; a.n1pre = (const float*)d_in[1]; a.n1post = (const float*)d_in[2]; a.w1g = (const float*)d_in[3]; a.w1u = (const float*)d_in[4]; a.w1d = (const float*)d_in[5];
    a.nmpre = (const float*)d_in[6]; a.nmpost = (const float*)d_in[7]; a.win = (const float*)d_in[8]; a.poolw = (const float*)d_in[9]; a.poolscale = (const float*)d_in[10];
    a.wab = (const float*)d_in[11]; a.wpb = (const float*)d_in[12]; a.wout = (const float*)d_in[13];
    a.n2pre = (const float*)d_in[14]; a.n2post = (const float*)d_in[15]; a.w2g = (const float*)d_in[16]; a.w2u = (const float*)d_in[17]; a.w2d = (const float*)d_in[18];
    a.out = (float*)d_out; a.ws = (unsigned char*)d_ws;
#if MK_ONE_LAUNCH
    a.ph_lo = 0; a.ph_hi = NPHASE;
    hipLaunchKernelGGL(mk_fwd, dim3(grid), dim3(NTHREADS), LDS_BYTES, stream, a);
#else
    for (int p = 0; p < NPHASE; ++p) { a.ph_lo = p; a.ph_hi = p + 1; hipLaunchKernelGGL(mk_fwd, dim3(grid), dim3(NTHREADS), LDS_BYTES, stream, a); }
#endif
}
```

```cpp
#include <hip/hip_runtime.h>
#include <cstdio>
#include <cstdint>

#ifndef MK_ONE_LAUNCH
#define MK_ONE_LAUNCH 1
#endif

#define LAS __attribute__((address_space(3)))
#define GAS __attribute__((address_space(1)))
typedef unsigned short bf16_t;
typedef short bf16x8 __attribute__((ext_vector_type(8)));
typedef float f32x4 __attribute__((ext_vector_type(4)));
typedef float f32x2 __attribute__((ext_vector_type(2)));
typedef unsigned u32x4 __attribute__((ext_vector_type(4)));
typedef unsigned u32x2 __attribute__((ext_vector_type(2)));

constexpr int BATCH = 4, SEQ = 4096, M = BATCH * SEQ, D = 4096, FF = 11008, NIN = 18432;
constexpr int POOL_OFF = 9216, GA_OFF = 10240, GP_OFF = 14336;
constexpr float RMS_EPS = 1e-6f;
constexpr int NWAVES = 8, NTHREADS = 512;

constexpr size_t MiB = (size_t)1 << 20;
constexpr size_t WS_CTL = 0, CTL_ZERO_BYTES = 1 * MiB;
constexpr size_t WS_WGU1 = 1 * MiB;
constexpr size_t WS_WD1 = 173 * MiB;
constexpr size_t WS_WIN = 259 * MiB;
constexpr size_t WS_WOUT = 403 * MiB;
constexpr size_t WS_WBA = 435 * MiB;
constexpr size_t WS_WBP = 443 * MiB;
constexpr size_t WS_WPL = 451 * MiB;
constexpr size_t WS_WGU2 = 452 * MiB;
constexpr size_t WS_WD2 = 624 * MiB;
constexpr size_t WS_XN = 710 * MiB;
constexpr size_t WS_ACT = 838 * MiB;
constexpr size_t WS_F = 1182 * MiB;
constexpr size_t WS_PROJ = 838 * MiB;
constexpr size_t WS_ATTN = 1438 * MiB;
constexpr size_t WS_DELTA = 1470 * MiB;
constexpr size_t WS_POOLED = 1502 * MiB;
constexpr size_t WS_T1 = 1534 * MiB;
constexpr size_t WS_OUTG = WS_XN;
constexpr size_t WS_LSE = WS_XN + 96 * MiB;
constexpr size_t WS_END = 1598 * MiB;
static_assert(WS_PROJ + (size_t)M * NIN * 2 <= WS_ATTN, "proj overlay");
constexpr int CW_BAR = 4096;

__device__ __forceinline__ unsigned cvt_pk_bf16(float lo, float hi) { unsigned r; asm volatile("v_cvt_pk_bf16_f32 %0, %1, %2" : "=v"(r) : "v"(lo), "v"(hi)); return r; }
__device__ __forceinline__ float bf_lo(unsigned w) { return __uint_as_float(w << 16); }
__device__ __forceinline__ float bf_hi(unsigned w) { return __uint_as_float(w & 0xffff0000u); }
__device__ __forceinline__ float wave_sum(float v) {
#pragma unroll
    for (int o = 1; o < 64; o <<= 1) v += __shfl_xor(v, o);
    return v;
}
__device__ __forceinline__ float fast_sigmoid(float x) { return __builtin_amdgcn_rcpf(1.0f + __builtin_amdgcn_exp2f(-1.4426950408889634f * x)); }

#define XB_TMO      128
#define XB_XCNT(j)  (256  + 64 * (j))
#define XB_XSUB(j)  (1280 + 64 * (j))
#define XB_XGEN(j)  (2304 + 64 * (j))
#define XB_TOP      3328
#define XB_TOPGEN   3392
#define XCD_BAR_WORDS 3456
#define XB_SPIN_CAP (1u << 18)

__device__ __forceinline__ unsigned xb_ld(unsigned* p)              { return __hip_atomic_load(p, __ATOMIC_RELAXED, __HIP_MEMORY_SCOPE_AGENT); }
__device__ __forceinline__ unsigned xb_add(unsigned* p, unsigned v) { return __hip_atomic_fetch_add(p, v, __ATOMIC_RELAXED, __HIP_MEMORY_SCOPE_AGENT); }
__device__ __forceinline__ unsigned xb_xcc_id() { return (unsigned)__builtin_amdgcn_s_getreg((3 << 11) | 20) & 0xFu; }
#define XB_SPIN(cond, bar) do { unsigned _sp = 0; while (cond) { __builtin_amdgcn_s_sleep(1); \
    if ((++_sp & 255u) == 0u) { if (xb_ld(&(bar)[XB_TMO])) break; if (_sp > XB_SPIN_CAP) { atomicAdd(&(bar)[XB_TMO], 1u); break; } } } } while (0)

struct XcdBarrier { unsigned* bar; unsigned x; volatile LAS unsigned* st; };

__device__ __forceinline__ XcdBarrier xcd_barrier_post(unsigned* bar, volatile LAS unsigned* st) {
    XcdBarrier b; b.bar = bar; b.x = xb_xcc_id(); b.st = st;
    if (threadIdx.x == 0) (void)xb_add(&bar[XB_XCNT(b.x)], 1u);
    return b;
}
__device__ __forceinline__ void xcd_barrier_complete(unsigned* bar, unsigned x, unsigned& nloc, unsigned& nx) {
    const unsigned G = gridDim.x * gridDim.y * gridDim.z;
    unsigned sum, cnt, mine, sp = 0u;
    for (;;) {
        sum = 0u; cnt = 0u; mine = 0u;
#pragma unroll
        for (unsigned j = 0; j < 16; ++j) { const unsigned c = xb_ld(&bar[XB_XCNT(j)]); sum += c; cnt += (c > 0u) ? 1u : 0u; mine = (j == x) ? c : mine; }
        if (sum == G) break;
        __builtin_amdgcn_s_sleep(1);
        if ((++sp & 255u) == 0u) { if (xb_ld(&bar[XB_TMO])) break; if (sp > XB_SPIN_CAP) { atomicAdd(&bar[XB_TMO], 1u); break; } }
    }
    nloc = mine > 0u ? mine : 1u; nx = cnt > 0u ? cnt : 1u;
}
__device__ __forceinline__ void xcd_barrier(const XcdBarrier& b) {
    asm volatile("s_waitcnt vmcnt(0)" ::: "memory");
    __syncthreads();
    if (threadIdx.x == 0) {
        unsigned* bar = b.bar;
        __builtin_amdgcn_s_waitcnt(0);
        unsigned nloc = b.st[0], nx = b.st[1];
        if (nloc == 0u) { xcd_barrier_complete(bar, b.x, nloc, nx); b.st[0] = nloc; b.st[1] = nx; }
        const unsigned old = xb_add(&bar[XB_XSUB(b.x)], 1u);
        const unsigned gen = old / nloc;
        if (old + 1u == (gen + 1u) * nloc) {
            __builtin_amdgcn_fence(__ATOMIC_RELEASE, "agent");
            asm volatile("s_waitcnt vmcnt(0)" ::: "memory");
            const unsigned og = xb_add(&bar[XB_TOP], 1u);
            const unsigned tg = og / nx;
            if (og + 1u == (tg + 1u) * nx) xb_add(&bar[XB_TOPGEN], 1u);
            else XB_SPIN(xb_ld(&bar[XB_TOPGEN]) == tg, bar);
            __builtin_amdgcn_fence(__ATOMIC_ACQUIRE, "agent");
            xb_add(&bar[XB_XGEN(b.x)], 1u);
            asm volatile("s_waitcnt vmcnt(0)" ::: "memory");
        } else {
            XB_SPIN(xb_ld(&bar[XB_XGEN(b.x)]) == gen, bar);
            __builtin_amdgcn_fence(__ATOMIC_ACQUIRE, "agent");
            asm volatile("s_waitcnt vmcnt(0)" ::: "memory");
        }
    }
    __syncthreads();
}

namespace pg8 {
constexpr int BM = 256, BK = 64, HALF = 128, HTB = HALF * BK * 2, STAGE_BYTES = 8 * HTB, NXCD = 8, WGM = 8;
__host__ __device__ __forceinline__ int lds_byte(int r, int c) { const int st = (r >> 4) * 2 + (c >> 5), rr = r & 15, cc = c & 31, ob = rr * 64 + cc * 2; return st * 1024 + (ob ^ (((ob >> 9) & 1) << 5)); }
__host__ __device__ __forceinline__ void stage_rc(int b, int& R, int& C) { const int st = b / 1024, sb = b % 1024, swz = sb ^ (((sb >> 9) & 1) << 5); R = (st >> 1) * 16 + swz / 64; C = (st & 1) * 32 + (swz % 64) / 2; }
__host__ __device__ __forceinline__ int perm32(int rho) { const int n = rho >> 4, i = rho & 15; return 8 * (i >> 2) + 4 * n + (i & 3); }

struct Unit { int pm, pn, sub; };
struct TileOrder {
    int nM, nN, nwg, G, c, wgm;
    __device__ __forceinline__ void init(int Mr, int Nc, int G_, int c_, int wgm_ = WGM) { nM = Mr / BM; nN = Nc / BM; nwg = nM * nN; G = G_; c = c_; wgm = wgm_; }
    __device__ __forceinline__ bool at(long L, int& pm, int& pn) const {
        if (L >= nwg) return false;
        int wgid = (int)L; { const int q = nwg / NXCD, r = nwg % NXCD, xcd = wgid % NXCD, off = wgid / NXCD; wgid = (xcd < r ? xcd * (q + 1) : r * (q + 1) + (xcd - r) * q) + off; }
        const int nig = wgm * nN, gid = wgid / nig, fm = gid * wgm, gsz = (nM - fm) < wgm ? (nM - fm) : wgm;
        pm = fm + ((wgid % nig) % gsz); pn = (wgid % nig) / gsz; return true;
    }
};
struct PlainSched {
    TileOrder T; const char* A; const char* B; size_t tstep;
    __device__ __forceinline__ bool next(int i, Unit& u) const { u.sub = 0; return T.at((long)i * T.G + T.c, u.pm, u.pn); }
    __device__ __forceinline__ const char* aptr(const Unit& u) const { return A + (size_t)u.pm * tstep; }
    __device__ __forceinline__ const char* bptr(const Unit& u) const { return B + (size_t)u.pn * tstep; }
};
struct BranchSched {
    TileOrder T; const char* A0; const char* B0; const char* A1; const char* B1; size_t tstep;
    __device__ __forceinline__ bool next(int i, Unit& u) const { u.sub = i & 1; return T.at((long)(i >> 1) * T.G + T.c, u.pm, u.pn); }
    __device__ __forceinline__ const char* aptr(const Unit& u) const { return (u.sub ? A1 : A0) + (size_t)u.pm * tstep; }
    __device__ __forceinline__ const char* bptr(const Unit& u) const { return (u.sub ? B1 : B0) + (size_t)u.pn * tstep; }
};
struct PoolSched {
    TileOrder T; const char* A; const char* B; size_t tstep, gstride;
    __device__ __forceinline__ bool next(int i, Unit& u) const { u.sub = 0; return T.at((long)i * T.G + T.c, u.pm, u.pn); }
    __device__ __forceinline__ const char* aptr(const Unit& u) const { return A + (size_t)u.pn * gstride + (size_t)u.pm * tstep; }
    __device__ __forceinline__ const char* bptr(const Unit& u) const { return B + (size_t)u.pn * tstep; }
};

struct EpiSwiGLU {
    static constexpr bool PERM = true, KEEP_SUB0 = false;
    bf16_t* O; int ldc;
    __device__ __forceinline__ void operator()(const f32x4 (&acc)[2][2][4][2], const Unit& u, int wr, int wc, int fr, int fq) const {
        const int row0 = u.pm * BM + wr * 64 + fr, col0 = u.pn * HALF + wc * 32 + 8 * fq;
#pragma unroll
        for (int ai = 0; ai < 2; ++ai)
#pragma unroll
            for (int m = 0; m < 4; ++m) { bf16_t* rowp = O + (size_t)(row0 + ai * HALF + m * 16) * ldc + col0;
                float o[8];
#pragma unroll
                for (int n = 0; n < 2; ++n)
#pragma unroll
                    for (int j = 0; j < 4; ++j) { const float g = acc[ai][0][m][n][j], uu = acc[ai][1][m][n][j]; o[n * 4 + j] = g * fast_sigmoid(g) * uu; }
                u32x4 w; w.x = cvt_pk_bf16(o[0], o[1]); w.y = cvt_pk_bf16(o[2], o[3]); w.z = cvt_pk_bf16(o[4], o[5]); w.w = cvt_pk_bf16(o[6], o[7]);
                *(u32x4*)rowp = w; }
    }
};
struct EpiBf16 {
    static constexpr bool PERM = true, KEEP_SUB0 = false;
    bf16_t* O; int ldc;
    __device__ __forceinline__ void operator()(const f32x4 (&acc)[2][2][4][2], const Unit& u, int wr, int wc, int fr, int fq) const {
        const int row0 = u.pm * BM + wr * 64 + fr, col0 = u.pn * BM + wc * 32 + 8 * fq;
#pragma unroll
        for (int ai = 0; ai < 2; ++ai)
#pragma unroll
            for (int m = 0; m < 4; ++m) { bf16_t* rowp = O + (size_t)(row0 + ai * HALF + m * 16) * ldc + col0;
#pragma unroll
                for (int bj = 0; bj < 2; ++bj) { const f32x4 v0 = acc[ai][bj][m][0], v1 = acc[ai][bj][m][1];
                    u32x4 w; w.x = cvt_pk_bf16(v0[0], v0[1]); w.y = cvt_pk_bf16(v0[2], v0[3]); w.z = cvt_pk_bf16(v1[0], v1[1]); w.w = cvt_pk_bf16(v1[2], v1[3]);
                    *(u32x4*)(rowp + bj * HALF) = w; } }
    }
};
struct EpiBf16Sig {
    static constexpr bool PERM = true, KEEP_SUB0 = false;
    bf16_t* O; int ldc; int sig_from;
    __device__ __forceinline__ void operator()(const f32x4 (&acc)[2][2][4][2], const Unit& u, int wr, int wc, int fr, int fq) const {
        const int row0 = u.pm * BM + wr * 64 + fr, col0 = u.pn * BM + wc * 32 + 8 * fq; const bool sg = u.pn >= sig_from;
#pragma unroll
        for (int ai = 0; ai < 2; ++ai)
#pragma unroll
            for (int m = 0; m < 4; ++m) { bf16_t* rowp = O + (size_t)(row0 + ai * HALF + m * 16) * ldc + col0;
#pragma unroll
                for (int bj = 0; bj < 2; ++bj) { f32x4 v0 = acc[ai][bj][m][0], v1 = acc[ai][bj][m][1];
                    if (sg) {
#pragma unroll
                        for (int j = 0; j < 4; ++j) { v0[j] = fast_sigmoid(v0[j]); v1[j] = fast_sigmoid(v1[j]); } }
                    u32x4 w; w.x = cvt_pk_bf16(v0[0], v0[1]); w.y = cvt_pk_bf16(v0[2], v0[3]); w.z = cvt_pk_bf16(v1[0], v1[1]); w.w = cvt_pk_bf16(v1[2], v1[3]);
                    *(u32x4*)(rowp + bj * HALF) = w; } }
    }
};
struct EpiPool {
    static constexpr bool PERM = true, KEEP_SUB0 = false;
    bf16_t* O; int ldc; const float* scale;
    __device__ __forceinline__ void operator()(const f32x4 (&acc)[2][2][4][2], const Unit& u, int, int, int, int) const {
        int tz = threadIdx.x; asm volatile("" : "+v"(tz));
        const int wid = tz >> 6, lane = tz & 63, wr = wid >> 2, wc = wid & 3, fr = lane & 15, fq = lane >> 4;
        const int row0 = u.pm * BM + wr * 64 + fr, col0 = u.pn * BM + wc * 32 + 8 * fq;
#pragma unroll
        for (int bj = 0; bj < 2; ++bj) { const f32x4 sv0 = *(const f32x4*)(scale + col0 + bj * HALF), sv1 = *(const f32x4*)(scale + col0 + bj * HALF + 4);
#pragma unroll
            for (int ai = 0; ai < 2; ++ai)
#pragma unroll
                for (int m = 0; m < 4; ++m) { bf16_t* rowp = O + (size_t)(row0 + ai * HALF + m * 16) * ldc + col0;
                    const f32x4 v0 = acc[ai][bj][m][0] * sv0, v1 = acc[ai][bj][m][1] * sv1;
                    u32x4 w; w.x = cvt_pk_bf16(v0[0], v0[1]); w.y = cvt_pk_bf16(v0[2], v0[3]); w.z = cvt_pk_bf16(v1[0], v1[1]); w.w = cvt_pk_bf16(v1[2], v1[3]);
                    *(u32x4*)(rowp + bj * HALF) = w; } }
    }
};
struct EpiBranch {
    static constexpr bool PERM = true, KEEP_SUB0 = true;
    bf16_t* O; int ldc; const bf16_t* proj;
    __device__ __forceinline__ void operator()(f32x4 (&acc)[2][2][4][2], const Unit& u, int, int, int, int) const {
        int tz = threadIdx.x; asm volatile("" : "+v"(tz));
        const int wid = tz >> 6, lane = tz & 63, wr = wid >> 2, wc = wid & 3, fr = lane & 15, fq = lane >> 4;
        const int row0 = u.pm * BM + wr * 64 + fr, col0 = u.pn * BM + wc * 32 + 8 * fq;
        if (u.sub == 0) {
#pragma unroll
            for (int ai = 0; ai < 2; ++ai)
#pragma unroll
                for (int mh = 0; mh < 2; ++mh) {
                    u32x4 ga[2][2], gp[2][2];
#pragma unroll
                    for (int mm = 0; mm < 2; ++mm)
#pragma unroll
                        for (int bj = 0; bj < 2; ++bj) { const bf16_t* gpt = proj + (size_t)(row0 + ai * HALF + (2 * mh + mm) * 16) * NIN + col0 + bj * HALF;
                            ga[mm][bj] = *(const u32x4*)(gpt + GA_OFF); gp[mm][bj] = *(const u32x4*)(gpt + GP_OFF); }
#pragma unroll
                    for (int mm = 0; mm < 2; ++mm)
#pragma unroll
                        for (int bj = 0; bj < 2; ++bj) { const int m = 2 * mh + mm;
#pragma unroll
                            for (int k = 0; k < 4; ++k) { const unsigned aw = ga[mm][bj][k], pw = gp[mm][bj][k];
                                const float r0 = bf_lo(aw) * __builtin_amdgcn_rcpf(fmaxf(bf_lo(pw), 1e-6f)), r1 = bf_hi(aw) * __builtin_amdgcn_rcpf(fmaxf(bf_hi(pw), 1e-6f));
                                acc[ai][bj][m][k >> 1][2 * (k & 1)] *= r0; acc[ai][bj][m][k >> 1][2 * (k & 1) + 1] *= r1; } }
                    asm volatile("" ::: "memory"); }
        } else {
#pragma unroll
            for (int ai = 0; ai < 2; ++ai) {
                u32x4 gp[4][2];
#pragma unroll
                for (int m = 0; m < 4; ++m)
#pragma unroll
                    for (int bj = 0; bj < 2; ++bj) gp[m][bj] = *(const u32x4*)(proj + (size_t)(row0 + ai * HALF + m * 16) * NIN + GP_OFF + col0 + bj * HALF);
#pragma unroll
                for (int m = 0; m < 4; ++m)
#pragma unroll
                    for (int bj = 0; bj < 2; ++bj) { u32x4 w;
#pragma unroll
                        for (int k = 0; k < 4; ++k) { const unsigned pw = gp[m][bj][k];
                            w[k] = cvt_pk_bf16(acc[ai][bj][m][k >> 1][2 * (k & 1)] * fmaxf(bf_lo(pw), 1e-6f), acc[ai][bj][m][k >> 1][2 * (k & 1) + 1] * fmaxf(bf_hi(pw), 1e-6f)); }
                        *(u32x4*)(O + (size_t)(row0 + ai * HALF + m * 16) * ldc + col0 + bj * HALF) = w; }
                asm volatile("" ::: "memory"); }
        }
    }
};

template <class Epi, class Sched, bool ALIGN_EPI, bool SP2>
__device__ __forceinline__ void gemm_phase(LAS unsigned char* lds, const int K, const Sched& S, const Epi& E) {
    int tid = threadIdx.x; asm volatile("" : "+v"(tid));
    const int wid = __builtin_amdgcn_readfirstlane(tid >> 6), lane = tid & 63, wr = wid >> 2, wc = wid & 3, fr = lane & 15, fq = lane >> 4;
    const int nt = K / BK;
    unsigned voffA[2], voffB[2];
#pragma unroll
    for (int i = 0; i < 2; ++i) { int R, C; stage_rc(tid * 16 + i * 8192, R, C);
        voffA[i] = (unsigned)(R * K + C) * 2u; voffB[i] = (unsigned)(tid * 16 + i * 8192); }
    const size_t kstep = (size_t)(BK * 2), kstepB = (size_t)HTB;
    const size_t hstep = (size_t)HALF * K * 2;
    const unsigned ldsw = (unsigned)wid * 1024u;
    const int aoff = lds_byte(wr * 64 + fr, fq * 8), boff = lds_byte(wc * 32 + fr, fq * 8);
#define PG8_SA(b, h) (((b) * 2 + (h)) * HTB)
#define PG8_SB(b, h) ((4 + (b) * 2 + (h)) * HTB)
#define PG8_STAGE(bufoff, gbase, voff) do { _Pragma("unroll") for (int _i = 0; _i < 2; ++_i) \
        __builtin_amdgcn_global_load_lds((const unsigned*)((const char*)(gbase) + (voff)[_i]), (LAS unsigned*)(lds + (bufoff) + ldsw + _i * 8192), 16, 0, 0); } while (0)
#define PG8_LDA(dst, b, h) do { _Pragma("unroll") for (int m = 0; m < 4; ++m) _Pragma("unroll") for (int k = 0; k < 2; ++k) dst[m][k] = *(const LAS bf16x8*)(lds + PG8_SA(b, h) + aoff + m * 2048 + k * 1024); } while (0)
#define PG8_LDB(dst, b, h) do { _Pragma("unroll") for (int n = 0; n < 2; ++n) _Pragma("unroll") for (int k = 0; k < 2; ++k) dst[n][k] = *(const LAS bf16x8*)(lds + PG8_SB(b, h) + boff + n * 2048 + k * 1024); } while (0)
#define PG8_MMA(ai, bj, At, Bt) do { __builtin_amdgcn_s_setprio(1); _Pragma("unroll") for (int m = 0; m < 4; ++m) _Pragma("unroll") for (int n = 0; n < 2; ++n) _Pragma("unroll") for (int k = 0; k < 2; ++k) \
        acc[ai][bj][m][n] = __builtin_amdgcn_mfma_f32_16x16x32_bf16(Bt[n][k], At[m][k], acc[ai][bj][m][n], 0, 0, 0); __builtin_amdgcn_s_setprio(0); } while (0)
#define PG8_WAIT_V(n) asm volatile("s_waitcnt vmcnt(" #n ")" ::: "memory")
#define PG8_WAIT_L(n) asm volatile("s_waitcnt lgkmcnt(" #n ")" ::: "memory")
#define PG8_BAR __builtin_amdgcn_s_barrier()
#define PG8_SCHED __builtin_amdgcn_sched_barrier(0)
    Unit cur, nxt; int ui = 0;
    if (!S.next(0, cur)) return;
    f32x4 acc[2][2][4][2];
#pragma unroll
    for (int a = 0; a < 2; ++a)
#pragma unroll
        for (int b = 0; b < 2; ++b)
#pragma unroll
            for (int m = 0; m < 4; ++m)
#pragma unroll
                for (int n = 0; n < 2; ++n) acc[a][b][m][n] = (f32x4){0.f, 0.f, 0.f, 0.f};
    bf16x8 At[4][2], B0[2][2], B1[2][2];
    const char* cA = S.aptr(cur); const char* cB = S.bptr(cur);
    if constexpr (SP2) {
        PG8_STAGE(PG8_SB(0, 0), cB, voffB); PG8_STAGE(PG8_SB(0, 1), cB + hstep, voffB); PG8_STAGE(PG8_SA(0, 0), cA, voffA); PG8_STAGE(PG8_SA(0, 1), cA + hstep, voffA);
        if (wr == 1) PG8_BAR;
        PG8_WAIT_V(2); PG8_BAR;
        PG8_STAGE(PG8_SB(1, 0), cB + kstepB, voffB); PG8_STAGE(PG8_SA(1, 0), cA + kstep, voffA); PG8_STAGE(PG8_SB(1, 1), cB + hstep + kstepB, voffB);
        PG8_WAIT_V(6); PG8_BAR;
    } else {
        PG8_STAGE(PG8_SB(0, 0), cB, voffB); PG8_STAGE(PG8_SA(0, 0), cA, voffA); PG8_STAGE(PG8_SB(0, 1), cB + hstep, voffB); PG8_STAGE(PG8_SA(0, 1), cA + hstep, voffA);
        if (wr == 1) PG8_BAR;
        PG8_WAIT_V(4); PG8_BAR;
        PG8_STAGE(PG8_SB(1, 0), cB + kstepB, voffB); PG8_STAGE(PG8_SA(1, 0), cA + kstep, voffA); PG8_STAGE(PG8_SB(1, 1), cB + hstep + kstepB, voffB);
        PG8_WAIT_V(6); PG8_BAR;
    }
    for (;;) {
        const bool has_next = S.next(ui + 1, nxt);
        const char* nA = has_next ? S.aptr(nxt) : cA; const char* nB = has_next ? S.bptr(nxt) : cB;
#pragma unroll 1
        for (int t = 0; t < nt; t += 2) {
            const bool last = (t == nt - 2);
            const char* a1 = cA + (size_t)(t + 1) * kstep;
            const char* a2 = last ? nA : cA + (size_t)(t + 2) * kstep; const char* b2 = last ? nB : cB + (size_t)(t + 2) * kstepB;
            const char* a3 = a2 + kstep; const char* b3 = b2 + kstepB;
            if constexpr (SP2) {
            PG8_LDB(B0, 0, 0); PG8_LDB(B1, 0, 1); PG8_SCHED; PG8_LDA(At, 0, 0); PG8_STAGE(PG8_SA(1, 1), a1 + hstep, voffA);
            PG8_WAIT_V(8); PG8_WAIT_L(0); PG8_BAR; PG8_MMA(0, 0, At, B0); PG8_MMA(0, 1, At, B1); PG8_BAR; PG8_SCHED;
            PG8_LDA(At, 0, 1); PG8_STAGE(PG8_SB(0, 0), b2, voffB); PG8_STAGE(PG8_SB(0, 1), b2 + hstep, voffB); PG8_STAGE(PG8_SA(0, 0), a2, voffA);
            PG8_WAIT_V(8); PG8_WAIT_L(0); PG8_BAR; PG8_MMA(1, 0, At, B0); PG8_MMA(1, 1, At, B1); PG8_BAR; PG8_SCHED;
            PG8_LDB(B0, 1, 0); PG8_LDB(B1, 1, 1); PG8_SCHED; PG8_LDA(At, 1, 0); PG8_STAGE(PG8_SA(0, 1), a2 + hstep, voffA);
            PG8_WAIT_V(8); PG8_WAIT_L(0); PG8_BAR; PG8_MMA(0, 0, At, B0); PG8_MMA(0, 1, At, B1); PG8_BAR; PG8_SCHED;
            PG8_LDA(At, 1, 1); PG8_STAGE(PG8_SB(1, 0), b3, voffB); PG8_STAGE(PG8_SB(1, 1), b3 + hstep, voffB); PG8_STAGE(PG8_SA(1, 0), a3, voffA);
            PG8_WAIT_V(8); PG8_WAIT_L(0); PG8_BAR; PG8_MMA(1, 0, At, B0); PG8_MMA(1, 1, At, B1); PG8_BAR; PG8_SCHED;
            } else {
            PG8_LDB(B0, 0, 0); PG8_SCHED; PG8_LDA(At, 0, 0); PG8_STAGE(PG8_SA(1, 1), a1 + hstep, voffA);
            PG8_WAIT_L(8); PG8_BAR; PG8_WAIT_L(0); PG8_MMA(0, 0, At, B0); PG8_BAR; PG8_SCHED;
            PG8_LDB(B1, 0, 1); PG8_STAGE(PG8_SB(0, 0), b2, voffB);
            PG8_BAR; PG8_WAIT_L(0); PG8_MMA(0, 1, At, B1); PG8_BAR;
            PG8_LDA(At, 0, 1); PG8_STAGE(PG8_SA(0, 0), a2, voffA);
            PG8_BAR; PG8_WAIT_L(0); PG8_MMA(1, 0, At, B0); PG8_BAR; PG8_SCHED;
            PG8_STAGE(PG8_SB(0, 1), b2 + hstep, voffB);
            PG8_WAIT_V(6); PG8_BAR; PG8_MMA(1, 1, At, B1); PG8_BAR;
            PG8_LDB(B0, 1, 0); PG8_SCHED; PG8_LDA(At, 1, 0); PG8_STAGE(PG8_SA(0, 1), a2 + hstep, voffA);
            PG8_WAIT_L(8); PG8_BAR; PG8_WAIT_L(0); PG8_MMA(0, 0, At, B0); PG8_BAR; PG8_SCHED;
            PG8_LDB(B1, 1, 1); PG8_STAGE(PG8_SB(1, 0), b3, voffB);
            PG8_BAR; PG8_WAIT_L(0); PG8_MMA(0, 1, At, B1); PG8_BAR;
            PG8_LDA(At, 1, 1); PG8_STAGE(PG8_SA(1, 0), a3, voffA);
            PG8_BAR; PG8_WAIT_L(0); PG8_MMA(1, 0, At, B0); PG8_BAR; PG8_SCHED;
            PG8_STAGE(PG8_SB(1, 1), b3 + hstep, voffB);
            PG8_WAIT_V(6); PG8_BAR; PG8_MMA(1, 1, At, B1); PG8_BAR;
            }
        }
        if constexpr (ALIGN_EPI) { if (wr == 0) PG8_BAR; }
        E(acc, cur, wr, wc, fr, fq);
        if (!has_next) break;
        if (!(Epi::KEEP_SUB0 && cur.sub == 0)) {
#pragma unroll
        for (int a = 0; a < 2; ++a)
#pragma unroll
            for (int b = 0; b < 2; ++b)
#pragma unroll
                for (int m = 0; m < 4; ++m)
#pragma unroll
                    for (int n = 0; n < 2; ++n) acc[a][b][m][n] = (f32x4){0.f, 0.f, 0.f, 0.f}; }
        cur = nxt; cA = nA; cB = nB; ++ui;
        if constexpr (ALIGN_EPI) { if (wr == 1) PG8_BAR; }
    }
    PG8_WAIT_V(0);
    if constexpr (!ALIGN_EPI) { if (wr == 0) PG8_BAR; }
    PG8_BAR;
#undef PG8_SA
#undef PG8_SB
#undef PG8_STAGE
#undef PG8_LDA
#undef PG8_LDB
#undef PG8_MMA
#undef PG8_WAIT_V
#undef PG8_WAIT_L
#undef PG8_BAR
#undef PG8_SCHED
}
}

#ifndef WGM_G
#define WGM_G 8
#endif
#ifndef WGM_D
#define WGM_D 4
#endif
#ifndef PG8_SP2
#define PG8_SP2 true
#endif
#ifndef PG8_ALIGN
#define PG8_ALIGN true
#endif

constexpr int RING_BYTES = 131072;
constexpr int LDS_BYTES = 147456;
constexpr int MISC_OFF = LDS_BYTES - 256;

struct Args {
    const float* x; const float* n1pre; const float* n1post; const float* w1g; const float* w1u; const float* w1d;
    const float* nmpre; const float* nmpost; const float* win; const float* poolw; const float* poolscale; const float* wab; const float* wpb; const float* wout;
    const float* n2pre; const float* n2post; const float* w2g; const float* w2u; const float* w2d;
    float* out; unsigned char* ws; int ph_lo, ph_hi;
};

__device__ __forceinline__ void transpose_item(const float* W, int K, int N, bf16_t* WT, int mode, LAS float* scr, int item, int lane) {
    const int nblk = N / 32, kb = item / nblk, nb = item % nblk, k0 = 64 * kb, n0 = 32 * nb;
    int drow = n0;
    if (mode == 1) drow = (n0 >> 7) * 256 + (n0 & 127);
    else if (mode == 2) drow = (n0 >> 7) * 256 + 128 + (n0 & 127);
#pragma unroll 8
    for (int i = 0; i < 32; ++i) { const int kk = 2 * i + (lane >> 5); scr[kk * 33 + (lane & 31)] = W[(size_t)(k0 + kk) * N + n0 + (lane & 31)]; }
    asm volatile("s_waitcnt lgkmcnt(0)" ::: "memory");
    const int c = lane & 7;
    unsigned char* blk = (unsigned char*)WT + ((size_t)(drow >> 7) * (K / 64) + kb) * 16384;
#pragma unroll
    for (int j = 0; j < 4; ++j) { const int n = (lane >> 3) + 8 * j; const LAS float* s = scr + (8 * c) * 33 + n;
        u32x4 o; o.x = cvt_pk_bf16(s[0 * 33], s[1 * 33]); o.y = cvt_pk_bf16(s[2 * 33], s[3 * 33]); o.z = cvt_pk_bf16(s[4 * 33], s[5 * 33]); o.w = cvt_pk_bf16(s[6 * 33], s[7 * 33]);
        const int slot = 16 * ((n >> 2) & 1) + 4 * (n >> 3) + (n & 3);
        *(u32x4*)(blk + pg8::lds_byte((drow & 127) + slot, 8 * c)) = o; }
    asm volatile("s_waitcnt lgkmcnt(0)" ::: "memory");
}

template <int SET> __device__ __forceinline__ void p0_weights(const Args& a, LAS unsigned char* lds, int gw, int NGW, int wave, int lane) {
    asm volatile("" : "+v"(lane));
    LAS float* scr = (LAS float*)(lds + wave * 16384);
    unsigned char* ws = a.ws;
    constexpr int I_GU = (D / 64) * (FF / 32), I_DN = (FF / 64) * (D / 32), I_IN = (D / 64) * (NIN / 32), I_OUT = (D / 64) * (D / 32), I_BR = (1024 / 64) * (D / 32), I_PL = (256 / 64) * (256 / 32);
    constexpr int NITEMS = SET == 0 ? 4 * I_GU + I_DN + I_OUT + 2 * I_BR + 4 * I_PL : (SET == 1 ? I_IN : I_DN);
    for (int it = gw; it < NITEMS; it += NGW) {
        int r = it; const float* W; int K, N, mode = 0; bf16_t* WT;
        if (SET == 1) { W = a.win; K = D; N = NIN; WT = (bf16_t*)(ws + WS_WIN); }
        else if (SET == 2) { W = a.w2d; K = FF; N = D; WT = (bf16_t*)(ws + WS_WD2); }
        else if (r < I_GU) { W = a.w1g; K = D; N = FF; WT = (bf16_t*)(ws + WS_WGU1); mode = 1; }
        else if ((r -= I_GU) < I_GU) { W = a.w1u; K = D; N = FF; WT = (bf16_t*)(ws + WS_WGU1); mode = 2; }
        else if ((r -= I_GU) < I_GU) { W = a.w2g; K = D; N = FF; WT = (bf16_t*)(ws + WS_WGU2); mode = 1; }
        else if ((r -= I_GU) < I_GU) { W = a.w2u; K = D; N = FF; WT = (bf16_t*)(ws + WS_WGU2); mode = 2; }
        else if ((r -= I_GU) < I_DN) { W = a.w1d; K = FF; N = D; WT = (bf16_t*)(ws + WS_WD1); }
        else if ((r -= I_DN) < I_OUT) { W = a.wout; K = D; N = D; WT = (bf16_t*)(ws + WS_WOUT); }
        else if ((r -= I_OUT) < I_BR) { W = a.wab; K = 1024; N = D; WT = (bf16_t*)(ws + WS_WBA); }
        else if ((r -= I_BR) < I_BR) { W = a.wpb; K = 1024; N = D; WT = (bf16_t*)(ws + WS_WBP); }
        else { r -= I_BR; const int g = r / I_PL; r -= g * I_PL; W = a.poolw + (size_t)g * 65536; K = 256; N = 256; WT = (bf16_t*)(ws + WS_WPL) + (size_t)g * 65536; }
        transpose_item(W, K, N, WT, mode, scr, r, lane);
    }
}

__device__ __forceinline__ void p0_norm(const float* x, const float* gain, bf16_t* xn, int gw, int NGW, int lane) {
    asm volatile("" : "+v"(lane));
    for (int m = gw; m < M; m += NGW) {
        const f32x4* xr = (const f32x4*)(x + (size_t)m * D) + lane; const f32x4* gr = (const f32x4*)gain + lane;
        f32x4 v[16]; float s = 0.f;
#pragma unroll
        for (int j = 0; j < 16; ++j) { v[j] = xr[64 * j]; s += (v[j][0] * v[j][0] + v[j][1] * v[j][1]) + (v[j][2] * v[j][2] + v[j][3] * v[j][3]); }
        const float rstd = 1.0f / sqrtf(wave_sum(s) * (1.0f / D) + RMS_EPS);
        u32x2* o = (u32x2*)(xn + (size_t)m * D) + lane;
#pragma unroll
        for (int j = 0; j < 16; ++j) { const f32x4 g = gr[64 * j]; u32x2 w; w.x = cvt_pk_bf16(v[j][0] * rstd * g[0], v[j][1] * rstd * g[1]); w.y = cvt_pk_bf16(v[j][2] * rstd * g[2], v[j][3] * rstd * g[3]); o[64 * j] = w; }
    }
}

__device__ __forceinline__ void norm_phase(LAS unsigned char* lds, const bf16_t* f, const float* base, float* hout, bf16_t* xn, const float* gpost, const float* gpre, float coef, int gw, int NGW, int tid) {
    asm volatile("" : "+v"(tid));
    const int lane = tid & 63;
    LAS f32x4* G1 = (LAS f32x4*)lds; LAS f32x4* G2 = (LAS f32x4*)(lds + 16384);
    for (int i = tid; i < D / 4; i += NTHREADS) { G1[i] = ((const f32x4*)gpost)[i]; if (xn) G2[i] = ((const f32x4*)gpre)[i]; }
    __syncthreads();
    for (int m = gw; m < M; m += NGW) {
        const u32x2* fr_ = (const u32x2*)(f + (size_t)m * D) + lane; const f32x4* br = (const f32x4*)(base + (size_t)m * D) + lane;
        u32x2 fw[16]; f32x4 v[16];
#pragma unroll
        for (int j = 0; j < 16; ++j) fw[j] = fr_[64 * j];
#pragma unroll
        for (int j = 0; j < 16; ++j) v[j] = br[64 * j];
        float s = 0.f;
#pragma unroll
        for (int j = 0; j < 16; ++j) { const float a0 = bf_lo(fw[j].x), a1 = bf_hi(fw[j].x), a2 = bf_lo(fw[j].y), a3 = bf_hi(fw[j].y); s += (a0 * a0 + a1 * a1) + (a2 * a2 + a3 * a3); }
        const float rstd = coef / sqrtf(wave_sum(s) * (1.0f / D) + RMS_EPS);
        float s2 = 0.f; f32x4* ho = (f32x4*)(hout + (size_t)m * D) + lane;
#pragma unroll
        for (int j = 0; j < 16; ++j) { const f32x4 g = G1[64 * j + lane]; f32x4 h;
            h[0] = v[j][0] + bf_lo(fw[j].x) * rstd * g[0]; h[1] = v[j][1] + bf_hi(fw[j].x) * rstd * g[1]; h[2] = v[j][2] + bf_lo(fw[j].y) * rstd * g[2]; h[3] = v[j][3] + bf_hi(fw[j].y) * rstd * g[3];
            v[j] = h; ho[64 * j] = h; s2 += (h[0] * h[0] + h[1] * h[1]) + (h[2] * h[2] + h[3] * h[3]); }
        if (xn) {
            const float r2 = 1.0f / sqrtf(wave_sum(s2) * (1.0f / D) + RMS_EPS);
            u32x2* o = (u32x2*)(xn + (size_t)m * D) + lane;
#pragma unroll
            for (int j = 0; j < 16; ++j) { const f32x4 g = G2[64 * j + lane]; u32x2 w; w.x = cvt_pk_bf16(v[j][0] * r2 * g[0], v[j][1] * r2 * g[1]); w.y = cvt_pk_bf16(v[j][2] * r2 * g[2], v[j][3] * r2 * g[3]); o[64 * j] = w; }
        }
    }
    __syncthreads();
}

template <int P> __device__ __forceinline__ void pool_delta_task(const bf16_t* proj, bf16_t* delta, int g, int mp, int lane) {
    const int m = 2 * mp + (lane >> 5), c = 8 * (lane & 31), t = m & (SEQ - 1);
    const bf16_t* zp = proj + (size_t)m * NIN + POOL_OFF + g * 256 + c;
    u32x4 w[P];
#pragma unroll
    for (int j = 0; j < P; ++j) w[j] = (j <= t) ? *(const u32x4*)(zp - (size_t)j * NIN) : (u32x4){0u, 0u, 0u, 0u};
    float s[8];
#pragma unroll
    for (int k = 0; k < 8; ++k) s[k] = 0.f;
#pragma unroll
    for (int j = 0; j < P; ++j) { s[0] += bf_lo(w[j].x); s[1] += bf_hi(w[j].x); s[2] += bf_lo(w[j].y); s[3] += bf_hi(w[j].y); s[4] += bf_lo(w[j].z); s[5] += bf_hi(w[j].z); s[6] += bf_lo(w[j].w); s[7] += bf_hi(w[j].w); }
    const int cnt = (t + 1) < P ? (t + 1) : P; const float ic = 1.0f / (float)cnt;
    u32x4 o; o.x = cvt_pk_bf16(s[0] * ic - bf_lo(w[0].x), s[1] * ic - bf_hi(w[0].x)); o.y = cvt_pk_bf16(s[2] * ic - bf_lo(w[0].y), s[3] * ic - bf_hi(w[0].y));
    o.z = cvt_pk_bf16(s[4] * ic - bf_lo(w[0].z), s[5] * ic - bf_hi(w[0].z)); o.w = cvt_pk_bf16(s[6] * ic - bf_lo(w[0].w), s[7] * ic - bf_hi(w[0].w));
    *(u32x4*)(delta + ((size_t)g * M + m) * 256 + c) = o;
}
__device__ __forceinline__ void pool_delta(const bf16_t* proj, bf16_t* delta, int gw, int NGW, int lane) {
    asm volatile("" : "+v"(lane));
    for (int task = gw; task < 2 * M; task += NGW) {
        const int g = task & 3, mp = task >> 2;
        if (g == 0) pool_delta_task<2>(proj, delta, 0, mp, lane);
        else if (g == 1) pool_delta_task<4>(proj, delta, 1, mp, lane);
        else if (g == 2) pool_delta_task<8>(proj, delta, 2, mp, lane);
        else pool_delta_task<16>(proj, delta, 3, mp, lane);
    }
}

namespace att {
__device__ __forceinline__ void attn_merge(const bf16_t* outg, const float* lse, bf16_t* attn, int gtid, int NT) {
    asm volatile("" : "+v"(gtid));
    for (int idx = gtid; idx < M * 128; idx += NT) {
        const int m = idx >> 7, c8 = (idx & 127) * 8, h = c8 >> 7;
        const float l0 = lse[(size_t)m * 8 + h], l1 = lse[((size_t)M + m) * 8 + h], l2 = lse[((size_t)2 * M + m) * 8 + h];
        const float mm = fmaxf(l0, fmaxf(l1, l2));
        float w0 = __expf(l0 - mm), w1 = __expf(l1 - mm), w2 = __expf(l2 - mm); const float inv = 1.0f / (w0 + w1 + w2); w0 *= inv; w1 *= inv; w2 *= inv;
        const u32x4 a = *(const u32x4*)(outg + (size_t)m * 1024 + c8), bq = *(const u32x4*)(outg + ((size_t)M + m) * 1024 + c8), c = *(const u32x4*)(outg + ((size_t)2 * M + m) * 1024 + c8);
        u32x4 o;
#pragma unroll
        for (int k = 0; k < 4; ++k) o[k] = cvt_pk_bf16(w0 * bf_lo(a[k]) + w1 * bf_lo(bq[k]) + w2 * bf_lo(c[k]), w0 * bf_hi(a[k]) + w1 * bf_hi(bq[k]) + w2 * bf_hi(c[k]));
        *(u32x4*)(attn + (size_t)m * 1024 + c8) = o;
    }
}
}


namespace att2 {
constexpr int VROW = 272, KBYTES = 32768, STG = KBYTES + 128 * VROW, N_UNITS = 3 * BATCH * 8 * 32;
static_assert(2 * STG <= MISC_OFF, "attention LDS");
struct Lane { int kR[2], kC[2]; unsigned ldsw; int koff, v_ch, v_kg, vcol, fr, fq, qbw, qi; };
struct UDec { const bf16_t* base; size_t rs; int qb, d, g, h, b, r; };
__device__ __forceinline__ UDec decode(const bf16_t* proj, int u) {
    UDec x; const int sub = u & 31; x.h = (u >> 5) & 7; x.b = (u >> 8) & 3; x.g = u >> 10;
    const int dsh = 2 * x.g, nbsh = 5 - dsh; x.d = 1 << dsh; x.qb = sub & ((1 << nbsh) - 1); x.r = sub >> nbsh;
    x.rs = (size_t)x.d * NIN; x.base = proj + ((size_t)x.b * SEQ + x.r) * NIN + x.g * 3072 + x.h * 128; return x;
}
__device__ __forceinline__ int first_half(int u) { const int g = u >> 10, nbsh = 5 - 2 * g; return ((u & 31) & ((1 << nbsh) - 1)) == 0 ? 1 : 0; }
template <int PAR> __device__ __forceinline__ void issue(LAS unsigned char* lds, const bf16_t* proj, int u, int half, const Lane& L, u32x4 (&vr)[4]) {
    const UDec x = decode(proj, u);
    const int i0 = 128 * x.qb - 128 * (1 - half);
    const bf16_t* kb = x.base + 1024 + (size_t)i0 * x.rs;
#pragma unroll
    for (int eh = 0; eh < 2; ++eh)
#pragma unroll
        for (int i = 0; i < 2; ++i)
            __builtin_amdgcn_global_load_lds((const unsigned*)(kb + 64 * eh + (size_t)L.kR[i] * x.rs + L.kC[i]), (LAS unsigned*)(lds + PAR * STG + eh * 16384 + L.ldsw + i * 8192), 16, 0, 0);
    const bf16_t* vp = x.base + 2048 + (size_t)(i0 + 4 * L.v_kg) * x.rs + 8 * L.v_ch;
#pragma unroll
    for (int c = 0; c < 4; ++c) vr[c] = *(const u32x4*)(vp + (size_t)c * x.rs);
}
template <int PAR> __device__ __forceinline__ void store_v(LAS unsigned char* lds, const Lane& L, const u32x4 (&vr)[4]) {
    LAS unsigned char* vdst = lds + PAR * STG + KBYTES + (8 * L.v_ch) * VROW + L.vcol;
#pragma unroll
    for (int wi = 0; wi < 4; ++wi) {
        u32x2 ev, od;
        ev.x = (vr[0][wi] & 0xffffu) | (vr[1][wi] << 16); ev.y = (vr[2][wi] & 0xffffu) | (vr[3][wi] << 16);
        od.x = (vr[0][wi] >> 16) | (vr[1][wi] & 0xffff0000u); od.y = (vr[2][wi] >> 16) | (vr[3][wi] & 0xffff0000u);
        *(LAS u32x2*)(vdst + (2 * wi) * VROW) = ev; *(LAS u32x2*)(vdst + (2 * wi + 1) * VROW) = od; }
}
__device__ __forceinline__ void load_q(const bf16_t* proj, int u, const Lane& L, bf16x8 (&q)[4]) {
    const UDec x = decode(proj, u);
    const bf16_t* qp = x.base + (size_t)(128 * x.qb + L.qi) * x.rs + 8 * L.fq;
#pragma unroll
    for (int ks = 0; ks < 4; ++ks) q[ks] = *(const bf16x8*)(qp + 32 * ks);
}
template <int PAR> __device__ __forceinline__ void compute(LAS unsigned char* lds, int u, int half, const Lane& L, const bf16x8 (&qf)[4], float& mrun, float& lrun, f32x4 (&o)[8]) {
    const int g = u >> 10, h = (u >> 5) & 7, d = 1 << (2 * g);
    const int qbw = L.qbw;
    f32x4 s[8];
#pragma unroll
    for (int kt = 0; kt < 8; ++kt) {
        const bool act = half ? (kt <= qbw) : (kt >= qbw);
        s[kt] = (f32x4){0.f, 0.f, 0.f, 0.f};
        if (act) {
#pragma unroll
            for (int ks = 0; ks < 4; ++ks) { const bf16x8 kf = *(const LAS bf16x8*)(lds + PAR * STG + (ks >> 1) * 16384 + L.koff + kt * 2048 + (ks & 1) * 1024);
                s[kt] = __builtin_amdgcn_mfma_f32_16x16x32_bf16(kf, qf[ks], s[kt], 0, 0, 0); } }
    }
    const float slope = (g < 2) ? exp2f(-0.25f * (float)(g * 8 + h + 1)) : exp2f(-(4.5f + 0.5f * (float)h));
    const float sld = slope * (float)d;
    int bi = L.qi + 128 * (1 - half) - 4 * L.fq; asm volatile("" : "+v"(bi));
    const float c0 = -sld * (float)bi;
    float mloc = -1e30f;
#pragma unroll
    for (int kt = 0; kt < 8; ++kt)
#pragma unroll
        for (int j = 0; j < 4; ++j) { const int kc = 16 * kt + j;
            const bool valid = (kc <= bi) && (kc >= bi - 128);
            float v = s[kt][j] * 0.08838834764831845f + (c0 + sld * (float)kc); v = valid ? v : -1e30f; s[kt][j] = v; mloc = fmaxf(mloc, v); }
    mloc = fmaxf(mloc, __shfl_xor(mloc, 16)); mloc = fmaxf(mloc, __shfl_xor(mloc, 32));
    const float mnew = fmaxf(mrun, mloc), alpha = __expf(mrun - mnew);
    float lsum = 0.f;
#pragma unroll
    for (int kt = 0; kt < 8; ++kt)
#pragma unroll
        for (int j = 0; j < 4; ++j) { const float p = __expf(s[kt][j] - mnew); s[kt][j] = p; lsum += p; }
    lrun = lrun * alpha + lsum; mrun = mnew;
#pragma unroll
    for (int et = 0; et < 8; ++et) o[et] = o[et] * alpha;
#pragma unroll
    for (int ss = 0; ss < 4; ++ss) {
        const bool act = half ? (2 * ss <= qbw) : (2 * ss + 1 >= qbw);
        if (act) {
            u32x4 pw; pw.x = cvt_pk_bf16(s[2 * ss][0], s[2 * ss][1]); pw.y = cvt_pk_bf16(s[2 * ss][2], s[2 * ss][3]); pw.z = cvt_pk_bf16(s[2 * ss + 1][0], s[2 * ss + 1][1]); pw.w = cvt_pk_bf16(s[2 * ss + 1][2], s[2 * ss + 1][3]);
            const bf16x8 pf = __builtin_bit_cast(bf16x8, pw);
#pragma unroll
            for (int et = 0; et < 8; ++et) { const bf16x8 vf = *(const LAS bf16x8*)(lds + PAR * STG + KBYTES + (16 * et + L.fr) * VROW + 64 * ss + 16 * L.fq);
                o[et] = __builtin_amdgcn_mfma_f32_16x16x32_bf16(vf, pf, o[et], 0, 0, 0); } }
    }
}
__device__ __forceinline__ void finalize(const bf16_t* proj, int u, const Lane& L, float mrun, float lrun, const f32x4 (&o)[8], bf16_t* outg, float* lse) {
    const UDec x = decode(proj, u);
    float l = lrun; l += __shfl_xor(l, 16); l += __shfl_xor(l, 32);
    const float inv = 1.0f / l;
    const size_t mrow = (size_t)x.g * M + (size_t)x.b * SEQ + (size_t)(128 * x.qb + L.qi) * x.d + x.r;
    bf16_t* op = outg + mrow * 1024 + x.h * 128 + 4 * L.fq;
#pragma unroll
    for (int et = 0; et < 8; ++et) { u32x2 w; w.x = cvt_pk_bf16(o[et][0] * inv, o[et][1] * inv); w.y = cvt_pk_bf16(o[et][2] * inv, o[et][3] * inv); *(u32x2*)(op + 16 * et) = w; }
    if (L.fq == 0) lse[mrow * 8 + x.h] = mrun + __logf(l);
}
template <int PAR> __device__ __forceinline__ bool step(LAS unsigned char* lds, const bf16_t* proj, bf16_t* outg, float* lse, int G, const Lane& L, int& u, int& half, bf16x8 (&qf)[4], float& mrun, float& lrun, f32x4 (&o)[8]) {
    int nu, nh; if (half == 0) { nu = u; nh = 1; } else { nu = u + G; nh = nu < N_UNITS ? first_half(nu) : 0; }
    const bool has_next = nu < N_UNITS, new_unit = has_next && (nu != u);
    u32x4 vr[4]; bf16x8 qn[4];
    if (has_next) issue<PAR ^ 1>(lds, proj, nu, nh, L, vr);
    if (new_unit) load_q(proj, nu, L, qn);
    __builtin_amdgcn_sched_barrier(0);
    compute<PAR>(lds, u, half, L, qf, mrun, lrun, o);
    if (half == 1) { finalize(proj, u, L, mrun, lrun, o, outg, lse); mrun = -1e30f; lrun = 0.f;
#pragma unroll
        for (int et = 0; et < 8; ++et) o[et] = (f32x4){0.f, 0.f, 0.f, 0.f}; }
    __builtin_amdgcn_sched_barrier(0);
    if (has_next) store_v<PAR ^ 1>(lds, L, vr);
    if (new_unit) {
#pragma unroll
        for (int ks = 0; ks < 4; ++ks) qf[ks] = qn[ks]; }
    __builtin_amdgcn_s_waitcnt(0); asm volatile("" ::: "memory"); __builtin_amdgcn_s_barrier(); asm volatile("" ::: "memory");
    u = nu; half = nh;
    return has_next;
}
__device__ __forceinline__ void attn_phase(LAS unsigned char* lds, const bf16_t* proj, bf16_t* outg, float* lse, int vcu, int G) {
    int tid = threadIdx.x; asm volatile("" : "+v"(tid));
    const int lane = tid & 63, wid = __builtin_amdgcn_readfirstlane(tid >> 6);
    Lane L;
#pragma unroll
    for (int i = 0; i < 2; ++i) pg8::stage_rc(tid * 16 + i * 8192, L.kR[i], L.kC[i]);
    L.fr = lane & 15; L.fq = lane >> 4; L.ldsw = (unsigned)wid * 1024u; L.koff = pg8::lds_byte(L.fr, L.fq * 8);
    L.v_ch = (lane & 3) + 4 * ((lane >> 4) & 3); L.v_kg = ((lane >> 2) & 3) + 4 * wid;
    L.vcol = 64 * (wid >> 1) + 16 * ((lane >> 2) & 3) + 8 * (wid & 1);
    L.qbw = wid < 4 ? wid : 11 - wid; L.qi = 16 * L.qbw + L.fr;
    int u = vcu; if (u >= N_UNITS) return;
    int half = first_half(u);
    bf16x8 qf[4]; f32x4 o[8]; float mrun = -1e30f, lrun = 0.f;
#pragma unroll
    for (int et = 0; et < 8; ++et) o[et] = (f32x4){0.f, 0.f, 0.f, 0.f};
    { u32x4 vr[4]; issue<0>(lds, proj, u, half, L, vr); load_q(proj, u, L, qf); store_v<0>(lds, L, vr); }
    __builtin_amdgcn_s_waitcnt(0); asm volatile("" ::: "memory"); __builtin_amdgcn_s_barrier(); asm volatile("" ::: "memory");
    for (;;) {
        if (!step<0>(lds, proj, outg, lse, G, L, u, half, qf, mrun, lrun, o)) break;
        if (!step<1>(lds, proj, outg, lse, G, L, u, half, qf, mrun, lrun, o)) break;
    }
}
}

constexpr int NPHASE = 13;
__global__ void __launch_bounds__(NTHREADS, 2) mk_fwd(Args a) {
    extern __shared__ __attribute__((aligned(16))) unsigned char lds_raw[];
    LAS unsigned char* lds = (LAS unsigned char*)lds_raw;
    const int tid = threadIdx.x, lane = tid & 63, wave = __builtin_amdgcn_readfirstlane(tid >> 6);
    const int G = gridDim.x, bx = blockIdx.x;
    const int vcu = (G % 8 == 0) ? (bx % 8) * (G / 8) + bx / 8 : bx;
    const int gw = vcu * NWAVES + wave, NGW = G * NWAVES;
    unsigned char* ws = a.ws;
    unsigned* ctl = (unsigned*)(ws + WS_CTL);
    volatile LAS unsigned* MISC = (volatile LAS unsigned*)(lds + MISC_OFF);
    if (tid < 32) MISC[tid] = 0u;
    __syncthreads();
    XcdBarrier bar; bar.bar = ctl + CW_BAR; bar.x = 0; bar.st = nullptr;
    if (MK_ONE_LAUNCH) bar = xcd_barrier_post(ctl + CW_BAR, MISC + 8);
    const int lo = a.ph_lo, hi = a.ph_hi;
#ifdef DBG_ONLY
#define IN(k) ((k) == DBG_ONLY && lo <= (k) && (k) < hi)
#else
#define IN(k) (lo <= (k) && (k) < hi)
#endif
#define SEAM(k) do { if (MK_ONE_LAUNCH && IN(k) && IN((k) + 1)) xcd_barrier(bar); } while (0)

    bf16_t* XN = (bf16_t*)(ws + WS_XN); bf16_t* ACT = (bf16_t*)(ws + WS_ACT); bf16_t* Fb = (bf16_t*)(ws + WS_F); bf16_t* PROJ = (bf16_t*)(ws + WS_PROJ);
    bf16_t* ATT = (bf16_t*)(ws + WS_ATTN); bf16_t* DELTA = (bf16_t*)(ws + WS_DELTA); bf16_t* POOLED = (bf16_t*)(ws + WS_POOLED); bf16_t* MERGED = XN;

    const bool tail_cvt = (G == 256);
    if (IN(0)) { p0_weights<0>(a, lds, gw, NGW, wave, lane);
        if (!tail_cvt) { p0_weights<1>(a, lds, gw, NGW, wave, lane); p0_weights<2>(a, lds, gw, NGW, wave, lane); }
        p0_norm(a.x, a.n1pre, XN, gw, NGW, lane); }
    SEAM(0);
    if (IN(1)) { pg8::PlainSched S; S.T.init(M, 2 * FF, G, bx, WGM_G); S.A = (const char*)XN; S.B = (const char*)(ws + WS_WGU1); S.tstep = (size_t)256 * D * 2;
        pg8::EpiSwiGLU E{ACT, FF};
        pg8::gemm_phase<pg8::EpiSwiGLU, pg8::PlainSched, PG8_ALIGN, PG8_SP2>(lds, D, S, E);
        if (tail_cvt && bx >= 128) p0_weights<1>(a, lds, (bx - 128) * NWAVES + wave, 128 * NWAVES, wave, lane); }
    SEAM(1);
    if (IN(2)) { pg8::PlainSched S; S.T.init(M, D, G, bx, WGM_D); S.A = (const char*)ACT; S.B = (const char*)(ws + WS_WD1); S.tstep = (size_t)256 * FF * 2;
        pg8::EpiBf16 E{Fb, D};
        pg8::gemm_phase<pg8::EpiBf16, pg8::PlainSched, PG8_ALIGN, PG8_SP2>(lds, FF, S, E); }
    SEAM(2);
    if (IN(3)) norm_phase(lds, Fb, a.x, a.out, XN, a.n1post, a.nmpre, 0.5f, gw, NGW, tid);
    SEAM(3);
    if (IN(4)) { pg8::PlainSched S; S.T.init(M, NIN, G, bx, WGM_G); S.A = (const char*)XN; S.B = (const char*)(ws + WS_WIN); S.tstep = (size_t)256 * D * 2;
        pg8::EpiBf16Sig E{PROJ, NIN, GA_OFF / 256};
        pg8::gemm_phase<pg8::EpiBf16Sig, pg8::PlainSched, PG8_ALIGN, PG8_SP2>(lds, D, S, E); }
    SEAM(4);
    if (IN(5)) { att2::attn_phase(lds, PROJ, (bf16_t*)(ws + WS_OUTG), (float*)(ws + WS_LSE), vcu, G); pool_delta(PROJ, DELTA, gw, NGW, lane); }
    SEAM(5);
    if (IN(6)) { att::attn_merge((const bf16_t*)(ws + WS_OUTG), (const float*)(ws + WS_LSE), ATT, vcu * NTHREADS + tid, G * NTHREADS);
        pg8::PoolSched S; S.T.init(M, 1024, G, bx); S.A = (const char*)DELTA; S.B = (const char*)(ws + WS_WPL); S.tstep = (size_t)256 * 256 * 2; S.gstride = (size_t)M * 256 * 2;
        pg8::EpiPool E{POOLED, 1024, a.poolscale};
        pg8::gemm_phase<pg8::EpiPool, pg8::PoolSched, PG8_ALIGN, PG8_SP2>(lds, 256, S, E); }
    SEAM(6);
    if (IN(7)) { pg8::BranchSched S; S.T.init(M, D, G, bx); S.A0 = (const char*)ATT; S.B0 = (const char*)(ws + WS_WBA); S.A1 = (const char*)POOLED; S.B1 = (const char*)(ws + WS_WBP); S.tstep = (size_t)256 * 1024 * 2;
        pg8::EpiBranch E{MERGED, D, PROJ};
        pg8::gemm_phase<pg8::EpiBranch, pg8::BranchSched, PG8_ALIGN, PG8_SP2>(lds, 1024, S, E); }
    SEAM(7);
    if (IN(8)) { pg8::PlainSched S; S.T.init(M, D, G, bx); S.A = (const char*)MERGED; S.B = (const char*)(ws + WS_WOUT); S.tstep = (size_t)256 * D * 2;
        pg8::EpiBf16 E{Fb, D};
        pg8::gemm_phase<pg8::EpiBf16, pg8::PlainSched, PG8_ALIGN, PG8_SP2>(lds, D, S, E); }
    SEAM(8);
    if (IN(9)) norm_phase(lds, Fb, a.out, a.out, XN, a.nmpost, a.n2pre, 1.0f, gw, NGW, tid);
    SEAM(9);
    if (IN(10)) { pg8::PlainSched S; S.T.init(M, 2 * FF, G, bx, WGM_G); S.A = (const char*)XN; S.B = (const char*)(ws + WS_WGU2); S.tstep = (size_t)256 * D * 2;
        pg8::EpiSwiGLU E{ACT, FF};
        pg8::gemm_phase<pg8::EpiSwiGLU, pg8::PlainSched, PG8_ALIGN, PG8_SP2>(lds, D, S, E);
        if (tail_cvt && bx >= 128) p0_weights<2>(a, lds, (bx - 128) * NWAVES + wave, 128 * NWAVES, wave, lane); }
    SEAM(10);
    if (IN(11)) { pg8::PlainSched S; S.T.init(M, D, G, bx, WGM_D); S.A = (const char*)ACT; S.B = (const char*)(ws + WS_WD2); S.tstep = (size_t)256 * FF * 2;
        pg8::EpiBf16 E{Fb, D};
        pg8::gemm_phase<pg8::EpiBf16, pg8::PlainSched, PG8_ALIGN, PG8_SP2>(lds, FF, S, E); }
    SEAM(11);
    if (IN(12)) norm_phase(lds, Fb, a.out, a.out, nullptr, a.n2post, nullptr, 0.5f, gw, NGW, tid);
#undef IN
#undef SEAM
}

extern "C" void kernel_launch(void* const* d_in, const int* in_sizes, int n_in, void* d_out, int out_size, void* d_ws, size_t ws_size, hipStream_t stream) {
    static int grid = 0;
    if (grid == 0) {
        if (n_in != 19 || in_sizes[0] != M * D || out_size != M * D || ws_size < WS_END) { fprintf(stderr, "kernel_launch: unexpected shapes (n_in %d, in0 %d, out %d, ws %zu < %zu)\n", n_in, n_in > 0 ? in_sizes[0] : -1, out_size, ws_size, (size_t)WS_END); grid = -1; return; }
        int dev = 0, cus = 0, per_cu = 0;
        if (hipGetDevice(&dev) != hipSuccess || hipDeviceGetAttribute(&cus, hipDeviceAttributeMultiprocessorCount, dev) != hipSuccess) { grid = -1; return; }
        if (hipFuncSetAttribute((const void*)mk_fwd, hipFuncAttributeMaxDynamicSharedMemorySize, LDS_BYTES) != hipSuccess) { fprintf(stderr, "kernel_launch: hipFuncSetAttribute failed\n"); grid = -1; return; }
        if (hipOccupancyMaxActiveBlocksPerMultiprocessor(&per_cu, (const void*)mk_fwd, NTHREADS, LDS_BYTES) != hipSuccess || per_cu < 1) { fprintf(stderr, "kernel_launch: occupancy query says %d\n", per_cu); }
        (void)hipGetLastError();
        grid = cus;
    }
    if (grid < 0) return;
    (void)hipMemsetAsync((char*)d_ws + WS_CTL, 0, CTL_ZERO_BYTES, stream);
    Args a{};
    a.x = (const float*)d_in[0]; a.n1pre = (const float*)d_in[1]; a.n1post = (const float*)d_in[2]; a.w1g = (const float*)d_in[3]; a.w1u = (const float*)d_in[4]; a.w1d = (const float*)d_in[5];
    a.nmpre = (const float*)d_in[6]; a.nmpost = (const float*)d_in[7]; a.win = (const float*)d_in[8]; a.poolw = (const float*)d_in[9]; a.poolscale = (const float*)d_in[10];
    a.wab = (const float*)d_in[11]; a.wpb = (const float*)d_in[12]; a.wout = (const float*)d_in[13];
    a.n2pre = (const float*)d_in[14]; a.n2post = (const float*)d_in[15]; a.w2g = (const float*)d_in[16]; a.w2u = (const float*)d_in[17]; a.w2d = (const float*)d_in[18];
    a.out = (float*)d_out; a.ws = (unsigned char*)d_ws;
#if MK_ONE_LAUNCH
    a.ph_lo = 0; a.ph_hi = NPHASE;
    hipLaunchKernelGGL(mk_fwd, dim3(grid), dim3(NTHREADS), LDS_BYTES, stream, a);
#else
    for (int p = 0; p < NPHASE; ++p) { a.ph_lo = p; a.ph_hi = p + 1; hipLaunchKernelGGL(mk_fwd, dim3(grid), dim3(NTHREADS), LDS_BYTES, stream, a); }
#endif
}
```

```cpp
#include <hip/hip_runtime.h>
#include <cstdio>
#include <cstdint>

#ifndef MK_ONE_LAUNCH
#define MK_ONE_LAUNCH 1
#endif

#define LAS __attribute__((address_space(3)))
#define GAS __attribute__((address_space(1)))
typedef unsigned short bf16_t;
typedef short bf16x8 __attribute__((ext_vector_type(8)));
typedef float f32x4 __attribute__((ext_vector_type(4)));
typedef float f32x2 __attribute__((ext_vector_type(2)));
typedef unsigned u32x4 __attribute__((ext_vector_type(4)));
typedef unsigned u32x2 __attribute__((ext_vector_type(2)));

constexpr int BATCH = 4, SEQ = 4096, M = BATCH * SEQ, D = 4096, FF = 11008, NIN = 18432;
constexpr int POOL_OFF = 9216, GA_OFF = 10240, GP_OFF = 14336;
constexpr float RMS_EPS = 1e-6f;
constexpr int NWAVES = 8, NTHREADS = 512;

constexpr size_t MiB = (size_t)1 << 20;
constexpr size_t WS_CTL = 0, CTL_ZERO_BYTES = 1 * MiB;
constexpr size_t WS_WGU1 = 1 * MiB;
constexpr size_t WS_WD1 = 173 * MiB;
constexpr size_t WS_WIN = 259 * MiB;
constexpr size_t WS_WOUT = 403 * MiB;
constexpr size_t WS_WBA = 435 * MiB;
constexpr size_t WS_WBP = 443 * MiB;
constexpr size_t WS_WPL = 451 * MiB;
constexpr size_t WS_WGU2 = 452 * MiB;
constexpr size_t WS_WD2 = 624 * MiB;
constexpr size_t WS_XN = 710 * MiB;
constexpr size_t WS_ACT = 838 * MiB;
constexpr size_t WS_F = 1182 * MiB;
constexpr size_t WS_PROJ = 838 * MiB;
constexpr size_t WS_ATTN = 1438 * MiB;
constexpr size_t WS_DELTA = 1470 * MiB;
constexpr size_t WS_POOLED = 1502 * MiB;
constexpr size_t WS_T1 = 1534 * MiB;
constexpr size_t WS_OUTG = WS_XN;
constexpr size_t WS_LSE = WS_XN + 96 * MiB;
constexpr size_t WS_END = 1598 * MiB;
static_assert(WS_PROJ + (size_t)M * NIN * 2 <= WS_ATTN, "proj overlay");
constexpr int CW_BAR = 4096;

__device__ __forceinline__ unsigned cvt_pk_bf16(float lo, float hi) { unsigned r; asm volatile("v_cvt_pk_bf16_f32 %0, %1, %2" : "=v"(r) : "v"(lo), "v"(hi)); return r; }
__device__ __forceinline__ float bf_lo(unsigned w) { return __uint_as_float(w << 16); }
__device__ __forceinline__ float bf_hi(unsigned w) { return __uint_as_float(w & 0xffff0000u); }
__device__ __forceinline__ float wave_sum(float v) {
#pragma unroll
    for (int o = 1; o < 64; o <<= 1) v += __shfl_xor(v, o);
    return v;
}
__device__ __forceinline__ float fast_sigmoid(float x) { return __builtin_amdgcn_rcpf(1.0f + __builtin_amdgcn_exp2f(-1.4426950408889634f * x)); }

#define XB_TMO      128
#define XB_XCNT(j)  (256  + 64 * (j))
#define XB_XSUB(j)  (1280 + 64 * (j))
#define XB_XGEN(j)  (2304 + 64 * (j))
#define XB_TOP      3328
#define XB_TOPGEN   3392
#define XCD_BAR_WORDS 3456
#define XB_SPIN_CAP (1u << 18)

__device__ __forceinline__ unsigned xb_ld(unsigned* p)              { return __hip_atomic_load(p, __ATOMIC_RELAXED, __HIP_MEMORY_SCOPE_AGENT); }
__device__ __forceinline__ unsigned xb_add(unsigned* p, unsigned v) { return __hip_atomic_fetch_add(p, v, __ATOMIC_RELAXED, __HIP_MEMORY_SCOPE_AGENT); }
__device__ __forceinline__ unsigned xb_xcc_id() { return (unsigned)__builtin_amdgcn_s_getreg((3 << 11) | 20) & 0xFu; }
#define XB_SPIN(cond, bar) do { unsigned _sp = 0; while (cond) { __builtin_amdgcn_s_sleep(1); \
    if ((++_sp & 255u) == 0u) { if (xb_ld(&(bar)[XB_TMO])) break; if (_sp > XB_SPIN_CAP) { atomicAdd(&(bar)[XB_TMO], 1u); break; } } } } while (0)

struct XcdBarrier { unsigned* bar; unsigned x; volatile LAS unsigned* st; };

__device__ __forceinline__ XcdBarrier xcd_barrier_post(unsigned* bar, volatile LAS unsigned* st) {
    XcdBarrier b; b.bar = bar; b.x = xb_xcc_id(); b.st = st;
    if (threadIdx.x == 0) (void)xb_add(&bar[XB_XCNT(b.x)], 1u);
    return b;
}
__device__ __forceinline__ void xcd_barrier_complete(unsigned* bar, unsigned x, unsigned& nloc, unsigned& nx) {
    const unsigned G = gridDim.x * gridDim.y * gridDim.z;
    unsigned sum, cnt, mine, sp = 0u;
    for (;;) {
        sum = 0u; cnt = 0u; mine = 0u;
#pragma unroll
        for (unsigned j = 0; j < 16; ++j) { const unsigned c = xb_ld(&bar[XB_XCNT(j)]); sum += c; cnt += (c > 0u) ? 1u : 0u; mine = (j == x) ? c : mine; }
        if (sum == G) break;
        __builtin_amdgcn_s_sleep(1);
        if ((++sp & 255u) == 0u) { if (xb_ld(&bar[XB_TMO])) break; if (sp > XB_SPIN_CAP) { atomicAdd(&bar[XB_TMO], 1u); break; } }
    }
    nloc = mine > 0u ? mine : 1u; nx = cnt > 0u ? cnt : 1u;
}
__device__ __forceinline__ void xcd_barrier(const XcdBarrier& b) {
    asm volatile("s_waitcnt vmcnt(0)" ::: "memory");
    __syncthreads();
    if (threadIdx.x == 0) {
        unsigned* bar = b.bar;
        __builtin_amdgcn_s_waitcnt(0);
        unsigned nloc = b.st[0], nx = b.st[1];
        if (nloc == 0u) { xcd_barrier_complete(bar, b.x, nloc, nx); b.st[0] = nloc; b.st[1] = nx; }
        const unsigned old = xb_add(&bar[XB_XSUB(b.x)], 1u);
        const unsigned gen = old / nloc;
        if (old + 1u == (gen + 1u) * nloc) {
            __builtin_amdgcn_fence(__ATOMIC_RELEASE, "agent");
            asm volatile("s_waitcnt vmcnt(0)" ::: "memory");
            const unsigned og = xb_add(&bar[XB_TOP], 1u);
            const unsigned tg = og / nx;
            if (og + 1u == (tg + 1u) * nx) xb_add(&bar[XB_TOPGEN], 1u);
            else XB_SPIN(xb_ld(&bar[XB_TOPGEN]) == tg, bar);
            __builtin_amdgcn_fence(__ATOMIC_ACQUIRE, "agent");
            xb_add(&bar[XB_XGEN(b.x)], 1u);
            asm volatile("s_waitcnt vmcnt(0)" ::: "memory");
        } else {
            XB_SPIN(xb_ld(&bar[XB_XGEN(b.x)]) == gen, bar);
            __builtin_amdgcn_fence(__ATOMIC_ACQUIRE, "agent");
            asm volatile("s_waitcnt vmcnt(0)" ::: "memory");
        }
    }
    __syncthreads();
}

namespace pg8 {
constexpr int BM = 256, BK = 64, HALF = 128, HTB = HALF * BK * 2, STAGE_BYTES = 8 * HTB, NXCD = 8, WGM = 8;
__host__ __device__ __forceinline__ int lds_byte(int r, int c) { const int st = (r >> 4) * 2 + (c >> 5), rr = r & 15, cc = c & 31, ob = rr * 64 + cc * 2; return st * 1024 + (ob ^ (((ob >> 9) & 1) << 5)); }
__host__ __device__ __forceinline__ void stage_rc(int b, int& R, int& C) { const int st = b / 1024, sb = b % 1024, swz = sb ^ (((sb >> 9) & 1) << 5); R = (st >> 1) * 16 + swz / 64; C = (st & 1) * 32 + (swz % 64) / 2; }
__host__ __device__ __forceinline__ int perm32(int rho) { const int n = rho >> 4, i = rho & 15; return 8 * (i >> 2) + 4 * n + (i & 3); }

struct Unit { int pm, pn, sub; };
struct TileOrder {
    int nM, nN, nwg, G, c, wgm;
    __device__ __forceinline__ void init(int Mr, int Nc, int G_, int c_, int wgm_ = WGM) { nM = Mr / BM; nN = Nc / BM; nwg = nM * nN; G = G_; c = c_; wgm = wgm_; }
    __device__ __forceinline__ bool at(long L, int& pm, int& pn) const {
        if (L >= nwg) return false;
        int wgid = (int)L; { const int q = nwg / NXCD, r = nwg % NXCD, xcd = wgid % NXCD, off = wgid / NXCD; wgid = (xcd < r ? xcd * (q + 1) : r * (q + 1) + (xcd - r) * q) + off; }
        const int nig = wgm * nN, gid = wgid / nig, fm = gid * wgm, gsz = (nM - fm) < wgm ? (nM - fm) : wgm;
        pm = fm + ((wgid % nig) % gsz); pn = (wgid % nig) / gsz; return true;
    }
};
struct PlainSched {
    TileOrder T; const char* A; const char* B; size_t tstep;
    __device__ __forceinline__ bool next(int i, Unit& u) const { u.sub = 0; return T.at((long)i * T.G + T.c, u.pm, u.pn); }
    __device__ __forceinline__ const char* aptr(const Unit& u) const { return A + (size_t)u.pm * tstep; }
    __device__ __forceinline__ const char* bptr(const Unit& u) const { return B + (size_t)u.pn * tstep; }
};
struct BranchSched {
    TileOrder T; const char* A0; const char* B0; const char* A1; const char* B1; size_t tstep;
    __device__ __forceinline__ bool next(int i, Unit& u) const { u.sub = i & 1; return T.at((long)(i >> 1) * T.G + T.c, u.pm, u.pn); }
    __device__ __forceinline__ const char* aptr(const Unit& u) const { return (u.sub ? A1 : A0) + (size_t)u.pm * tstep; }
    __device__ __forceinline__ const char* bptr(const Unit& u) const { return (u.sub ? B1 : B0) + (size_t)u.pn * tstep; }
};
struct PoolSched {
    TileOrder T; const char* A; const char* B; size_t tstep, gstride;
    __device__ __forceinline__ bool next(int i, Unit& u) const { u.sub = 0; return T.at((long)i * T.G + T.c, u.pm, u.pn); }
    __device__ __forceinline__ const char* aptr(const Unit& u) const { return A + (size_t)u.pn * gstride + (size_t)u.pm * tstep; }
    __device__ __forceinline__ const char* bptr(const Unit& u) const { return B + (size_t)u.pn * tstep; }
};

struct EpiSwiGLU {
    static constexpr bool PERM = true, KEEP_SUB0 = false;
    bf16_t* O; int ldc;
    __device__ __forceinline__ void operator()(const f32x4 (&acc)[2][2][4][2], const Unit& u, int wr, int wc, int fr, int fq) const {
        const int row0 = u.pm * BM + wr * 64 + fr, col0 = u.pn * HALF + wc * 32 + 8 * fq;
#pragma unroll
        for (int ai = 0; ai < 2; ++ai)
#pragma unroll
            for (int m = 0; m < 4; ++m) { bf16_t* rowp = O + (size_t)(row0 + ai * HALF + m * 16) * ldc + col0;
                float o[8];
#pragma unroll
                for (int n = 0; n < 2; ++n)
#pragma unroll
                    for (int j = 0; j < 4; ++j) { const float g = acc[ai][0][m][n][j], uu = acc[ai][1][m][n][j]; o[n * 4 + j] = g * fast_sigmoid(g) * uu; }
                u32x4 w; w.x = cvt_pk_bf16(o[0], o[1]); w.y = cvt_pk_bf16(o[2], o[3]); w.z = cvt_pk_bf16(o[4], o[5]); w.w = cvt_pk_bf16(o[6], o[7]);
                *(u32x4*)rowp = w; }
    }
};
struct EpiBf16 {
    static constexpr bool PERM = true, KEEP_SUB0 = false;
    bf16_t* O; int ldc;
    __device__ __forceinline__ void operator()(const f32x4 (&acc)[2][2][4][2], const Unit& u, int wr, int wc, int fr, int fq) const {
        const int row0 = u.pm * BM + wr * 64 + fr, col0 = u.pn * BM + wc * 32 + 8 * fq;
#pragma unroll
        for (int ai = 0; ai < 2; ++ai)
#pragma unroll
            for (int m = 0; m < 4; ++m) { bf16_t* rowp = O + (size_t)(row0 + ai * HALF + m * 16) * ldc + col0;
#pragma unroll
                for (int bj = 0; bj < 2; ++bj) { const f32x4 v0 = acc[ai][bj][m][0], v1 = acc[ai][bj][m][1];
                    u32x4 w; w.x = cvt_pk_bf16(v0[0], v0[1]); w.y = cvt_pk_bf16(v0[2], v0[3]); w.z = cvt_pk_bf16(v1[0], v1[1]); w.w = cvt_pk_bf16(v1[2], v1[3]);
                    *(u32x4*)(rowp + bj * HALF) = w; } }
    }
};
struct EpiBf16Sig {
    static constexpr bool PERM = true, KEEP_SUB0 = false;
    bf16_t* O; int ldc; int sig_from;
    __device__ __forceinline__ void operator()(const f32x4 (&acc)[2][2][4][2], const Unit& u, int wr, int wc, int fr, int fq) const {
        const int row0 = u.pm * BM + wr * 64 + fr, col0 = u.pn * BM + wc * 32 + 8 * fq; const bool sg = u.pn >= sig_from;
#pragma unroll
        for (int ai = 0; ai < 2; ++ai)
#pragma unroll
            for (int m = 0; m < 4; ++m) { bf16_t* rowp = O + (size_t)(row0 + ai * HALF + m * 16) * ldc + col0;
#pragma unroll
                for (int bj = 0; bj < 2; ++bj) { f32x4 v0 = acc[ai][bj][m][0], v1 = acc[ai][bj][m][1];
                    if (sg) {
#pragma unroll
                        for (int j = 0; j < 4; ++j) { v0[j] = fast_sigmoid(v0[j]); v1[j] = fast_sigmoid(v1[j]); } }
                    u32x4 w; w.x = cvt_pk_bf16(v0[0], v0[1]); w.y = cvt_pk_bf16(v0[2], v0[3]); w.z = cvt_pk_bf16(v1[0], v1[1]); w.w = cvt_pk_bf16(v1[2], v1[3]);
                    *(u32x4*)(rowp + bj * HALF) = w; } }
    }
};
struct EpiPool {
    static constexpr bool PERM = true, KEEP_SUB0 = false;
    bf16_t* O; int ldc; const float* scale;
    __device__ __forceinline__ void operator()(const f32x4 (&acc)[2][2][4][2], const Unit& u, int, int, int, int) const {
        int tz = threadIdx.x; asm volatile("" : "+v"(tz));
        const int wid = tz >> 6, lane = tz & 63, wr = wid >> 2, wc = wid & 3, fr = lane & 15, fq = lane >> 4;
        const int row0 = u.pm * BM + wr * 64 + fr, col0 = u.pn * BM + wc * 32 + 8 * fq;
#pragma unroll
        for (int bj = 0; bj < 2; ++bj) { const f32x4 sv0 = *(const f32x4*)(scale + col0 + bj * HALF), sv1 = *(const f32x4*)(scale + col0 + bj * HALF + 4);
#pragma unroll
            for (int ai = 0; ai < 2; ++ai)
#pragma unroll
                for (int m = 0; m < 4; ++m) { bf16_t* rowp = O + (size_t)(row0 + ai * HALF + m * 16) * ldc + col0;
                    const f32x4 v0 = acc[ai][bj][m][0] * sv0, v1 = acc[ai][bj][m][1] * sv1;
                    u32x4 w; w.x = cvt_pk_bf16(v0[0], v0[1]); w.y = cvt_pk_bf16(v0[2], v0[3]); w.z = cvt_pk_bf16(v1[0], v1[1]); w.w = cvt_pk_bf16(v1[2], v1[3]);
                    *(u32x4*)(rowp + bj * HALF) = w; } }
    }
};
struct EpiBranch {
    static constexpr bool PERM = true, KEEP_SUB0 = true;
    bf16_t* O; int ldc; const bf16_t* proj;
    __device__ __forceinline__ void operator()(f32x4 (&acc)[2][2][4][2], const Unit& u, int, int, int, int) const {
        int tz = threadIdx.x; asm volatile("" : "+v"(tz));
        const int wid = tz >> 6, lane = tz & 63, wr = wid >> 2, wc = wid & 3, fr = lane & 15, fq = lane >> 4;
        const int row0 = u.pm * BM + wr * 64 + fr, col0 = u.pn * BM + wc * 32 + 8 * fq;
        if (u.sub == 0) {
#pragma unroll
            for (int ai = 0; ai < 2; ++ai)
#pragma unroll
                for (int mh = 0; mh < 2; ++mh) {
                    u32x4 ga[2][2], gp[2][2];
#pragma unroll
                    for (int mm = 0; mm < 2; ++mm)
#pragma unroll
                        for (int bj = 0; bj < 2; ++bj) { const bf16_t* gpt = proj + (size_t)(row0 + ai * HALF + (2 * mh + mm) * 16) * NIN + col0 + bj * HALF;
                            ga[mm][bj] = *(const u32x4*)(gpt + GA_OFF); gp[mm][bj] = *(const u32x4*)(gpt + GP_OFF); }
#pragma unroll
                    for (int mm = 0; mm < 2; ++mm)
#pragma unroll
                        for (int bj = 0; bj < 2; ++bj) { const int m = 2 * mh + mm;
#pragma unroll
                            for (int k = 0; k < 4; ++k) { const unsigned aw = ga[mm][bj][k], pw = gp[mm][bj][k];
                                const float r0 = bf_lo(aw) * __builtin_amdgcn_rcpf(fmaxf(bf_lo(pw), 1e-6f)), r1 = bf_hi(aw) * __builtin_amdgcn_rcpf(fmaxf(bf_hi(pw), 1e-6f));
                                acc[ai][bj][m][k >> 1][2 * (k & 1)] *= r0; acc[ai][bj][m][k >> 1][2 * (k & 1) + 1] *= r1; } }
                    asm volatile("" ::: "memory"); }
        } else {
#pragma unroll
            for (int ai = 0; ai < 2; ++ai) {
                u32x4 gp[4][2];
#pragma unroll
                for (int m = 0; m < 4; ++m)
#pragma unroll
                    for (int bj = 0; bj < 2; ++bj) gp[m][bj] = *(const u32x4*)(proj + (size_t)(row0 + ai * HALF + m * 16) * NIN + GP_OFF + col0 + bj * HALF);
#pragma unroll
                for (int m = 0; m < 4; ++m)
#pragma unroll
                    for (int bj = 0; bj < 2; ++bj) { u32x4 w;
#pragma unroll
                        for (int k = 0; k < 4; ++k) { const unsigned pw = gp[m][bj][k];
                            w[k] = cvt_pk_bf16(acc[ai][bj][m][k >> 1][2 * (k & 1)] * fmaxf(bf_lo(pw), 1e-6f), acc[ai][bj][m][k >> 1][2 * (k & 1) + 1] * fmaxf(bf_hi(pw), 1e-6f)); }
                        *(u32x4*)(O + (size_t)(row0 + ai * HALF + m * 16) * ldc + col0 + bj * HALF) = w; }
                asm volatile("" ::: "memory"); }
        }
    }
};

template <class Epi, class Sched, bool ALIGN_EPI, bool SP2>
__device__ __forceinline__ void gemm_phase(LAS unsigned char* lds, const int K, const Sched& S, const Epi& E) {
    int tid = threadIdx.x; asm volatile("" : "+v"(tid));
    const int wid = __builtin_amdgcn_readfirstlane(tid >> 6), lane = tid & 63, wr = wid >> 2, wc = wid & 3, fr = lane & 15, fq = lane >> 4;
    const int nt = K / BK;
    unsigned voffA[2], voffB[2];
#pragma unroll
    for (int i = 0; i < 2; ++i) { int R, C; stage_rc(tid * 16 + i * 8192, R, C);
        voffA[i] = (unsigned)(R * K + C) * 2u; voffB[i] = (unsigned)(tid * 16 + i * 8192); }
    const size_t kstep = (size_t)(BK * 2), kstepB = (size_t)HTB;
    const size_t hstep = (size_t)HALF * K * 2;
    const unsigned ldsw = (unsigned)wid * 1024u;
    const int aoff = lds_byte(wr * 64 + fr, fq * 8), boff = lds_byte(wc * 32 + fr, fq * 8);
#define PG8_SA(b, h) (((b) * 2 + (h)) * HTB)
#define PG8_SB(b, h) ((4 + (b) * 2 + (h)) * HTB)
#define PG8_STAGE(bufoff, gbase, voff) do { _Pragma("unroll") for (int _i = 0; _i < 2; ++_i) \
        __builtin_amdgcn_global_load_lds((const unsigned*)((const char*)(gbase) + (voff)[_i]), (LAS unsigned*)(lds + (bufoff) + ldsw + _i * 8192), 16, 0, 0); } while (0)
#define PG8_LDA(dst, b, h) do { _Pragma("unroll") for (int m = 0; m < 4; ++m) _Pragma("unroll") for (int k = 0; k < 2; ++k) dst[m][k] = *(const LAS bf16x8*)(lds + PG8_SA(b, h) + aoff + m * 2048 + k * 1024); } while (0)
#define PG8_LDB(dst, b, h) do { _Pragma("unroll") for (int n = 0; n < 2; ++n) _Pragma("unroll") for (int k = 0; k < 2; ++k) dst[n][k] = *(const LAS bf16x8*)(lds + PG8_SB(b, h) + boff + n * 2048 + k * 1024); } while (0)
#define PG8_MMA(ai, bj, At, Bt) do { __builtin_amdgcn_s_setprio(1); _Pragma("unroll") for (int m = 0; m < 4; ++m) _Pragma("unroll") for (int n = 0; n < 2; ++n) _Pragma("unroll") for (int k = 0; k < 2; ++k) \
        acc[ai][bj][m][n] = __builtin_amdgcn_mfma_f32_16x16x32_bf16(Bt[n][k], At[m][k], acc[ai][bj][m][n], 0, 0, 0); __builtin_amdgcn_s_setprio(0); } while (0)
#define PG8_WAIT_V(n) asm volatile("s_waitcnt vmcnt(" #n ")" ::: "memory")
#define PG8_WAIT_L(n) asm volatile("s_waitcnt lgkmcnt(" #n ")" ::: "memory")
#define PG8_BAR __builtin_amdgcn_s_barrier()
#define PG8_SCHED __builtin_amdgcn_sched_barrier(0)
    Unit cur, nxt; int ui = 0;
    if (!S.next(0, cur)) return;
    f32x4 acc[2][2][4][2];
#pragma unroll
    for (int a = 0; a < 2; ++a)
#pragma unroll
        for (int b = 0; b < 2; ++b)
#pragma unroll
            for (int m = 0; m < 4; ++m)
#pragma unroll
                for (int n = 0; n < 2; ++n) acc[a][b][m][n] = (f32x4){0.f, 0.f, 0.f, 0.f};
    bf16x8 At[4][2], B0[2][2], B1[2][2];
    const char* cA = S.aptr(cur); const char* cB = S.bptr(cur);
    if constexpr (SP2) {
        PG8_STAGE(PG8_SB(0, 0), cB, voffB); PG8_STAGE(PG8_SB(0, 1), cB + hstep, voffB); PG8_STAGE(PG8_SA(0, 0), cA, voffA); PG8_STAGE(PG8_SA(0, 1), cA + hstep, voffA);
        if (wr == 1) PG8_BAR;
        PG8_WAIT_V(2); PG8_BAR;
        PG8_STAGE(PG8_SB(1, 0), cB + kstepB, voffB); PG8_STAGE(PG8_SA(1, 0), cA + kstep, voffA); PG8_STAGE(PG8_SB(1, 1), cB + hstep + kstepB, voffB);
        PG8_WAIT_V(6); PG8_BAR;
    } else {
        PG8_STAGE(PG8_SB(0, 0), cB, voffB); PG8_STAGE(PG8_SA(0, 0), cA, voffA); PG8_STAGE(PG8_SB(0, 1), cB + hstep, voffB); PG8_STAGE(PG8_SA(0, 1), cA + hstep, voffA);
        if (wr == 1) PG8_BAR;
        PG8_WAIT_V(4); PG8_BAR;
        PG8_STAGE(PG8_SB(1, 0), cB + kstepB, voffB); PG8_STAGE(PG8_SA(1, 0), cA + kstep, voffA); PG8_STAGE(PG8_SB(1, 1), cB + hstep + kstepB, voffB);
        PG8_WAIT_V(6); PG8_BAR;
    }
    for (;;) {
        const bool has_next = S.next(ui + 1, nxt);
        const char* nA = has_next ? S.aptr(nxt) : cA; const char* nB = has_next ? S.bptr(nxt) : cB;
#pragma unroll 1
        for (int t = 0; t < nt; t += 2) {
            const bool last = (t == nt - 2);
            const char* a1 = cA + (size_t)(t + 1) * kstep;
            const char* a2 = last ? nA : cA + (size_t)(t + 2) * kstep; const char* b2 = last ? nB : cB + (size_t)(t + 2) * kstepB;
            const char* a3 = a2 + kstep; const char* b3 = b2 + kstepB;
            if constexpr (SP2) {
            PG8_LDB(B0, 0, 0); PG8_LDB(B1, 0, 1); PG8_SCHED; PG8_LDA(At, 0, 0); PG8_STAGE(PG8_SA(1, 1), a1 + hstep, voffA);
            PG8_WAIT_V(8); PG8_WAIT_L(0); PG8_BAR; PG8_MMA(0, 0, At, B0); PG8_MMA(0, 1, At, B1); PG8_BAR; PG8_SCHED;
            PG8_LDA(At, 0, 1); PG8_STAGE(PG8_SB(0, 0), b2, voffB); PG8_STAGE(PG8_SB(0, 1), b2 + hstep, voffB); PG8_STAGE(PG8_SA(0, 0), a2, voffA);
            PG8_WAIT_V(8); PG8_WAIT_L(0); PG8_BAR; PG8_MMA(1, 0, At, B0); PG8_MMA(1, 1, At, B1); PG8_BAR; PG8_SCHED;
            PG8_LDB(B0, 1, 0); PG8_LDB(B1, 1, 1); PG8_SCHED; PG8_LDA(At, 1, 0); PG8_STAGE(PG8_SA(0, 1), a2 + hstep, voffA);
            PG8_WAIT_V(8); PG8_WAIT_L(0); PG8_BAR; PG8_MMA(0, 0, At, B0); PG8_MMA(0, 1, At, B1); PG8_BAR; PG8_SCHED;
            PG8_LDA(At, 1, 1); PG8_STAGE(PG8_SB(1, 0), b3, voffB); PG8_STAGE(PG8_SB(1, 1), b3 + hstep, voffB); PG8_STAGE(PG8_SA(1, 0), a3, voffA);
            PG8_WAIT_V(8); PG8_WAIT_L(0); PG8_BAR; PG8_MMA(1, 0, At, B0); PG8_MMA(1, 1, At, B1); PG8_BAR; PG8_SCHED;
            } else {
            PG8_LDB(B0, 0, 0); PG8_SCHED; PG8_LDA(At, 0, 0); PG8_STAGE(PG8_SA(1, 1), a1 + hstep, voffA);
            PG8_WAIT_L(8); PG8_BAR; PG8_WAIT_L(0); PG8_MMA(0, 0, At, B0); PG8_BAR; PG8_SCHED;
            PG8_LDB(B1, 0, 1); PG8_STAGE(PG8_SB(0, 0), b2, voffB);
            PG8_BAR; PG8_WAIT_L(0); PG8_MMA(0, 1, At, B1); PG8_BAR;
            PG8_LDA(At, 0, 1); PG8_STAGE(PG8_SA(0, 0), a2, voffA);
            PG8_BAR; PG8_WAIT_L(0); PG8_MMA(1, 0, At, B0); PG8_BAR; PG8_SCHED;
            PG8_STAGE(PG8_SB(0, 1), b2 + hstep, voffB);
            PG8_WAIT_V(6); PG8_BAR; PG8_MMA(1, 1, At, B1); PG8_BAR;
            PG8_LDB(B0, 1, 0); PG8_SCHED; PG8_LDA(At, 1, 0); PG8_STAGE(PG8_SA(0, 1), a2 + hstep, voffA);
            PG8_WAIT_L(8); PG8_BAR; PG8_WAIT_L(0); PG8_MMA(0, 0, At, B0); PG8_BAR; PG8_SCHED;
            PG8_LDB(B1, 1, 1); PG8_STAGE(PG8_SB(1, 0), b3, voffB);
            PG8_BAR; PG8_WAIT_L(0); PG8_MMA(0, 1, At, B1); PG8_BAR;
            PG8_LDA(At, 1, 1); PG8_STAGE(PG8_SA(1, 0), a3, voffA);
            PG8_BAR; PG8_WAIT_L(0); PG8_MMA(1, 0, At, B0); PG8_BAR; PG8_SCHED;
            PG8_STAGE(PG8_SB(1, 1), b3 + hstep, voffB);
            PG8_WAIT_V(6); PG8_BAR; PG8_MMA(1, 1, At, B1); PG8_BAR;
            }
        }
        if constexpr (ALIGN_EPI) { if (wr == 0) PG8_BAR; }
        E(acc, cur, wr, wc, fr, fq);
        if (!has_next) break;
        if (!(Epi::KEEP_SUB0 && cur.sub == 0)) {
#pragma unroll
        for (int a = 0; a < 2; ++a)
#pragma unroll
            for (int b = 0; b < 2; ++b)
#pragma unroll
                for (int m = 0; m < 4; ++m)
#pragma unroll
                    for (int n = 0; n < 2; ++n) acc[a][b][m][n] = (f32x4){0.f, 0.f, 0.f, 0.f}; }
        cur = nxt; cA = nA; cB = nB; ++ui;
        if constexpr (ALIGN_EPI) { if (wr == 1) PG8_BAR; }
    }
    PG8_WAIT_V(0);
    if constexpr (!ALIGN_EPI) { if (wr == 0) PG8_BAR; }
    PG8_BAR;
#undef PG8_SA
#undef PG8_SB
#undef PG8_STAGE
#undef PG8_LDA
#undef PG8_LDB
#undef PG8_MMA
#undef PG8_WAIT_V
#undef PG8_WAIT_L
#undef PG8_BAR
#undef PG8_SCHED
}
}

#ifndef WGM_G
#define WGM_G 8
#endif
#ifndef WGM_D
#define WGM_D 4
#endif
#ifndef PG8_SP2
#define PG8_SP2 true
#endif
#ifndef PG8_ALIGN
#define PG8_ALIGN true
#endif

constexpr int RING_BYTES = 131072;
constexpr int LDS_BYTES = 147456;
constexpr int MISC_OFF = LDS_BYTES - 256;

struct Args {
    const float* x; const float* n1pre; const float* n1post; const float* w1g; const float* w1u; const float* w1d;
    const float* nmpre; const float* nmpost; const float* win; const float* poolw; const float* poolscale; const float* wab; const float* wpb; const float* wout;
    const float* n2pre; const float* n2post; const float* w2g; const float* w2u; const float* w2d;
    float* out; unsigned char* ws; int ph_lo, ph_hi;
};

__device__ __forceinline__ void transpose_item(const float* W, int K, int N, bf16_t* WT, int mode, LAS float* scr, int item, int lane) {
    const int nblk = N / 32, kb = item / nblk, nb = item % nblk, k0 = 64 * kb, n0 = 32 * nb;
    int drow = n0;
    if (mode == 1) drow = (n0 >> 7) * 256 + (n0 & 127);
    else if (mode == 2) drow = (n0 >> 7) * 256 + 128 + (n0 & 127);
#pragma unroll 8
    for (int i = 0; i < 32; ++i) { const int kk = 2 * i + (lane >> 5); scr[kk * 33 + (lane & 31)] = W[(size_t)(k0 + kk) * N + n0 + (lane & 31)]; }
    asm volatile("s_waitcnt lgkmcnt(0)" ::: "memory");
    const int c = lane & 7;
    unsigned char* blk = (unsigned char*)WT + ((size_t)(drow >> 7) * (K / 64) + kb) * 16384;
#pragma unroll
    for (int j = 0; j < 4; ++j) { const int n = (lane >> 3) + 8 * j; const LAS float* s = scr + (8 * c) * 33 + n;
        u32x4 o; o.x = cvt_pk_bf16(s[0 * 33], s[1 * 33]); o.y = cvt_pk_bf16(s[2 * 33], s[3 * 33]); o.z = cvt_pk_bf16(s[4 * 33], s[5 * 33]); o.w = cvt_pk_bf16(s[6 * 33], s[7 * 33]);
        const int slot = 16 * ((n >> 2) & 1) + 4 * (n >> 3) + (n & 3);
        *(u32x4*)(blk + pg8::lds_byte((drow & 127) + slot, 8 * c)) = o; }
    asm volatile("s_waitcnt lgkmcnt(0)" ::: "memory");
}

template <int SET> __device__ __forceinline__ void p0_weights(const Args& a, LAS unsigned char* lds, int gw, int NGW, int wave, int lane) {
    asm volatile("" : "+v"(lane));
    LAS float* scr = (LAS float*)(lds + wave * 16384);
    unsigned char* ws = a.ws;
    constexpr int I_GU = (D / 64) * (FF / 32), I_DN = (FF / 64) * (D / 32), I_IN = (D / 64) * (NIN / 32), I_OUT = (D / 64) * (D / 32), I_BR = (1024 / 64) * (D / 32), I_PL = (256 / 64) * (256 / 32);
    constexpr int NITEMS = SET == 0 ? 4 * I_GU + I_DN + I_OUT + 2 * I_BR + 4 * I_PL : (SET == 1 ? I_IN : I_DN);
    for (int it = gw; it < NITEMS; it += NGW) {
        int r = it; const float* W; int K, N, mode = 0; bf16_t* WT;
        if (SET == 1) { W = a.win; K = D; N = NIN; WT = (bf16_t*)(ws + WS_WIN); }
        else if (SET == 2) { W = a.w2d; K = FF; N = D; WT = (bf16_t*)(ws + WS_WD2); }
        else if (r < I_GU) { W = a.w1g; K = D; N = FF; WT = (bf16_t*)(ws + WS_WGU1); mode = 1; }
        else if ((r -= I_GU) < I_GU) { W = a.w1u; K = D; N = FF; WT = (bf16_t*)(ws + WS_WGU1); mode = 2; }
        else if ((r -= I_GU) < I_GU) { W = a.w2g; K = D; N = FF; WT = (bf16_t*)(ws + WS_WGU2); mode = 1; }
        else if ((r -= I_GU) < I_GU) { W = a.w2u; K = D; N = FF; WT = (bf16_t*)(ws + WS_WGU2); mode = 2; }
        else if ((r -= I_GU) < I_DN) { W = a.w1d; K = FF; N = D; WT = (bf16_t*)(ws + WS_WD1); }
        else if ((r -= I_DN) < I_OUT) { W = a.wout; K = D; N = D; WT = (bf16_t*)(ws + WS_WOUT); }
        else if ((r -= I_OUT) < I_BR) { W = a.wab; K = 1024; N = D; WT = (bf16_t*)(ws + WS_WBA); }
        else if ((r -= I_BR) < I_BR) { W = a.wpb; K = 1024; N = D; WT = (bf16_t*)(ws + WS_WBP); }
        else { r -= I_BR; const int g = r / I_PL; r -= g * I_PL; W = a.poolw + (size_t)g * 65536; K = 256; N = 256; WT = (bf16_t*)(ws + WS_WPL) + (size_t)g * 65536; }
        transpose_item(W, K, N, WT, mode, scr, r, lane);
    }
}

__device__ __forceinline__ void p0_norm(const float* x, const float* gain, bf16_t* xn, int gw, int NGW, int lane) {
    asm volatile("" : "+v"(lane));
    for (int m = gw; m < M; m += NGW) {
        const f32x4* xr = (const f32x4*)(x + (size_t)m * D) + lane; const f32x4* gr = (const f32x4*)gain + lane;
        f32x4 v[16]; float s = 0.f;
#pragma unroll
        for (int j = 0; j < 16; ++j) { v[j] = xr[64 * j]; s += (v[j][0] * v[j][0] + v[j][1] * v[j][1]) + (v[j][2] * v[j][2] + v[j][3] * v[j][3]); }
        const float rstd = 1.0f / sqrtf(wave_sum(s) * (1.0f / D) + RMS_EPS);
        u32x2* o = (u32x2*)(xn + (size_t)m * D) + lane;
#pragma unroll
        for (int j = 0; j < 16; ++j) { const f32x4 g = gr[64 * j]; u32x2 w; w.x = cvt_pk_bf16(v[j][0] * rstd * g[0], v[j][1] * rstd * g[1]); w.y = cvt_pk_bf16(v[j][2] * rstd * g[2], v[j][3] * rstd * g[3]); o[64 * j] = w; }
    }
}

__device__ __forceinline__ void norm_phase(LAS unsigned char* lds, const bf16_t* f, const float* base, float* hout, bf16_t* xn, const float* gpost, const float* gpre, float coef, int gw, int NGW, int tid) {
    asm volatile("" : "+v"(tid));
    const int lane = tid & 63;
    LAS f32x4* G1 = (LAS f32x4*)lds; LAS f32x4* G2 = (LAS f32x4*)(lds + 16384);
    for (int i = tid; i < D / 4; i += NTHREADS) { G1[i] = ((const f32x4*)gpost)[i]; if (xn) G2[i] = ((const f32x4*)gpre)[i]; }
    __syncthreads();
    for (int m = gw; m < M; m += NGW) {
        const u32x2* fr_ = (const u32x2*)(f + (size_t)m * D) + lane; const f32x4* br = (const f32x4*)(base + (size_t)m * D) + lane;
        u32x2 fw[16]; f32x4 v[16];
#pragma unroll
        for (int j = 0; j < 16; ++j) fw[j] = fr_[64 * j];
#pragma unroll
        for (int j = 0; j < 16; ++j) v[j] = br[64 * j];
        float s = 0.f;
#pragma unroll
        for (int j = 0; j < 16; ++j) { const float a0 = bf_lo(fw[j].x), a1 = bf_hi(fw[j].x), a2 = bf_lo(fw[j].y), a3 = bf_hi(fw[j].y); s += (a0 * a0 + a1 * a1) + (a2 * a2 + a3 * a3); }
        const float rstd = coef / sqrtf(wave_sum(s) * (1.0f / D) + RMS_EPS);
        float s2 = 0.f; f32x4* ho = (f32x4*)(hout + (size_t)m * D) + lane;
#pragma unroll
        for (int j = 0; j < 16; ++j) { const f32x4 g = G1[64 * j + lane]; f32x4 h;
            h[0] = v[j][0] + bf_lo(fw[j].x) * rstd * g[0]; h[1] = v[j][1] + bf_hi(fw[j].x) * rstd * g[1]; h[2] = v[j][2] + bf_lo(fw[j].y) * rstd * g[2]; h[3] = v[j][3] + bf_hi(fw[j].y) * rstd * g[3];
            v[j] = h; ho[64 * j] = h; s2 += (h[0] * h[0] + h[1] * h[1]) + (h[2] * h[2] + h[3] * h[3]); }
        if (xn) {
            const float r2 = 1.0f / sqrtf(wave_sum(s2) * (1.0f / D) + RMS_EPS);
            u32x2* o = (u32x2*)(xn + (size_t)m * D) + lane;
#pragma unroll
            for (int j = 0; j < 16; ++j) { const f32x4 g = G2[64 * j + lane]; u32x2 w; w.x = cvt_pk_bf16(v[j][0] * r2 * g[0], v[j][1] * r2 * g[1]); w.y = cvt_pk_bf16(v[j][2] * r2 * g[2], v[j][3] * r2 * g[3]); o[64 * j] = w; }
        }
    }
    __syncthreads();
}

template <int P> __device__ __forceinline__ void pool_delta_task(const bf16_t* proj, bf16_t* delta, int g, int mp, int lane) {
    const int m = 2 * mp + (lane >> 5), c = 8 * (lane & 31), t = m & (SEQ - 1);
    const bf16_t* zp = proj + (size_t)m * NIN + POOL_OFF + g * 256 + c;
    u32x4 w[P];
#pragma unroll
    for (int j = 0; j < P; ++j) w[j] = (j <= t) ? *(const u32x4*)(zp - (size_t)j * NIN) : (u32x4){0u, 0u, 0u, 0u};
    float s[8];
#pragma unroll
    for (int k = 0; k < 8; ++k) s[k] = 0.f;
#pragma unroll
    for (int j = 0; j < P; ++j) { s[0] += bf_lo(w[j].x); s[1] += bf_hi(w[j].x); s[2] += bf_lo(w[j].y); s[3] += bf_hi(w[j].y); s[4] += bf_lo(w[j].z); s[5] += bf_hi(w[j].z); s[6] += bf_lo(w[j].w); s[7] += bf_hi(w[j].w); }
    const int cnt = (t + 1) < P ? (t + 1) : P; const float ic = 1.0f / (float)cnt;
    u32x4 o; o.x = cvt_pk_bf16(s[0] * ic - bf_lo(w[0].x), s[1] * ic - bf_hi(w[0].x)); o.y = cvt_pk_bf16(s[2] * ic - bf_lo(w[0].y), s[3] * ic - bf_hi(w[0].y));
    o.z = cvt_pk_bf16(s[4] * ic - bf_lo(w[0].z), s[5] * ic - bf_hi(w[0].z)); o.w = cvt_pk_bf16(s[6] * ic - bf_lo(w[0].w), s[7] * ic - bf_hi(w[0].w));
    *(u32x4*)(delta + ((size_t)g * M + m) * 256 + c) = o;
}
__device__ __forceinline__ void pool_delta(const bf16_t* proj, bf16_t* delta, int gw, int NGW, int lane) {
    asm volatile("" : "+v"(lane));
    for (int task = gw; task < 2 * M; task += NGW) {
        const int g = task & 3, mp = task >> 2;
        if (g == 0) pool_delta_task<2>(proj, delta, 0, mp, lane);
        else if (g == 1) pool_delta_task<4>(proj, delta, 1, mp, lane);
        else if (g == 2) pool_delta_task<8>(proj, delta, 2, mp, lane);
        else pool_delta_task<16>(proj, delta, 3, mp, lane);
    }
}

namespace att {
__device__ __forceinline__ void attn_merge(const bf16_t* outg, const float* lse, bf16_t* attn, int gtid, int NT) {
    asm volatile("" : "+v"(gtid));
    for (int idx = gtid; idx < M * 128; idx += NT) {
        const int m = idx >> 7, c8 = (idx & 127) * 8, h = c8 >> 7;
        const float l0 = lse[(size_t)m * 8 + h], l1 = lse[((size_t)M + m) * 8 + h], l2 = lse[((size_t)2 * M + m) * 8 + h];
        const float mm = fmaxf(l0, fmaxf(l1, l2));
        float w0 = __expf(l0 - mm), w1 = __expf(l1 - mm), w2 = __expf(l2 - mm); const float inv = 1.0f / (w0 + w1 + w2); w0 *= inv; w1 *= inv; w2 *= inv;
        const u32x4 a = *(const u32x4*)(outg + (size_t)m * 1024 + c8), bq = *(const u32x4*)(outg + ((size_t)M + m) * 1024 + c8), c = *(const u32x4*)(outg + ((size_t)2 * M + m) * 1024 + c8);
        u32x4 o;
#pragma unroll
        for (int k = 0; k < 4; ++k) o[k] = cvt_pk_bf16(w0 * bf_lo(a[k]) + w1 * bf_lo(bq[k]) + w2 * bf_lo(c[k]), w0 * bf_hi(a[k]) + w1 * bf_hi(bq[k]) + w2 * bf_hi(c[k]));
        *(u32x4*)(attn + (size_t)m * 1024 + c8) = o;
    }
}
}


namespace att2 {
constexpr int VROW = 272, KBYTES = 32768, STG = KBYTES + 128 * VROW, N_UNITS = 3 * BATCH * 8 * 32;
static_assert(2 * STG <= MISC_OFF, "attention LDS");
struct Lane { int kR[2], kC[2]; unsigned ldsw; int koff, v_ch, v_kg, vcol, fr, fq, qbw, qi; };
struct UDec { const bf16_t* base; size_t rs; int qb, d, g, h, b, r; };
__device__ __forceinline__ UDec decode(const bf16_t* proj, int u) {
    UDec x; const int sub = u & 31; x.h = (u >> 5) & 7; x.b = (u >> 8) & 3; x.g = u >> 10;
    const int dsh = 2 * x.g, nbsh = 5 - dsh; x.d = 1 << dsh; x.qb = sub & ((1 << nbsh) - 1); x.r = sub >> nbsh;
    x.rs = (size_t)x.d * NIN; x.base = proj + ((size_t)x.b * SEQ + x.r) * NIN + x.g * 3072 + x.h * 128; return x;
}
__device__ __forceinline__ int first_half(int u) { const int g = u >> 10, nbsh = 5 - 2 * g; return ((u & 31) & ((1 << nbsh) - 1)) == 0 ? 1 : 0; }
template <int PAR> __device__ __forceinline__ void issue(LAS unsigned char* lds, const bf16_t* proj, int u, int half, const Lane& L, u32x4 (&vr)[4]) {
    const UDec x = decode(proj, u);
    const int i0 = 128 * x.qb - 128 * (1 - half);
    const bf16_t* kb = x.base + 1024 + (size_t)i0 * x.rs;
#pragma unroll
    for (int eh = 0; eh < 2; ++eh)
#pragma unroll
        for (int i = 0; i < 2; ++i)
            __builtin_amdgcn_global_load_lds((const unsigned*)(kb + 64 * eh + (size_t)L.kR[i] * x.rs + L.kC[i]), (LAS unsigned*)(lds + PAR * STG + eh * 16384 + L.ldsw + i * 8192), 16, 0, 0);
    const bf16_t* vp = x.base + 2048 + (size_t)(i0 + 4 * L.v_kg) * x.rs + 8 * L.v_ch;
#pragma unroll
    for (int c = 0; c < 4; ++c) vr[c] = *(const u32x4*)(vp + (size_t)c * x.rs);
}
template <int PAR> __device__ __forceinline__ void store_v(LAS unsigned char* lds, const Lane& L, const u32x4 (&vr)[4]) {
    LAS unsigned char* vdst = lds + PAR * STG + KBYTES + (8 * L.v_ch) * VROW + L.vcol;
#pragma unroll
    for (int wi = 0; wi < 4; ++wi) {
        u32x2 ev, od;
        ev.x = (vr[0][wi] & 0xffffu) | (vr[1][wi] << 16); ev.y = (vr[2][wi] & 0xffffu) | (vr[3][wi] << 16);
        od.x = (vr[0][wi] >> 16) | (vr[1][wi] & 0xffff0000u); od.y = (vr[2][wi] >> 16) | (vr[3][wi] & 0xffff0000u);
        *(LAS u32x2*)(vdst + (2 * wi) * VROW) = ev; *(LAS u32x2*)(vdst + (2 * wi + 1) * VROW) = od; }
}
__device__ __forceinline__ void load_q(const bf16_t* proj, int u, const Lane& L, bf16x8 (&q)[4]) {
    const UDec x = decode(proj, u);
    const bf16_t* qp = x.base + (size_t)(128 * x.qb + L.qi) * x.rs + 8 * L.fq;
#pragma unroll
    for (int ks = 0; ks < 4; ++ks) q[ks] = *(const bf16x8*)(qp + 32 * ks);
}
template <int PAR, int HALF, int QBW> __device__ __forceinline__ void compute(LAS unsigned char* lds, int u, const Lane& L, const bf16x8 (&qf)[4], float& mrun, float& lrun, f32x4 (&o)[8]) {
    const int g = u >> 10, h = (u >> 5) & 7, d = 1 << (2 * g);
    constexpr int KT0 = HALF ? 0 : QBW, KT1 = HALF ? QBW : 7;
    f32x4 s[8];
#pragma unroll
    for (int kt = KT0; kt <= KT1; ++kt) {
        s[kt] = (f32x4){0.f, 0.f, 0.f, 0.f};
#pragma unroll
        for (int ks = 0; ks < 4; ++ks) { const bf16x8 kf = *(const LAS bf16x8*)(lds + PAR * STG + (ks >> 1) * 16384 + L.koff + kt * 2048 + (ks & 1) * 1024);
            s[kt] = __builtin_amdgcn_mfma_f32_16x16x32_bf16(kf, qf[ks], s[kt], 0, 0, 0); }
        if ((kt - KT0) & 1) __builtin_amdgcn_sched_barrier(0);
    }
    const float slope = (g < 2) ? exp2f(-0.25f * (float)(g * 8 + h + 1)) : exp2f(-(4.5f + 0.5f * (float)h));
    const float sld = slope * (float)d * 1.4426950408889634f;
    int bi = 16 * QBW + L.fr + 128 * (1 - HALF) - 4 * L.fq; asm volatile("" : "+v"(bi));
    int dq = 4 * L.fq - L.fr; asm volatile("" : "+v"(dq));
    const float c0 = -sld * (float)bi;
    float mloc = -1e30f;
#pragma unroll
    for (int kt = KT0; kt <= KT1; ++kt) {
#pragma unroll
        for (int j = 0; j < 4; ++j) { float v = s[kt][j] * (0.08838834764831845f * 1.4426950408889634f) + (c0 + sld * (float)(16 * kt + j));
            if (kt == QBW) { const bool valid = HALF ? (dq + j <= 0) : (dq + j >= 0); v = valid ? v : -1e30f; }
            s[kt][j] = v; mloc = fmaxf(mloc, v); }
    }
    mloc = fmaxf(mloc, __shfl_xor(mloc, 16)); mloc = fmaxf(mloc, __shfl_xor(mloc, 32));
    const float mnew = fmaxf(mrun, mloc), alpha = __builtin_amdgcn_exp2f(mrun - mnew);
    float lsum = 0.f;
#pragma unroll
    for (int kt = KT0; kt <= KT1; ++kt)
#pragma unroll
        for (int j = 0; j < 4; ++j) { const float p = __builtin_amdgcn_exp2f(s[kt][j] - mnew); s[kt][j] = p; lsum += p; }
    lrun = lrun * alpha + lsum; mrun = mnew;
#pragma unroll
    for (int et = 0; et < 8; ++et) o[et] = o[et] * alpha;
#pragma unroll
    for (int ss = KT0 / 2; ss <= KT1 / 2; ++ss) {
        const bool l0 = (2 * ss >= KT0) && (2 * ss <= KT1), l1 = (2 * ss + 1 >= KT0) && (2 * ss + 1 <= KT1);
        u32x4 pw;
        pw.x = l0 ? cvt_pk_bf16(s[2 * ss][0], s[2 * ss][1]) : 0u; pw.y = l0 ? cvt_pk_bf16(s[2 * ss][2], s[2 * ss][3]) : 0u;
        pw.z = l1 ? cvt_pk_bf16(s[(2 * ss + 1) & 7][0], s[(2 * ss + 1) & 7][1]) : 0u; pw.w = l1 ? cvt_pk_bf16(s[(2 * ss + 1) & 7][2], s[(2 * ss + 1) & 7][3]) : 0u;
        const bf16x8 pf = __builtin_bit_cast(bf16x8, pw);
#pragma unroll
        for (int et = 0; et < 8; ++et) { const bf16x8 vf = *(const LAS bf16x8*)(lds + PAR * STG + KBYTES + (16 * et + L.fr) * VROW + 64 * ss + 16 * L.fq);
            o[et] = __builtin_amdgcn_mfma_f32_16x16x32_bf16(vf, pf, o[et], 0, 0, 0); }
        __builtin_amdgcn_sched_barrier(0);
    }
}
template <int PAR> __device__ __forceinline__ void compute_sel(LAS unsigned char* lds, int u, int half, const Lane& L, const bf16x8 (&qf)[4], float& mrun, float& lrun, f32x4 (&o)[8]) {
#define ATT_CASE(H, Q) case (H) * 8 + (Q): compute<PAR, H, Q>(lds, u, L, qf, mrun, lrun, o); break;
    switch (half * 8 + L.qbw) {
        ATT_CASE(0, 0) ATT_CASE(0, 1) ATT_CASE(0, 2) ATT_CASE(0, 3) ATT_CASE(0, 4) ATT_CASE(0, 5) ATT_CASE(0, 6) ATT_CASE(0, 7)
        ATT_CASE(1, 0) ATT_CASE(1, 1) ATT_CASE(1, 2) ATT_CASE(1, 3) ATT_CASE(1, 4) ATT_CASE(1, 5) ATT_CASE(1, 6) ATT_CASE(1, 7)
        default: break;
    }
#undef ATT_CASE
}
__device__ __forceinline__ void finalize(const bf16_t* proj, int u, const Lane& L, float mrun, float lrun, const f32x4 (&o)[8], bf16_t* outg, float* lse) {
    const UDec x = decode(proj, u);
    float l = lrun; l += __shfl_xor(l, 16); l += __shfl_xor(l, 32);
    const float inv = 1.0f / l;
    const size_t mrow = (size_t)x.g * M + (size_t)x.b * SEQ + (size_t)(128 * x.qb + L.qi) * x.d + x.r;
    bf16_t* op = outg + mrow * 1024 + x.h * 128 + 4 * L.fq;
#pragma unroll
    for (int et = 0; et < 8; ++et) { u32x2 w; w.x = cvt_pk_bf16(o[et][0] * inv, o[et][1] * inv); w.y = cvt_pk_bf16(o[et][2] * inv, o[et][3] * inv); *(u32x2*)(op + 16 * et) = w; }
    if (L.fq == 0) lse[mrow * 8 + x.h] = (mrun + __builtin_amdgcn_logf(l)) * 0.6931471805599453f;
}
template <int PAR> __device__ __forceinline__ bool step(LAS unsigned char* lds, const bf16_t* proj, bf16_t* outg, float* lse, int G, const Lane& L, int& u, int& half, bf16x8 (&qf)[4], float& mrun, float& lrun, f32x4 (&o)[8]) {
    int nu, nh; if (half == 0) { nu = u; nh = 1; } else { nu = u + G; nh = nu < N_UNITS ? first_half(nu) : 0; }
    const bool has_next = nu < N_UNITS, new_unit = has_next && (nu != u);
    u32x4 vr[4]; bf16x8 qn[4];
    if (has_next) issue<PAR ^ 1>(lds, proj, nu, nh, L, vr);
    if (new_unit) load_q(proj, nu, L, qn);
    __builtin_amdgcn_sched_barrier(0);
    compute_sel<PAR>(lds, u, half, L, qf, mrun, lrun, o);
    if (half == 1) { finalize(proj, u, L, mrun, lrun, o, outg, lse); mrun = -1e30f; lrun = 0.f;
#pragma unroll
        for (int et = 0; et < 8; ++et) o[et] = (f32x4){0.f, 0.f, 0.f, 0.f}; }
    __builtin_amdgcn_sched_barrier(0);
    if (has_next) store_v<PAR ^ 1>(lds, L, vr);
    if (new_unit) {
#pragma unroll
        for (int ks = 0; ks < 4; ++ks) qf[ks] = qn[ks]; }
    __builtin_amdgcn_s_waitcnt(0); asm volatile("" ::: "memory"); __builtin_amdgcn_s_barrier(); asm volatile("" ::: "memory");
    u = nu; half = nh;
    return has_next;
}
__device__ __forceinline__ void attn_phase(LAS unsigned char* lds, const bf16_t* proj, bf16_t* outg, float* lse, int vcu, int G) {
    int tid = threadIdx.x; asm volatile("" : "+v"(tid));
    const int lane = tid & 63, wid = __builtin_amdgcn_readfirstlane(tid >> 6);
    Lane L;
#pragma unroll
    for (int i = 0; i < 2; ++i) pg8::stage_rc(tid * 16 + i * 8192, L.kR[i], L.kC[i]);
    L.fr = lane & 15; L.fq = lane >> 4; L.ldsw = (unsigned)wid * 1024u; L.koff = pg8::lds_byte(L.fr, L.fq * 8);
    L.v_ch = (lane & 3) + 4 * ((lane >> 4) & 3); L.v_kg = ((lane >> 2) & 3) + 4 * wid;
    L.vcol = 64 * (wid >> 1) + 16 * ((lane >> 2) & 3) + 8 * (wid & 1);
    L.qbw = wid < 4 ? wid : 11 - wid; L.qi = 16 * L.qbw + L.fr;
    int u = vcu; if (u >= N_UNITS) return;
    int half = first_half(u);
    bf16x8 qf[4]; f32x4 o[8]; float mrun = -1e30f, lrun = 0.f;
#pragma unroll
    for (int et = 0; et < 8; ++et) o[et] = (f32x4){0.f, 0.f, 0.f, 0.f};
    { u32x4 vr[4]; issue<0>(lds, proj, u, half, L, vr); load_q(proj, u, L, qf); store_v<0>(lds, L, vr); }
    __builtin_amdgcn_s_waitcnt(0); asm volatile("" ::: "memory"); __builtin_amdgcn_s_barrier(); asm volatile("" ::: "memory");
    for (;;) {
        if (!step<0>(lds, proj, outg, lse, G, L, u, half, qf, mrun, lrun, o)) break;
        if (!step<1>(lds, proj, outg, lse, G, L, u, half, qf, mrun, lrun, o)) break;
    }
}
}

constexpr int NPHASE = 13;
__global__ void __launch_bounds__(NTHREADS, 2) mk_fwd(Args a) {
    extern __shared__ __attribute__((aligned(16))) unsigned char lds_raw[];
    LAS unsigned char* lds = (LAS unsigned char*)lds_raw;
    const int tid = threadIdx.x, lane = tid & 63, wave = __builtin_amdgcn_readfirstlane(tid >> 6);
    const int G = gridDim.x, bx = blockIdx.x;
    const int vcu = (G % 8 == 0) ? (bx % 8) * (G / 8) + bx / 8 : bx;
    const int gw = vcu * NWAVES + wave, NGW = G * NWAVES;
    unsigned char* ws = a.ws;
    unsigned* ctl = (unsigned*)(ws + WS_CTL);
    volatile LAS unsigned* MISC = (volatile LAS unsigned*)(lds + MISC_OFF);
    if (tid < 32) MISC[tid] = 0u;
    __syncthreads();
    XcdBarrier bar; bar.bar = ctl + CW_BAR; bar.x = 0; bar.st = nullptr;
    if (MK_ONE_LAUNCH) bar = xcd_barrier_post(ctl + CW_BAR, MISC + 8);
    const int lo = a.ph_lo, hi = a.ph_hi;
#ifdef DBG_ONLY
#define IN(k) ((k) == DBG_ONLY && lo <= (k) && (k) < hi)
#else
#define IN(k) (lo <= (k) && (k) < hi)
#endif
#define SEAM(k) do { if (MK_ONE_LAUNCH && IN(k) && IN((k) + 1)) xcd_barrier(bar); } while (0)

    bf16_t* XN = (bf16_t*)(ws + WS_XN); bf16_t* ACT = (bf16_t*)(ws + WS_ACT); bf16_t* Fb = (bf16_t*)(ws + WS_F); bf16_t* PROJ = (bf16_t*)(ws + WS_PROJ);
    bf16_t* ATT = (bf16_t*)(ws + WS_ATTN); bf16_t* DELTA = (bf16_t*)(ws + WS_DELTA); bf16_t* POOLED = (bf16_t*)(ws + WS_POOLED); bf16_t* MERGED = XN;

    const bool tail_cvt = (G == 256);
    if (IN(0)) { p0_weights<0>(a, lds, gw, NGW, wave, lane);
        if (!tail_cvt) { p0_weights<1>(a, lds, gw, NGW, wave, lane); p0_weights<2>(a, lds, gw, NGW, wave, lane); }
        p0_norm(a.x, a.n1pre, XN, gw, NGW, lane); }
    SEAM(0);
    if (IN(1)) { pg8::PlainSched S; S.T.init(M, 2 * FF, G, bx, WGM_G); S.A = (const char*)XN; S.B = (const char*)(ws + WS_WGU1); S.tstep = (size_t)256 * D * 2;
        pg8::EpiSwiGLU E{ACT, FF};
        pg8::gemm_phase<pg8::EpiSwiGLU, pg8::PlainSched, PG8_ALIGN, PG8_SP2>(lds, D, S, E);
        if (tail_cvt && bx >= 128) p0_weights<1>(a, lds, (bx - 128) * NWAVES + wave, 128 * NWAVES, wave, lane); }
    SEAM(1);
    if (IN(2)) { pg8::PlainSched S; S.T.init(M, D, G, bx, WGM_D); S.A = (const char*)ACT; S.B = (const char*)(ws + WS_WD1); S.tstep = (size_t)256 * FF * 2;
        pg8::EpiBf16 E{Fb, D};
        pg8::gemm_phase<pg8::EpiBf16, pg8::PlainSched, PG8_ALIGN, PG8_SP2>(lds, FF, S, E); }
    SEAM(2);
    if (IN(3)) norm_phase(lds, Fb, a.x, a.out, XN, a.n1post, a.nmpre, 0.5f, gw, NGW, tid);
    SEAM(3);
    if (IN(4)) { pg8::PlainSched S; S.T.init(M, NIN, G, bx, WGM_G); S.A = (const char*)XN; S.B = (const char*)(ws + WS_WIN); S.tstep = (size_t)256 * D * 2;
        pg8::EpiBf16Sig E{PROJ, NIN, GA_OFF / 256};
        pg8::gemm_phase<pg8::EpiBf16Sig, pg8::PlainSched, PG8_ALIGN, PG8_SP2>(lds, D, S, E); }
    SEAM(4);
    if (IN(5)) { att2::attn_phase(lds, PROJ, (bf16_t*)(ws + WS_OUTG), (float*)(ws + WS_LSE), vcu, G); pool_delta(PROJ, DELTA, gw, NGW, lane); }
    SEAM(5);
    if (IN(6)) { att::attn_merge((const bf16_t*)(ws + WS_OUTG), (const float*)(ws + WS_LSE), ATT, vcu * NTHREADS + tid, G * NTHREADS);
        pg8::PoolSched S; S.T.init(M, 1024, G, bx); S.A = (const char*)DELTA; S.B = (const char*)(ws + WS_WPL); S.tstep = (size_t)256 * 256 * 2; S.gstride = (size_t)M * 256 * 2;
        pg8::EpiPool E{POOLED, 1024, a.poolscale};
        pg8::gemm_phase<pg8::EpiPool, pg8::PoolSched, PG8_ALIGN, PG8_SP2>(lds, 256, S, E); }
    SEAM(6);
    if (IN(7)) { pg8::BranchSched S; S.T.init(M, D, G, bx); S.A0 = (const char*)ATT; S.B0 = (const char*)(ws + WS_WBA); S.A1 = (const char*)POOLED; S.B1 = (const char*)(ws + WS_WBP); S.tstep = (size_t)256 * 1024 * 2;
        pg8::EpiBranch E{MERGED, D, PROJ};
        pg8::gemm_phase<pg8::EpiBranch, pg8::BranchSched, PG8_ALIGN, PG8_SP2>(lds, 1024, S, E); }
    SEAM(7);
    if (IN(8)) { pg8::PlainSched S; S.T.init(M, D, G, bx); S.A = (const char*)MERGED; S.B = (const char*)(ws + WS_WOUT); S.tstep = (size_t)256 * D * 2;
        pg8::EpiBf16 E{Fb, D};
        pg8::gemm_phase<pg8::EpiBf16, pg8::PlainSched, PG8_ALIGN, PG8_SP2>(lds, D, S, E); }
    SEAM(8);
    if (IN(9)) norm_phase(lds, Fb, a.out, a.out, XN, a.nmpost, a.n2pre, 1.0f, gw, NGW, tid);
    SEAM(9);
    if (IN(10)) { pg8::PlainSched S; S.T.init(M, 2 * FF, G, bx, WGM_G); S.A = (const char*)XN; S.B = (const char*)(ws + WS_WGU2); S.tstep = (size_t)256 * D * 2;
        pg8::EpiSwiGLU E{ACT, FF};
        pg8::gemm_phase<pg8::EpiSwiGLU, pg8::PlainSched, PG8_ALIGN, PG8_SP2>(lds, D, S, E);
        if (tail_cvt && bx >= 128) p0_weights<2>(a, lds, (bx - 128) * NWAVES + wave, 128 * NWAVES, wave, lane); }
    SEAM(10);
    if (IN(11)) { pg8::PlainSched S; S.T.init(M, D, G, bx, WGM_D); S.A = (const char*)ACT; S.B = (const char*)(ws + WS_WD2); S.tstep = (size_t)256 * FF * 2;
        pg8::EpiBf16 E{Fb, D};
        pg8::gemm_phase<pg8::EpiBf16, pg8::PlainSched, PG8_ALIGN, PG8_SP2>(lds, FF, S, E); }
    SEAM(11);
    if (IN(12)) norm_phase(lds, Fb, a.out, a.out, nullptr, a.n2post, nullptr, 0.5f, gw, NGW, tid);
#undef IN
#undef SEAM
}

extern "C" void kernel_launch(void* const* d_in, const int* in_sizes, int n_in, void* d_out, int out_size, void* d_ws, size_t ws_size, hipStream_t stream) {
    static int grid = 0;
    if (grid == 0) {
        if (n_in != 19 || in_sizes[0] != M * D || out_size != M * D || ws_size < WS_END) { fprintf(stderr, "kernel_launch: unexpected shapes (n_in %d, in0 %d, out %d, ws %zu < %zu)\n", n_in, n_in > 0 ? in_sizes[0] : -1, out_size, ws_size, (size_t)WS_END); grid = -1; return; }
        int dev = 0, cus = 0, per_cu = 0;
        if (hipGetDevice(&dev) != hipSuccess || hipDeviceGetAttribute(&cus, hipDeviceAttributeMultiprocessorCount, dev) != hipSuccess) { grid = -1; return; }
        if (hipFuncSetAttribute((const void*)mk_fwd, hipFuncAttributeMaxDynamicSharedMemorySize, LDS_BYTES) != hipSuccess) { fprintf(stderr, "kernel_launch: hipFuncSetAttribute failed\n"); grid = -1; return; }
        if (hipOccupancyMaxActiveBlocksPerMultiprocessor(&per_cu, (const void*)mk_fwd, NTHREADS, LDS_BYTES) != hipSuccess || per_cu < 1) { fprintf(stderr, "kernel_launch: occupancy query says %d\n", per_cu); }
        (void)hipGetLastError();
        grid = cus;
    }
    if (grid < 0) return;
    (void)hipMemsetAsync((char*)d_ws + WS_CTL, 0, CTL_ZERO_BYTES, stream);
    Args a{};
    a.x = (const float*)d_in[0]; a.n1pre = (const float*)d_in[1]; a.n1post = (const float*)d_in[2]; a.w1g = (const float*)d_in[3]; a.w1u = (const float*)d_in[4]; a.w1d = (const float*)d_in[5];
    a.nmpre = (const float*)d_in[6]; a.nmpost = (const float*)d_in[7]; a.win = (const float*)d_in[8]; a.poolw = (const float*)d_in[9]; a.poolscale = (const float*)d_in[10];
    a.wab = (const float*)d_in[11]; a.wpb = (const float*)d_in[12]; a.wout = (const float*)d_in[13];
    a.n2pre = (const float*)d_in[14]; a.n2post = (const float*)d_in[15]; a.w2g = (const float*)d_in[16]; a.w2u = (const float*)d_in[17]; a.w2d = (const float*)d_in[18];
    a.out = (float*)d_out; a.ws = (unsigned char*)d_ws;
#if MK_ONE_LAUNCH
    a.ph_lo = 0; a.ph_hi = NPHASE;
    hipLaunchKernelGGL(mk_fwd, dim3(grid), dim3(NTHREADS), LDS_BYTES, stream, a);
#else
    for (int p = 0; p < NPHASE; ++p) { a.ph_lo = p; a.ph_hi = p + 1; hipLaunchKernelGGL(mk_fwd, dim3(grid), dim3(NTHREADS), LDS_BYTES, stream, a); }
#endif
}
```

```cpp
#include <hip/hip_runtime.h>
#include <cstdio>
#include <cstdint>

#ifndef MK_ONE_LAUNCH
#define MK_ONE_LAUNCH 1
#endif

#define LAS __attribute__((address_space(3)))
#define GAS __attribute__((address_space(1)))
typedef unsigned short bf16_t;
typedef short bf16x8 __attribute__((ext_vector_type(8)));
typedef float f32x4 __attribute__((ext_vector_type(4)));
typedef float f32x2 __attribute__((ext_vector_type(2)));
typedef unsigned u32x4 __attribute__((ext_vector_type(4)));
typedef unsigned u32x2 __attribute__((ext_vector_type(2)));
typedef int i32x8 __attribute__((ext_vector_type(8)));
typedef int i32x4 __attribute__((ext_vector_type(4)));
typedef i32x8 i32x8a __attribute__((aligned(16)));

constexpr int BATCH = 4, SEQ = 4096, M = BATCH * SEQ, D = 4096, FF = 11008, NIN = 18432;
constexpr int POOL_OFF = 9216, GA_OFF = 10240, GP_OFF = 14336;
constexpr float RMS_EPS = 1e-6f;
constexpr int NWAVES = 8, NTHREADS = 512;

constexpr size_t MiB = (size_t)1 << 20;
constexpr size_t WS_CTL = 0, CTL_ZERO_BYTES = 1 * MiB;
constexpr size_t WS_WGU1 = 1 * MiB;
constexpr size_t WS_WD1 = 173 * MiB;
constexpr size_t WS_WIN = 259 * MiB;
constexpr size_t WS_WIN8 = WS_WIN + 80 * MiB;
constexpr size_t WS_WOUT = 403 * MiB;
constexpr size_t WS_WBA = 435 * MiB;
constexpr size_t WS_WBP = 443 * MiB;
constexpr size_t WS_WPL = 451 * MiB;
constexpr size_t WS_WGU2 = 452 * MiB;
constexpr size_t WS_WD2 = 624 * MiB;
constexpr size_t WS_XN = 710 * MiB;
constexpr size_t WS_ACT = 838 * MiB;
constexpr size_t WS_F = 1182 * MiB;
constexpr size_t WS_PROJ = 838 * MiB;
constexpr size_t WS_ATTN = 1438 * MiB;
constexpr size_t WS_DELTA = 1470 * MiB;
constexpr size_t WS_POOLED = 1502 * MiB;
constexpr size_t WS_T1 = 1534 * MiB;
constexpr size_t WS_OUTG = WS_XN;
constexpr size_t WS_LSE = WS_XN + 96 * MiB;
constexpr size_t WS_END = 1598 * MiB;
static_assert(WS_PROJ + (size_t)M * NIN * 2 <= WS_ATTN, "proj overlay");
constexpr int CW_BAR = 4096;
constexpr int CW_DYN = 180224;
constexpr int CW_DQ = 192512;
constexpr int CW_SLAB = 12288;
constexpr int CW_CMAX = 16384;
constexpr int CM_W1G = 0, CM_W1U = FF, CM_W2G = 2 * FF, CM_W2U = 3 * FF, CM_WIN = 4 * FF, CM_W1D = 4 * FF + NIN, CM_W2D = CM_W1D + D;
static_assert((CW_CMAX + 4 * FF + NIN + 2 * D) * 4 <= 512 * 1024, "column maxima below the row-scale arrays");

__device__ __forceinline__ unsigned cvt_pk_bf16(float lo, float hi) { unsigned r; asm volatile("v_cvt_pk_bf16_f32 %0, %1, %2" : "=v"(r) : "v"(lo), "v"(hi)); return r; }
__device__ __forceinline__ float bf_lo(unsigned w) { return __uint_as_float(w << 16); }
__device__ __forceinline__ float bf_hi(unsigned w) { return __uint_as_float(w & 0xffff0000u); }
__device__ __forceinline__ float wave_sum(float v) {
#pragma unroll
    for (int o = 1; o < 64; o <<= 1) v += __shfl_xor(v, o);
    return v;
}
__device__ __forceinline__ unsigned cvt4_fp8(float a, float b, float c, float d) { int w = __builtin_amdgcn_cvt_pk_fp8_f32(a, b, 0, false); w = __builtin_amdgcn_cvt_pk_fp8_f32(c, d, w, true); return (unsigned)w; }
__device__ __forceinline__ unsigned pack4_i8(float a, float b, float c, float d) {
    const float MG = 12582912.0f;
    return __builtin_amdgcn_perm(__float_as_uint(b + MG), __float_as_uint(a + MG), 0x0c0c0400u) | __builtin_amdgcn_perm(__float_as_uint(d + MG), __float_as_uint(c + MG), 0x04000c0cu);
}
__device__ __forceinline__ float lane_xor1(float v) { return __int_as_float(__builtin_amdgcn_update_dpp(0, __float_as_int(v), 0xB1, 0xF, 0xF, true)); }
__device__ __forceinline__ float lane_xor2(float v) { return __int_as_float(__builtin_amdgcn_update_dpp(0, __float_as_int(v), 0x4E, 0xF, 0xF, true)); }
__device__ __forceinline__ float lane_xor4(float v) { return __int_as_float(__builtin_amdgcn_ds_swizzle(__float_as_int(v), 0x101F)); }
__device__ __forceinline__ float wave_max(float v) {
#pragma unroll
    for (int o = 1; o < 64; o <<= 1) v = fmaxf(v, __shfl_xor(v, o));
    return v;
}
__device__ __forceinline__ float fast_sigmoid(float x) { return __builtin_amdgcn_rcpf(1.0f + __builtin_amdgcn_exp2f(-1.4426950408889634f * x)); }

#define XB_TMO      128
#define XB_XCNT(j)  (256  + 64 * (j))
#define XB_XSUB(j)  (1280 + 64 * (j))
#define XB_XGEN(j)  (2304 + 64 * (j))
#define XB_TOP      3328
#define XB_TOPGEN   3392
#define XCD_BAR_WORDS 3456
#define XB_SPIN_CAP (1u << 18)

__device__ __forceinline__ unsigned xb_ld(unsigned* p)              { return __hip_atomic_load(p, __ATOMIC_RELAXED, __HIP_MEMORY_SCOPE_AGENT); }
__device__ __forceinline__ unsigned xb_add(unsigned* p, unsigned v) { return __hip_atomic_fetch_add(p, v, __ATOMIC_RELAXED, __HIP_MEMORY_SCOPE_AGENT); }
__device__ __forceinline__ unsigned xb_xcc_id() { return (unsigned)__builtin_amdgcn_s_getreg((3 << 11) | 20) & 0xFu; }
#define XB_SPIN(cond, bar) do { unsigned _sp = 0; while (cond) { __builtin_amdgcn_s_sleep(1); \
    if ((++_sp & 255u) == 0u) { if (xb_ld(&(bar)[XB_TMO])) break; if (_sp > XB_SPIN_CAP) { atomicAdd(&(bar)[XB_TMO], 1u); break; } } } } while (0)

struct XcdBarrier { unsigned* bar; unsigned x; volatile LAS unsigned* st; };

__device__ __forceinline__ XcdBarrier xcd_barrier_post(unsigned* bar, volatile LAS unsigned* st) {
    XcdBarrier b; b.bar = bar; b.x = xb_xcc_id(); b.st = st;
    if (threadIdx.x == 0) (void)xb_add(&bar[XB_XCNT(b.x)], 1u);
    return b;
}
__device__ __forceinline__ void xcd_barrier_complete(unsigned* bar, unsigned x, unsigned& nloc, unsigned& nx) {
    const unsigned G = gridDim.x * gridDim.y * gridDim.z;
    unsigned sum, cnt, mine, sp = 0u;
    for (;;) {
        sum = 0u; cnt = 0u; mine = 0u;
#pragma unroll
        for (unsigned j = 0; j < 16; ++j) { const unsigned c = xb_ld(&bar[XB_XCNT(j)]); sum += c; cnt += (c > 0u) ? 1u : 0u; mine = (j == x) ? c : mine; }
        if (sum == G) break;
        __builtin_amdgcn_s_sleep(1);
        if ((++sp & 255u) == 0u) { if (xb_ld(&bar[XB_TMO])) break; if (sp > XB_SPIN_CAP) { atomicAdd(&bar[XB_TMO], 1u); break; } }
    }
    nloc = mine > 0u ? mine : 1u; nx = cnt > 0u ? cnt : 1u;
}
__device__ __forceinline__ void xcd_barrier(const XcdBarrier& b) {
    asm volatile("s_waitcnt vmcnt(0)" ::: "memory");
    __syncthreads();
    if (threadIdx.x == 0) {
        unsigned* bar = b.bar;
        __builtin_amdgcn_s_waitcnt(0);
        unsigned nloc = b.st[0], nx = b.st[1];
        if (nloc == 0u) { xcd_barrier_complete(bar, b.x, nloc, nx); b.st[0] = nloc; b.st[1] = nx; }
        const unsigned old = xb_add(&bar[XB_XSUB(b.x)], 1u);
        const unsigned gen = old / nloc;
        if (old + 1u == (gen + 1u) * nloc) {
            __builtin_amdgcn_fence(__ATOMIC_RELEASE, "agent");
            asm volatile("s_waitcnt vmcnt(0)" ::: "memory");
            const unsigned og = xb_add(&bar[XB_TOP], 1u);
            const unsigned tg = og / nx;
            if (og + 1u == (tg + 1u) * nx) xb_add(&bar[XB_TOPGEN], 1u);
            else XB_SPIN(xb_ld(&bar[XB_TOPGEN]) == tg, bar);
            __builtin_amdgcn_fence(__ATOMIC_ACQUIRE, "agent");
            xb_add(&bar[XB_XGEN(b.x)], 1u);
            asm volatile("s_waitcnt vmcnt(0)" ::: "memory");
        } else {
            XB_SPIN(xb_ld(&bar[XB_XGEN(b.x)]) == gen, bar);
            __builtin_amdgcn_fence(__ATOMIC_ACQUIRE, "agent");
            asm volatile("s_waitcnt vmcnt(0)" ::: "memory");
        }
    }
    __syncthreads();
}

namespace pg8 {
constexpr int BM = 256, BK = 64, HALF = 128, HTB = HALF * BK * 2, STAGE_BYTES = 8 * HTB, NXCD = 8, WGM = 8;
__host__ __device__ __forceinline__ int lds_byte(int r, int c) { const int st = (r >> 4) * 2 + (c >> 5), rr = r & 15, cc = c & 31, ob = rr * 64 + cc * 2; return st * 1024 + (ob ^ (((ob >> 9) & 1) << 5)); }
__host__ __device__ __forceinline__ void stage_rc(int b, int& R, int& C) { const int st = b / 1024, sb = b % 1024, swz = sb ^ (((sb >> 9) & 1) << 5); R = (st >> 1) * 16 + swz / 64; C = (st & 1) * 32 + (swz % 64) / 2; }
__host__ __device__ __forceinline__ int perm32(int rho) { const int n = rho >> 4, i = rho & 15; return 8 * (i >> 2) + 4 * n + (i & 3); }

struct Unit { int pm, pn, sub; };
struct TileOrder {
    int nM, nN, nwg, G, c, wgm;
    __device__ __forceinline__ void init(int Mr, int Nc, int G_, int c_, int wgm_ = WGM) { nM = Mr / BM; nN = Nc / BM; nwg = nM * nN; G = G_; c = c_; wgm = wgm_; }
    __device__ __forceinline__ bool at(long L, int& pm, int& pn) const {
        if (L >= nwg) return false;
        int wgid = (int)L; { const int q = nwg / NXCD, r = nwg % NXCD, xcd = wgid % NXCD, off = wgid / NXCD; wgid = (xcd < r ? xcd * (q + 1) : r * (q + 1) + (xcd - r) * q) + off; }
        const int nig = wgm * nN, gid = wgid / nig, fm = gid * wgm, gsz = (nM - fm) < wgm ? (nM - fm) : wgm;
        pm = fm + ((wgid % nig) % gsz); pn = (wgid % nig) / gsz; return true;
    }
};
struct PlainSched {
    TileOrder T; const char* A; const char* B; size_t tstep;
    __device__ __forceinline__ bool next(int i, Unit& u) const { u.sub = 0; return T.at((long)i * T.G + T.c, u.pm, u.pn); }
    __device__ __forceinline__ const char* aptr(const Unit& u) const { return A + (size_t)u.pm * tstep; }
    __device__ __forceinline__ const char* bptr(const Unit& u) const { return B + (size_t)u.pn * tstep; }
};
struct BranchSched {
    TileOrder T; const char* A0; const char* B0; const char* A1; const char* B1; size_t tstep;
    __device__ __forceinline__ bool next(int i, Unit& u) const { u.sub = i & 1; return T.at((long)(i >> 1) * T.G + T.c, u.pm, u.pn); }
    __device__ __forceinline__ const char* aptr(const Unit& u) const { return (u.sub ? A1 : A0) + (size_t)u.pm * tstep; }
    __device__ __forceinline__ const char* bptr(const Unit& u) const { return (u.sub ? B1 : B0) + (size_t)u.pn * tstep; }
};
struct PoolSched {
    TileOrder T; const char* A; const char* B; size_t tstep, gstride;
    __device__ __forceinline__ bool next(int i, Unit& u) const { u.sub = 0; return T.at((long)i * T.G + T.c, u.pm, u.pn); }
    __device__ __forceinline__ const char* aptr(const Unit& u) const { return A + (size_t)u.pn * gstride + (size_t)u.pm * tstep; }
    __device__ __forceinline__ const char* bptr(const Unit& u) const { return B + (size_t)u.pn * tstep; }
};

struct EpiSwiGLU {
    static constexpr bool PERM = true, KEEP_SUB0 = false;
    bf16_t* O; int ldc;
    __device__ __forceinline__ void operator()(const f32x4 (&acc)[2][2][4][2], const Unit& u, int wr, int wc, int fr, int fq) const {
        const int row0 = u.pm * BM + wr * 64 + fr, col0 = u.pn * HALF + wc * 32 + 8 * fq;
#pragma unroll
        for (int ai = 0; ai < 2; ++ai)
#pragma unroll
            for (int m = 0; m < 4; ++m) { bf16_t* rowp = O + (size_t)(row0 + ai * HALF + m * 16) * ldc + col0;
                float o[8];
#pragma unroll
                for (int n = 0; n < 2; ++n)
#pragma unroll
                    for (int j = 0; j < 4; ++j) { const float g = acc[ai][0][m][n][j], uu = acc[ai][1][m][n][j]; o[n * 4 + j] = g * fast_sigmoid(g) * uu; }
                u32x4 w; w.x = cvt_pk_bf16(o[0], o[1]); w.y = cvt_pk_bf16(o[2], o[3]); w.z = cvt_pk_bf16(o[4], o[5]); w.w = cvt_pk_bf16(o[6], o[7]);
                *(u32x4*)rowp = w; }
    }
};
struct EpiBf16 {
    static constexpr bool PERM = true, KEEP_SUB0 = false;
    bf16_t* O; int ldc; float osc;
    __device__ __forceinline__ void operator()(const f32x4 (&acc)[2][2][4][2], const Unit& u, int wr, int wc, int fr, int fq) const {
        const int row0 = u.pm * BM + wr * 64 + fr, col0 = u.pn * BM + wc * 32 + 8 * fq;
#pragma unroll
        for (int ai = 0; ai < 2; ++ai)
#pragma unroll
            for (int m = 0; m < 4; ++m) { bf16_t* rowp = O + (size_t)(row0 + ai * HALF + m * 16) * ldc + col0;
#pragma unroll
                for (int bj = 0; bj < 2; ++bj) { const f32x4 v0 = acc[ai][bj][m][0] * osc, v1 = acc[ai][bj][m][1] * osc;
                    u32x4 w; w.x = cvt_pk_bf16(v0[0], v0[1]); w.y = cvt_pk_bf16(v0[2], v0[3]); w.z = cvt_pk_bf16(v1[0], v1[1]); w.w = cvt_pk_bf16(v1[2], v1[3]);
                    *(u32x4*)(rowp + bj * HALF) = w; } }
    }
};
struct EpiSwiGLU8 {
    static constexpr bool PERM = true, KEEP_SUB0 = false;
    unsigned char* O; int ldc;
    __device__ __forceinline__ void operator()(const f32x4 (&acc)[2][2][4][2], const Unit& u, int wr, int wc, int fr, int fq) const {
        const int row0 = u.pm * BM + wr * 64 + fr, col0 = u.pn * HALF + wc * 32 + 8 * fq;
#pragma unroll
        for (int ai = 0; ai < 2; ++ai)
#pragma unroll
            for (int m = 0; m < 4; ++m) { unsigned char* rowp = O + (size_t)(row0 + ai * HALF + m * 16) * ldc + col0;
                float o[8];
#pragma unroll
                for (int n = 0; n < 2; ++n)
#pragma unroll
                    for (int j = 0; j < 4; ++j) { const float g = acc[ai][0][m][n][j], uu = acc[ai][1][m][n][j]; o[n * 4 + j] = g * fast_sigmoid(g) * uu; }
                u32x2 w; w.x = cvt4_fp8(o[0], o[1], o[2], o[3]); w.y = cvt4_fp8(o[4], o[5], o[6], o[7]);
                *(u32x2*)rowp = w; }
    }
};
template <int OUT> struct EpiSwiGLUI8 {
    static constexpr bool PERM = true, KEEP_SUB0 = false;
    bf16_t* O16; unsigned char* O8; int ldc; const float* rs; const float* cg; const float* cu;
    __device__ __forceinline__ void operator()(const f32x4 (&acc)[2][2][4][2], const Unit& u, int wr, int wc, int fr, int fq) const {
        const int row0 = u.pm * BM + wr * 64 + fr, col0 = u.pn * HALF + wc * 32 + 8 * fq;
        f32x4 sg[2], su[2];
#pragma unroll
        for (int n = 0; n < 2; ++n) { sg[n] = *(const f32x4*)(cg + col0 + 4 * n) * (1.0f / 127.f); su[n] = *(const f32x4*)(cu + col0 + 4 * n) * (1.0f / 127.f); }
#pragma unroll
        for (int ai = 0; ai < 2; ++ai)
#pragma unroll
            for (int m = 0; m < 4; ++m) { const int row = row0 + ai * HALF + m * 16; const float r = rs[row];
                float o[8];
#pragma unroll
                for (int n = 0; n < 2; ++n)
#pragma unroll
                    for (int j = 0; j < 4; ++j) { const float g = (float)__float_as_int(acc[ai][0][m][n][j]) * (r * sg[n][j]), uu = (float)__float_as_int(acc[ai][1][m][n][j]) * (r * su[n][j]); o[n * 4 + j] = g * fast_sigmoid(g) * uu; }
                if constexpr (OUT != 0) { u32x2 w; w.x = cvt4_fp8(o[0], o[1], o[2], o[3]); w.y = cvt4_fp8(o[4], o[5], o[6], o[7]); *(u32x2*)(O8 + (size_t)row * ldc + col0) = w; }
                if constexpr (OUT != 1) { u32x4 w; w.x = cvt_pk_bf16(o[0], o[1]); w.y = cvt_pk_bf16(o[2], o[3]); w.z = cvt_pk_bf16(o[4], o[5]); w.w = cvt_pk_bf16(o[6], o[7]); *(u32x4*)(O16 + (size_t)row * ldc + col0) = w; } }
    }
};
struct EpiBf16SigI8 {
    static constexpr bool PERM = true, KEEP_SUB0 = false;
    bf16_t* O; int ldc; int sig_from; const float* rs; const float* cm; float cs;
    __device__ __forceinline__ void operator()(const f32x4 (&acc)[2][2][4][2], const Unit& u, int wr, int wc, int fr, int fq) const {
        const int row0 = u.pm * BM + wr * 64 + fr, col0 = u.pn * BM + wc * 32 + 8 * fq; const bool sg = u.pn >= sig_from;
#pragma unroll
        for (int bj = 0; bj < 2; ++bj) { f32x4 sw[2];
#pragma unroll
            for (int n = 0; n < 2; ++n) sw[n] = *(const f32x4*)(cm + col0 + bj * HALF + 4 * n) * cs;
#pragma unroll
            for (int ai = 0; ai < 2; ++ai)
#pragma unroll
                for (int m = 0; m < 4; ++m) { const int row = row0 + ai * HALF + m * 16; const float r = rs[row]; bf16_t* rowp = O + (size_t)row * ldc + col0; float v[8];
#pragma unroll
                    for (int n = 0; n < 2; ++n)
#pragma unroll
                        for (int j = 0; j < 4; ++j) { float x = (float)__float_as_int(acc[ai][bj][m][n][j]) * (r * sw[n][j]); v[n * 4 + j] = sg ? fast_sigmoid(x) : x; }
                    u32x4 w; w.x = cvt_pk_bf16(v[0], v[1]); w.y = cvt_pk_bf16(v[2], v[3]); w.z = cvt_pk_bf16(v[4], v[5]); w.w = cvt_pk_bf16(v[6], v[7]);
                    *(u32x4*)(rowp + bj * HALF) = w; } }
    }
};
struct EpiBf16Sig {
    static constexpr bool PERM = true, KEEP_SUB0 = false;
    bf16_t* O; int ldc; int sig_from; float osc;
    __device__ __forceinline__ void operator()(const f32x4 (&acc)[2][2][4][2], const Unit& u, int wr, int wc, int fr, int fq) const {
        const int row0 = u.pm * BM + wr * 64 + fr, col0 = u.pn * BM + wc * 32 + 8 * fq; const bool sg = u.pn >= sig_from;
#pragma unroll
        for (int ai = 0; ai < 2; ++ai)
#pragma unroll
            for (int m = 0; m < 4; ++m) { bf16_t* rowp = O + (size_t)(row0 + ai * HALF + m * 16) * ldc + col0;
#pragma unroll
                for (int bj = 0; bj < 2; ++bj) { f32x4 v0 = acc[ai][bj][m][0] * osc, v1 = acc[ai][bj][m][1] * osc;
                    if (sg) {
#pragma unroll
                        for (int j = 0; j < 4; ++j) { v0[j] = fast_sigmoid(v0[j]); v1[j] = fast_sigmoid(v1[j]); } }
                    u32x4 w; w.x = cvt_pk_bf16(v0[0], v0[1]); w.y = cvt_pk_bf16(v0[2], v0[3]); w.z = cvt_pk_bf16(v1[0], v1[1]); w.w = cvt_pk_bf16(v1[2], v1[3]);
                    *(u32x4*)(rowp + bj * HALF) = w; } }
    }
};
struct EpiBf16Row {
    static constexpr bool PERM = true, KEEP_SUB0 = false;
    bf16_t* O; int ldc; const float* rowscale;
    __device__ __forceinline__ void operator()(const f32x4 (&acc)[2][2][4][2], const Unit& u, int wr, int wc, int fr, int fq) const {
        const int row0 = u.pm * BM + wr * 64 + fr, col0 = u.pn * BM + wc * 32 + 8 * fq;
#pragma unroll
        for (int ai = 0; ai < 2; ++ai)
#pragma unroll
            for (int m = 0; m < 4; ++m) { const int row = row0 + ai * HALF + m * 16; const float r = rowscale[row]; bf16_t* rowp = O + (size_t)row * ldc + col0;
#pragma unroll
                for (int bj = 0; bj < 2; ++bj) { const f32x4 v0 = acc[ai][bj][m][0] * r, v1 = acc[ai][bj][m][1] * r;
                    u32x4 w; w.x = cvt_pk_bf16(v0[0], v0[1]); w.y = cvt_pk_bf16(v0[2], v0[3]); w.z = cvt_pk_bf16(v1[0], v1[1]); w.w = cvt_pk_bf16(v1[2], v1[3]);
                    *(u32x4*)(rowp + bj * HALF) = w; } }
    }
};
struct EpiPool {
    static constexpr bool PERM = true, KEEP_SUB0 = false;
    bf16_t* O; int ldc; const float* scale;
    __device__ __forceinline__ void operator()(const f32x4 (&acc)[2][2][4][2], const Unit& u, int, int, int, int) const {
        int tz = threadIdx.x; asm volatile("" : "+v"(tz));
        const int wid = tz >> 6, lane = tz & 63, wr = wid >> 2, wc = wid & 3, fr = lane & 15, fq = lane >> 4;
        const int row0 = u.pm * BM + wr * 64 + fr, col0 = u.pn * BM + wc * 32 + 8 * fq;
#pragma unroll
        for (int bj = 0; bj < 2; ++bj) { const f32x4 sv0 = *(const f32x4*)(scale + col0 + bj * HALF), sv1 = *(const f32x4*)(scale + col0 + bj * HALF + 4);
#pragma unroll
            for (int ai = 0; ai < 2; ++ai)
#pragma unroll
                for (int m = 0; m < 4; ++m) { bf16_t* rowp = O + (size_t)(row0 + ai * HALF + m * 16) * ldc + col0;
                    const f32x4 v0 = acc[ai][bj][m][0] * sv0, v1 = acc[ai][bj][m][1] * sv1;
                    u32x4 w; w.x = cvt_pk_bf16(v0[0], v0[1]); w.y = cvt_pk_bf16(v0[2], v0[3]); w.z = cvt_pk_bf16(v1[0], v1[1]); w.w = cvt_pk_bf16(v1[2], v1[3]);
                    *(u32x4*)(rowp + bj * HALF) = w; } }
    }
};
struct EpiBranch {
    static constexpr bool PERM = true, KEEP_SUB0 = true;
    bf16_t* O; int ldc; const bf16_t* proj;
    __device__ __forceinline__ void operator()(f32x4 (&acc)[2][2][4][2], const Unit& u, int, int, int, int) const {
        int tz = threadIdx.x; asm volatile("" : "+v"(tz));
        const int wid = tz >> 6, lane = tz & 63, wr = wid >> 2, wc = wid & 3, fr = lane & 15, fq = lane >> 4;
        const int row0 = u.pm * BM + wr * 64 + fr, col0 = u.pn * BM + wc * 32 + 8 * fq;
        if (u.sub == 0) {
#pragma unroll
            for (int ai = 0; ai < 2; ++ai)
#pragma unroll
                for (int mh = 0; mh < 2; ++mh) {
                    u32x4 ga[2][2], gp[2][2];
#pragma unroll
                    for (int mm = 0; mm < 2; ++mm)
#pragma unroll
                        for (int bj = 0; bj < 2; ++bj) { const bf16_t* gpt = proj + (size_t)(row0 + ai * HALF + (2 * mh + mm) * 16) * NIN + col0 + bj * HALF;
                            ga[mm][bj] = *(const u32x4*)(gpt + GA_OFF); gp[mm][bj] = *(const u32x4*)(gpt + GP_OFF); }
#pragma unroll
                    for (int mm = 0; mm < 2; ++mm)
#pragma unroll
                        for (int bj = 0; bj < 2; ++bj) { const int m = 2 * mh + mm;
#pragma unroll
                            for (int k = 0; k < 4; ++k) { const unsigned aw = ga[mm][bj][k], pw = gp[mm][bj][k];
                                const float r0 = bf_lo(aw) * __builtin_amdgcn_rcpf(fmaxf(bf_lo(pw), 1e-6f)), r1 = bf_hi(aw) * __builtin_amdgcn_rcpf(fmaxf(bf_hi(pw), 1e-6f));
                                acc[ai][bj][m][k >> 1][2 * (k & 1)] *= r0; acc[ai][bj][m][k >> 1][2 * (k & 1) + 1] *= r1; } }
                    asm volatile("" ::: "memory"); }
        } else {
#pragma unroll
            for (int ai = 0; ai < 2; ++ai) {
                u32x4 gp[4][2];
#pragma unroll
                for (int m = 0; m < 4; ++m)
#pragma unroll
                    for (int bj = 0; bj < 2; ++bj) gp[m][bj] = *(const u32x4*)(proj + (size_t)(row0 + ai * HALF + m * 16) * NIN + GP_OFF + col0 + bj * HALF);
#pragma unroll
                for (int m = 0; m < 4; ++m)
#pragma unroll
                    for (int bj = 0; bj < 2; ++bj) { u32x4 w;
#pragma unroll
                        for (int k = 0; k < 4; ++k) { const unsigned pw = gp[m][bj][k];
                            w[k] = cvt_pk_bf16(acc[ai][bj][m][k >> 1][2 * (k & 1)] * fmaxf(bf_lo(pw), 1e-6f), acc[ai][bj][m][k >> 1][2 * (k & 1) + 1] * fmaxf(bf_hi(pw), 1e-6f)); }
                        *(u32x4*)(O + (size_t)(row0 + ai * HALF + m * 16) * ldc + col0 + bj * HALF) = w; }
                asm volatile("" ::: "memory"); }
        }
    }
};

constexpr int DSLOT_OFF = 147456 - 64;
__device__ __forceinline__ unsigned dyn_resolve(const TileOrder& T, unsigned* ctr, int x, unsigned t) {
    const int q = T.nwg / NXCD, r = T.nwg % NXCD; int y = x;
    for (int k = 0; k < NXCD; ++k) {
        const int qy = q + (y < r ? 1 : 0);
        if ((int)t < qy) { const int wgid = (y < r ? y * (q + 1) : r * (q + 1) + (y - r) * q) + (int)t;
            const int nig = T.wgm * T.nN, gid = wgid / nig, fm = gid * T.wgm, gsz = (T.nM - fm) < T.wgm ? (T.nM - fm) : T.wgm;
            return (unsigned)(fm + ((wgid % nig) % gsz)) | ((unsigned)((wgid % nig) / gsz) << 16); }
        y = (y + 1) & (NXCD - 1); if (k + 1 < NXCD) t = atomicAdd(ctr + 32 * y, 1u);
    }
    return ~0u;
}
template <class Epi, class Sched, bool ALIGN_EPI, bool SP2, int PREC = 0, bool DYN = false>
__device__ __forceinline__ void gemm_phase(LAS unsigned char* lds, const int K, const Sched& S, const Epi& E, unsigned* dq = nullptr, int dx = 0) {
    constexpr bool FP8 = (PREC == 1), INT8 = (PREC == 2);
    int tid = threadIdx.x; asm volatile("" : "+v"(tid));
    const int wid = __builtin_amdgcn_readfirstlane(tid >> 6), lane = tid & 63, wr = wid >> 2, wc = wid & 3, fr = lane & 15, fq = lane >> 4;
    const int nt = K / BK;
    unsigned voffA[2], voffB[2];
#pragma unroll
    for (int i = 0; i < 2; ++i) { int R, C; stage_rc(tid * 16 + i * 8192, R, C);
        voffA[i] = (unsigned)(R * K + C) * 2u; voffB[i] = (unsigned)(tid * 16 + i * 8192); }
    const size_t kstep = (size_t)(BK * 2), kstepB = (size_t)HTB;
    const size_t hstep = (size_t)HALF * K * 2;
    const unsigned ldsw = (unsigned)wid * 1024u;
    const int aoff = FP8 ? lds_byte(wr * 64 + fr, fq * 16) : lds_byte(wr * 64 + fr, fq * 8), boff = FP8 ? lds_byte(wc * 32 + fr, fq * 16) : lds_byte(wc * 32 + fr, fq * 8);
    constexpr int KOFF = FP8 ? 16 : 1024;
#define PG8_SA(b, h) (((b) * 2 + (h)) * HTB)
#define PG8_SB(b, h) ((4 + (b) * 2 + (h)) * HTB)
#define PG8_STAGE(bufoff, gbase, voff) do { _Pragma("unroll") for (int _i = 0; _i < 2; ++_i) \
        __builtin_amdgcn_global_load_lds((const unsigned*)((const char*)(gbase) + (voff)[_i]), (LAS unsigned*)(lds + (bufoff) + ldsw + _i * 8192), 16, 0, 0); } while (0)
#define PG8_LD32(p) __builtin_shufflevector(*(const LAS i32x4*)(p), *(const LAS i32x4*)((p) + 16), 0, 1, 2, 3, 4, 5, 6, 7)
#define PG8_LDA(dst, b, h) do { if constexpr (FP8) { _Pragma("unroll") for (int m = 0; m < 4; ++m) dst##8[m] = PG8_LD32(lds + PG8_SA(b, h) + aoff + m * 2048); } \
        else { _Pragma("unroll") for (int m = 0; m < 4; ++m) _Pragma("unroll") for (int k = 0; k < 2; ++k) dst[m][k] = *(const LAS bf16x8*)(lds + PG8_SA(b, h) + aoff + m * 2048 + k * KOFF); } } while (0)
#define PG8_LDB(dst, b, h) do { if constexpr (FP8) { _Pragma("unroll") for (int n = 0; n < 2; ++n) dst##8[n] = PG8_LD32(lds + PG8_SB(b, h) + boff + n * 2048); } \
        else { _Pragma("unroll") for (int n = 0; n < 2; ++n) _Pragma("unroll") for (int k = 0; k < 2; ++k) dst[n][k] = *(const LAS bf16x8*)(lds + PG8_SB(b, h) + boff + n * 2048 + k * KOFF); } } while (0)
#define PG8_MMA(ai, bj, At, Bt) do { __builtin_amdgcn_s_setprio(1); _Pragma("unroll") for (int m = 0; m < 4; ++m) _Pragma("unroll") for (int n = 0; n < 2; ++n) { \
        if constexpr (FP8) asm volatile("v_mfma_scale_f32_16x16x128_f8f6f4 %0, %1, %2, %0, %3, %3 op_sel_hi:[0,0,0]" : "+v"(acc[ai][bj][m][n]) : "v"(Bt##8[n]), "v"(At##8[m]), "v"(one8));   \
        else if constexpr (INT8) { _Pragma("unroll") for (int k = 0; k < 2; ++k) acc[ai][bj][m][n] = __builtin_bit_cast(f32x4, __builtin_amdgcn_mfma_i32_16x16x64_i8(__builtin_bit_cast(i32x4, Bt[n][k]), __builtin_bit_cast(i32x4, At[m][k]), __builtin_bit_cast(i32x4, acc[ai][bj][m][n]), 0, 0, 0)); } \
        else { _Pragma("unroll") for (int k = 0; k < 2; ++k) acc[ai][bj][m][n] = __builtin_amdgcn_mfma_f32_16x16x32_bf16(Bt[n][k], At[m][k], acc[ai][bj][m][n], 0, 0, 0); } } \
        __builtin_amdgcn_s_setprio(0); } while (0)
#define PG8_WAIT_V(n) asm volatile("s_waitcnt vmcnt(" #n ")" ::: "memory")
#define PG8_WAIT_L(n) asm volatile("s_waitcnt lgkmcnt(" #n ")" ::: "memory")
#define PG8_BAR __builtin_amdgcn_s_barrier()
#define PG8_SCHED __builtin_amdgcn_sched_barrier(0)
    Unit cur, nxt; int ui = 0;
    volatile LAS unsigned* dslot = (volatile LAS unsigned*)(lds + DSLOT_OFF);
    unsigned tkv = 0;
    if constexpr (DYN) {
        if (tid == 0) { const unsigned t0 = atomicAdd(dq + 32 * dx, 1u); dslot[0] = dyn_resolve(S.T, dq, dx, t0); }
        __syncthreads();
        const unsigned code = (unsigned)__builtin_amdgcn_readfirstlane((int)dslot[0]);
        if (code == ~0u) return;
        cur.pm = (int)(code & 0xffffu); cur.pn = (int)(code >> 16); cur.sub = 0;
    } else { if (!S.next(0, cur)) return; }
    f32x4 acc[2][2][4][2];
#pragma unroll
    for (int a = 0; a < 2; ++a)
#pragma unroll
        for (int b = 0; b < 2; ++b)
#pragma unroll
            for (int m = 0; m < 4; ++m)
#pragma unroll
                for (int n = 0; n < 2; ++n) acc[a][b][m][n] = (f32x4){0.f, 0.f, 0.f, 0.f};
    const int one8 = 0x7F7F7F7F;
    bf16x8 At[4][2], B0[2][2], B1[2][2];
    i32x8 At8[4], B08[2], B18[2];
    const char* cA = S.aptr(cur); const char* cB = S.bptr(cur);
    if constexpr (SP2) {
        PG8_STAGE(PG8_SB(0, 0), cB, voffB); PG8_STAGE(PG8_SB(0, 1), cB + hstep, voffB); PG8_STAGE(PG8_SA(0, 0), cA, voffA); PG8_STAGE(PG8_SA(0, 1), cA + hstep, voffA);
        if (wr == 1) PG8_BAR;
        PG8_WAIT_V(2); PG8_BAR;
        PG8_STAGE(PG8_SB(1, 0), cB + kstepB, voffB); PG8_STAGE(PG8_SA(1, 0), cA + kstep, voffA); PG8_STAGE(PG8_SB(1, 1), cB + hstep + kstepB, voffB);
        PG8_WAIT_V(6); PG8_BAR;
    } else {
        PG8_STAGE(PG8_SB(0, 0), cB, voffB); PG8_STAGE(PG8_SA(0, 0), cA, voffA); PG8_STAGE(PG8_SB(0, 1), cB + hstep, voffB); PG8_STAGE(PG8_SA(0, 1), cA + hstep, voffA);
        if (wr == 1) PG8_BAR;
        PG8_WAIT_V(4); PG8_BAR;
        PG8_STAGE(PG8_SB(1, 0), cB + kstepB, voffB); PG8_STAGE(PG8_SA(1, 0), cA + kstep, voffA); PG8_STAGE(PG8_SB(1, 1), cB + hstep + kstepB, voffB);
        PG8_WAIT_V(6); PG8_BAR;
    }
    for (;;) {
        bool has_next = false; const char* nA = cA; const char* nB = cB;
        if constexpr (DYN) { if (tid == 0) tkv = atomicAdd(dq + 32 * dx, 1u); }
        else { has_next = S.next(ui + 1, nxt); if (has_next) { nA = S.aptr(nxt); nB = S.bptr(nxt); } }
        const int tq = nt >= 12 ? 8 : 0;
#pragma unroll 1
        for (int t = 0; t < nt; t += 2) {
            const bool last = (t == nt - 2);
            if constexpr (DYN) {
                if (t == tq) { if (tid == 0) dslot[0] = dyn_resolve(S.T, dq, dx, tkv); }
                if (last) { const unsigned code = (unsigned)__builtin_amdgcn_readfirstlane((int)dslot[0]); has_next = code != ~0u;
                    if (has_next) { nxt.pm = (int)(code & 0xffffu); nxt.pn = (int)(code >> 16); nxt.sub = 0; nA = S.aptr(nxt); nB = S.bptr(nxt); } }
            }
            const char* a1 = cA + (size_t)(t + 1) * kstep;
            const char* a2 = last ? nA : cA + (size_t)(t + 2) * kstep; const char* b2 = last ? nB : cB + (size_t)(t + 2) * kstepB;
            const char* a3 = a2 + kstep; const char* b3 = b2 + kstepB;
            if constexpr (SP2) {
            PG8_LDB(B0, 0, 0); PG8_LDB(B1, 0, 1); PG8_SCHED; PG8_LDA(At, 0, 0); PG8_STAGE(PG8_SA(1, 1), a1 + hstep, voffA);
            PG8_WAIT_V(8); PG8_WAIT_L(0); PG8_BAR; PG8_MMA(0, 0, At, B0); PG8_MMA(0, 1, At, B1); PG8_BAR; PG8_SCHED;
            PG8_LDA(At, 0, 1); PG8_STAGE(PG8_SB(0, 0), b2, voffB); PG8_STAGE(PG8_SB(0, 1), b2 + hstep, voffB); PG8_STAGE(PG8_SA(0, 0), a2, voffA);
            PG8_WAIT_V(8); PG8_WAIT_L(0); PG8_BAR; PG8_MMA(1, 0, At, B0); PG8_MMA(1, 1, At, B1); PG8_BAR; PG8_SCHED;
            PG8_LDB(B0, 1, 0); PG8_LDB(B1, 1, 1); PG8_SCHED; PG8_LDA(At, 1, 0); PG8_STAGE(PG8_SA(0, 1), a2 + hstep, voffA);
            PG8_WAIT_V(8); PG8_WAIT_L(0); PG8_BAR; PG8_MMA(0, 0, At, B0); PG8_MMA(0, 1, At, B1); PG8_BAR; PG8_SCHED;
            PG8_LDA(At, 1, 1); PG8_STAGE(PG8_SB(1, 0), b3, voffB); PG8_STAGE(PG8_SB(1, 1), b3 + hstep, voffB); PG8_STAGE(PG8_SA(1, 0), a3, voffA);
            PG8_WAIT_V(8); PG8_WAIT_L(0); PG8_BAR; PG8_MMA(1, 0, At, B0); PG8_MMA(1, 1, At, B1); PG8_BAR; PG8_SCHED;
            } else {
            PG8_LDB(B0, 0, 0); PG8_SCHED; PG8_LDA(At, 0, 0); PG8_STAGE(PG8_SA(1, 1), a1 + hstep, voffA);
            PG8_WAIT_L(8); PG8_BAR; PG8_WAIT_L(0); PG8_MMA(0, 0, At, B0); PG8_BAR; PG8_SCHED;
            PG8_LDB(B1, 0, 1); PG8_STAGE(PG8_SB(0, 0), b2, voffB);
            PG8_BAR; PG8_WAIT_L(0); PG8_MMA(0, 1, At, B1); PG8_BAR;
            PG8_LDA(At, 0, 1); PG8_STAGE(PG8_SA(0, 0), a2, voffA);
            PG8_BAR; PG8_WAIT_L(0); PG8_MMA(1, 0, At, B0); PG8_BAR; PG8_SCHED;
            PG8_STAGE(PG8_SB(0, 1), b2 + hstep, voffB);
            PG8_WAIT_V(6); PG8_BAR; PG8_MMA(1, 1, At, B1); PG8_BAR;
            PG8_LDB(B0, 1, 0); PG8_SCHED; PG8_LDA(At, 1, 0); PG8_STAGE(PG8_SA(0, 1), a2 + hstep, voffA);
            PG8_WAIT_L(8); PG8_BAR; PG8_WAIT_L(0); PG8_MMA(0, 0, At, B0); PG8_BAR; PG8_SCHED;
            PG8_LDB(B1, 1, 1); PG8_STAGE(PG8_SB(1, 0), b3, voffB);
            PG8_BAR; PG8_WAIT_L(0); PG8_MMA(0, 1, At, B1); PG8_BAR;
            PG8_LDA(At, 1, 1); PG8_STAGE(PG8_SA(1, 0), a3, voffA);
            PG8_BAR; PG8_WAIT_L(0); PG8_MMA(1, 0, At, B0); PG8_BAR; PG8_SCHED;
            PG8_STAGE(PG8_SB(1, 1), b3 + hstep, voffB);
            PG8_WAIT_V(6); PG8_BAR; PG8_MMA(1, 1, At, B1); PG8_BAR;
            }
        }
        if constexpr (ALIGN_EPI) { if (wr == 0) PG8_BAR; }
        if constexpr (FP8) asm volatile("s_nop 15\n\ts_nop 15" ::: "memory");
        E(acc, cur, wr, wc, fr, fq);
        if (!has_next) break;
        if (!(Epi::KEEP_SUB0 && cur.sub == 0)) {
#pragma unroll
        for (int a = 0; a < 2; ++a)
#pragma unroll
            for (int b = 0; b < 2; ++b)
#pragma unroll
                for (int m = 0; m < 4; ++m)
#pragma unroll
                    for (int n = 0; n < 2; ++n) acc[a][b][m][n] = (f32x4){0.f, 0.f, 0.f, 0.f}; }
        cur = nxt; cA = nA; cB = nB; ++ui;
        if constexpr (ALIGN_EPI) { if (wr == 1) PG8_BAR; }
    }
    PG8_WAIT_V(0);
    if constexpr (!ALIGN_EPI) { if (wr == 0) PG8_BAR; }
    PG8_BAR;
#undef PG8_SA
#undef PG8_SB
#undef PG8_STAGE
#undef PG8_LDA
#undef PG8_LD32
#undef PG8_LDB
#undef PG8_MMA
#undef PG8_WAIT_V
#undef PG8_WAIT_L
#undef PG8_BAR
#undef PG8_SCHED
}
}

#ifndef I8_GU1
#define I8_GU1 1
#endif
#ifndef I8_GU2
#define I8_GU2 1
#endif
#ifndef I8_IN
#define I8_IN 1
#endif
#ifndef I8_D1
#define I8_D1 1
#endif
#ifndef I8_D2
#define I8_D2 1
#endif
#ifndef F8_D2N
#define F8_D2N (I8_D2 ? 0 : 8)
#endif
#define F8_D2 (F8_D2N == 16)
#ifndef DYN_GEMM
#define DYN_GEMM true
#endif
#ifndef POOL_FROM_H
#define POOL_FROM_H 1
#endif
#ifndef I8_POOL
#define I8_POOL 0
#endif
#ifndef W_IN_P0_SLABS
#define W_IN_P0_SLABS ((I8_POOL ? GA_OFF : POOL_OFF) / 32)
#endif
#ifndef WGM_G
#define WGM_G 8
#endif
#ifndef WGM_D
#define WGM_D 4
#endif
#ifndef PG8_SP2
#define PG8_SP2 true
#endif
#ifndef PG8_ALIGN
#define PG8_ALIGN true
#endif

constexpr int RING_BYTES = 131072;
constexpr int LDS_BYTES = 147456;
constexpr int MISC_OFF = LDS_BYTES - 256;
static_assert(pg8::DSLOT_OFF == MISC_OFF + 192, "dynamic-unit LDS word");

struct Args {
    const float* x; const float* n1pre; const float* n1post; const float* w1g; const float* w1u; const float* w1d;
    const float* nmpre; const float* nmpost; const float* win; const float* poolw; const float* poolscale; const float* wab; const float* wpb; const float* wout;
    const float* n2pre; const float* n2post; const float* w2g; const float* w2u; const float* w2d;
    float* out; unsigned char* ws; int ph_lo, ph_hi;
};


#define KARG(T, member) (karg_load<T>(__builtin_offsetof(Args, member)))
template <class T> __device__ __forceinline__ T karg_load(unsigned off) {
    const char __attribute__((address_space(4)))* kp = (const char __attribute__((address_space(4)))*)__builtin_amdgcn_kernarg_segment_ptr(); asm volatile("" : "+s"(kp));
    return *(const T __attribute__((address_space(4)))*)(kp + off);
}
__device__ __forceinline__ void transpose_item(const float* W, int K, int N, bf16_t* WT, int mode, LAS float* scr, int item, int lane, const float* kgain = nullptr) {
    const int nblk = N / 32, kb = item / nblk, nb = item % nblk, k0 = 64 * kb, n0 = 32 * nb;
    int drow = n0;
    if (mode == 1) drow = (n0 >> 7) * 256 + (n0 & 127);
    else if (mode == 2) drow = (n0 >> 7) * 256 + 128 + (n0 & 127);
#pragma unroll 8
    for (int i = 0; i < 32; ++i) { const int kk = 2 * i + (lane >> 5); scr[kk * 33 + (lane & 31)] = W[(size_t)(k0 + kk) * N + n0 + (lane & 31)] * (kgain ? kgain[k0 + kk] : 1.0f); }
    asm volatile("s_waitcnt lgkmcnt(0)" ::: "memory");
    const int c = lane & 7;
    unsigned char* blk = (unsigned char*)WT + ((size_t)(drow >> 7) * (K / 64) + kb) * 16384;
#pragma unroll
    for (int j = 0; j < 4; ++j) { const int n = (lane >> 3) + 8 * j; const LAS float* s = scr + (8 * c) * 33 + n;
        u32x4 o; o.x = cvt_pk_bf16(s[0 * 33], s[1 * 33]); o.y = cvt_pk_bf16(s[2 * 33], s[3 * 33]); o.z = cvt_pk_bf16(s[4 * 33], s[5 * 33]); o.w = cvt_pk_bf16(s[6 * 33], s[7 * 33]);
        const int slot = 16 * ((n >> 2) & 1) + 4 * (n >> 3) + (n & 3);
        *(u32x4*)(blk + pg8::lds_byte((drow & 127) + slot, 8 * c)) = o; }
    asm volatile("s_waitcnt lgkmcnt(0)" ::: "memory");
}

template <bool INT8> __device__ __forceinline__ void transpose_item8(const float* W, int K, int N, unsigned char* WT, LAS float* scr, int kb, int nb, int d0, float scale, const unsigned* cmax, int lane) {
    const int k0 = 64 * kb, n0 = 32 * nb;
#pragma unroll 8
    for (int i = 0; i < 32; ++i) { const int kk = 2 * i + (lane >> 5); scr[kk * 33 + (lane & 31)] = W[(size_t)(k0 + kk) * N + n0 + (lane & 31)]; }
    asm volatile("s_waitcnt lgkmcnt(0)" ::: "memory");
    const int c = lane & 3;
    unsigned char* blk = WT + ((size_t)(d0 >> 7) * (K / 128) + (k0 >> 7)) * 16384;
#pragma unroll
    for (int j = 0; j < 2; ++j) { const int n = (lane >> 2) + 16 * j; const LAS float* sp = scr + (16 * c) * 33 + n;
        if (INT8) scale = 127.0f / fmaxf(__uint_as_float(cmax[n0 + n]), 1e-30f);
        u32x4 o;
#pragma unroll
        for (int q = 0; q < 4; ++q) { const float e0 = sp[(4 * q) * 33] * scale, e1 = sp[(4 * q + 1) * 33] * scale, e2 = sp[(4 * q + 2) * 33] * scale, e3 = sp[(4 * q + 3) * 33] * scale;
            o[q] = INT8 ? pack4_i8(e0, e1, e2, e3) : cvt4_fp8(e0, e1, e2, e3); }
        const int slot = 16 * ((n >> 2) & 1) + 4 * (n >> 3) + (n & 3);
        *(u32x4*)(blk + pg8::lds_byte((d0 & 127) + slot, ((k0 & 127) + 16 * c) >> 1)) = o; }
    asm volatile("s_waitcnt lgkmcnt(0)" ::: "memory");
}
__device__ __forceinline__ void slab_convert_i8(const float* W, int N, unsigned char* WT, int n0, int d0, unsigned* cmax, unsigned* arrive, int khalf, LAS float* red, int tid) {
    const int lane = tid & 63, w = __builtin_amdgcn_readfirstlane(tid >> 6), c = lane & 31, h = lane >> 5, kb0 = khalf * (D / 2) + w * 256 + h * 128;
    const float* rowbase = W + (size_t)(khalf * (D / 2) + w * 256) * N + n0; const unsigned loff = (unsigned)(h * 128 * N + c);
    float v[128];
#pragma unroll
    for (int i = 0; i < 128; ++i) v[i] = (rowbase + (size_t)i * N)[loff];
    __builtin_amdgcn_sched_barrier(0);
    float m = 0.f;
#pragma unroll
    for (int i = 0; i < 128; ++i) m = fmaxf(m, fabsf(v[i]));
    m = fmaxf(m, __shfl_xor(m, 32));
    if (h == 0) red[w * 32 + c] = m;
    __syncthreads();
    if (tid < 32) { float mm = red[tid];
#pragma unroll
        for (int j = 1; j < 8; ++j) mm = fmaxf(mm, red[j * 32 + tid]);
        const unsigned old = atomicMax(cmax + n0 + tid, __float_as_uint(mm)); asm volatile("" :: "v"(old)); }
    __syncthreads();
    if (tid == 0) { xb_add(arrive, 1u); unsigned sp = 0; while (xb_ld(arrive) < 2u && ++sp < (1u << 22)) __builtin_amdgcn_s_sleep(1); }
    __syncthreads();
    const float scale = 127.0f / fmaxf(__uint_as_float(xb_ld(cmax + n0 + c)), 1e-30f);
    const int slot = 16 * ((c >> 2) & 1) + 4 * (c >> 3) + (c & 3);
    unsigned char* blk = WT + ((size_t)(d0 >> 7) * (D / 128) + (kb0 >> 7)) * 16384;
#pragma unroll
    for (int j = 0; j < 8; ++j) { u32x4 o;
#pragma unroll
        for (int q = 0; q < 4; ++q) o[q] = pack4_i8(v[16 * j + 4 * q] * scale, v[16 * j + 4 * q + 1] * scale, v[16 * j + 4 * q + 2] * scale, v[16 * j + 4 * q + 3] * scale);
        *(u32x4*)(blk + pg8::lds_byte((d0 & 127) + slot, 8 * j)) = o; }
}
template <int LIST> __device__ __forceinline__ void p0_slabs(const Args& a, LAS unsigned char* lds, unsigned* ctl, int pair, int npairs, int khalf, int tid, int s_lo = 0, int s_hi = 1 << 30) {
    asm volatile("" : "+v"(tid));
    unsigned char* ws = a.ws; unsigned* cm = ctl + CW_CMAX; LAS float* red = (LAS float*)lds;
    constexpr int SPT = FF / 32, NS0 = ((I8_GU1 ? 2 : 0) + (I8_GU2 ? 2 : 0)) * SPT, NQ = (I8_POOL ? GA_OFF : POOL_OFF) / 32, NS1 = I8_IN ? NQ + (NIN - GA_OFF) / 32 : 0;
    for (int sl = (LIST == 0 ? 0 : s_lo) + pair; sl < (LIST == 0 ? NS0 : (s_hi < NS1 ? s_hi : NS1)); sl += npairs) {
        if (LIST == 0) { int t = sl / SPT; const int n0 = 32 * (sl - t * SPT); if (!I8_GU1) t += 2;
            const float* W = t == 0 ? KARG(const float*, w1g) : t == 1 ? KARG(const float*, w1u) : t == 2 ? KARG(const float*, w2g) : KARG(const float*, w2u);
            slab_convert_i8(W, FF, ws + (t < 2 ? WS_WGU1 : WS_WGU2), n0, (n0 >> 7) * 256 + (t & 1) * 128 + (n0 & 127), cm + t * FF, ctl + CW_SLAB + sl, khalf, red, tid); }
        else { const bool qkv = sl < NQ; const int n0 = qkv ? 32 * sl : GA_OFF + 32 * (sl - NQ);
            slab_convert_i8(KARG(const float*, win), NIN, ws + (qkv ? WS_WIN : WS_WIN8), n0, qkv ? n0 : n0 - GA_OFF, cm + CM_WIN, ctl + CW_SLAB + 4 * SPT + sl, khalf, red, tid); }
        __syncthreads(); }
}
#define DYN_ROWS_BEGIN(ctr) { const int ks_ = ((M / NGW) * 5) / 8; const bool dyn_ = (ctr) != nullptr && ks_ >= 1; int k_ = 0; unsigned ndv_ = 0; unsigned* dc_ = (ctr) + (gw & 63) * 32; \
    for (int m = gw; m < M; ) { const bool nd_ = dyn_ && (k_ + 1 >= ks_); if (nd_) { ndv_ = 0; if (lane == 0) ndv_ = atomicAdd(dc_, 1u); }
#define DYN_ROWS_END() ++k_; m = !dyn_ ? m + NGW : (nd_ ? ks_ * NGW + (gw & 63) + 64 * (int)__builtin_amdgcn_readfirstlane(ndv_) : gw + k_ * NGW); } }
template <int N> __device__ __forceinline__ void fwht_regs(float (&v)[N]) {
#pragma unroll
    for (int h = 1; h < N; h <<= 1)
#pragma unroll
        for (int i = 0; i < N; i += 2 * h)
#pragma unroll
            for (int j = i; j < i + h; ++j) { const float a = v[j], b = v[j + h]; v[j] = a + b; v[j + h] = a - b; }
}
__device__ __forceinline__ void actq_phase(const bf16_t* act, unsigned char* aq, float* rs2, int gw, int NGW, int lane, unsigned* dctr = nullptr) {
    asm volatile("" : "+v"(lane));
    static_assert(FF == 21 * 512 + 256, "row = 21 full chunks of 512 + one of 256");
    DYN_ROWS_BEGIN(dctr)
        const u32x4* src = (const u32x4*)(act + (size_t)m * FF) + lane;
        u32x4 w[22];
#pragma unroll
        for (int i = 0; i < 21; ++i) w[i] = src[64 * i];
        w[21] = lane < 32 ? src[64 * 21] : (u32x4){0u, 0u, 0u, 0u};
        float amax = 0.f; const float sg1 = (lane & 1) ? -1.f : 1.f, sg2 = (lane & 2) ? -1.f : 1.f, sg4 = (lane & 4) ? -1.f : 1.f;
#pragma unroll
        for (int i = 0; i < 22; ++i) { float v[8] = {bf_lo(w[i].x), bf_hi(w[i].x), bf_lo(w[i].y), bf_hi(w[i].y), bf_lo(w[i].z), bf_hi(w[i].z), bf_lo(w[i].w), bf_hi(w[i].w)};
            fwht_regs<8>(v);
#pragma unroll
            for (int r = 0; r < 8; ++r) v[r] = fmaf(v[r], sg1, lane_xor1(v[r]));
#pragma unroll
            for (int r = 0; r < 8; ++r) v[r] = fmaf(v[r], sg2, lane_xor2(v[r]));
#pragma unroll
            for (int r = 0; r < 8; ++r) v[r] = fmaf(v[r], sg4, lane_xor4(v[r]));
            u32x4 o; o.x = cvt_pk_bf16(v[0], v[1]); o.y = cvt_pk_bf16(v[2], v[3]); o.z = cvt_pk_bf16(v[4], v[5]); o.w = cvt_pk_bf16(v[6], v[7]); w[i] = o;
            amax = fmaxf(fmaxf(fmaxf(amax, fmaxf(fabsf(v[0]), fabsf(v[1]))), fmaxf(fabsf(v[2]), fabsf(v[3]))), fmaxf(fmaxf(fabsf(v[4]), fabsf(v[5])), fmaxf(fabsf(v[6]), fabsf(v[7]))));
            if ((i & 3) == 3) __builtin_amdgcn_sched_barrier(0); }
        amax = fmaxf(wave_max(amax), 1e-30f); const float qs = 127.0f / amax; if (lane == 0) rs2[m] = amax * (1.0f / (8.f * 127.f));
        u32x2* dst = (u32x2*)(aq + (size_t)m * FF) + lane;
#pragma unroll
        for (int i = 0; i < 22; ++i) { u32x2 o; o.x = pack4_i8(bf_lo(w[i].x) * qs, bf_hi(w[i].x) * qs, bf_lo(w[i].y) * qs, bf_hi(w[i].y) * qs); o.y = pack4_i8(bf_lo(w[i].z) * qs, bf_hi(w[i].z) * qs, bf_lo(w[i].w) * qs, bf_hi(w[i].w) * qs);
            if (i < 21 || lane < 32) dst[64 * i] = o; }
    DYN_ROWS_END()
}
template <int PASS> __device__ __forceinline__ void wd_pass(const float* W, unsigned char* WT, unsigned* cmax, int gw, int NGW, int lane) {
    asm volatile("" : "+v"(lane));
    const int n = lane & 31, hh = lane >> 5; const float sgh = hh ? -1.f : 1.f;
    constexpr int NB = D / 32, ITEMS = (FF / 64) * NB;
    for (int it = gw; it < ITEMS; it += NGW) { const int kb = it / NB, nb = it - kb * NB, k0 = 64 * kb, n0 = 32 * nb;
        const float* src = W + (size_t)(k0 + 32 * hh) * D + n0 + n;
        float v[32];
#pragma unroll
        for (int i = 0; i < 32; ++i) v[i] = src[(size_t)i * D];
        fwht_regs<32>(v);
#pragma unroll
        for (int i = 0; i < 32; ++i) v[i] = fmaf(v[i], sgh, __shfl_xor(v[i], 32));
        if (PASS == 0) { float mx = 0.f;
#pragma unroll
            for (int i = 0; i < 32; ++i) mx = fmaxf(mx, fabsf(v[i]));
            mx = fmaxf(mx, __shfl_xor(mx, 32));
            if (hh == 0) atomicMax(cmax + n0 + n, __float_as_uint(mx)); }
        else { const float scale = 127.0f / fmaxf(__uint_as_float(cmax[n0 + n]), 1e-30f);
            const int slot = 16 * ((n >> 2) & 1) + 4 * (n >> 3) + (n & 3);
            unsigned char* blk = WT + ((size_t)(n0 >> 7) * (FF / 128) + (k0 >> 7)) * 16384;
#pragma unroll
            for (int cc = 0; cc < 2; ++cc) { u32x4 o;
#pragma unroll
                for (int q = 0; q < 4; ++q) o[q] = pack4_i8(v[16 * cc + 4 * q] * scale, v[16 * cc + 4 * q + 1] * scale, v[16 * cc + 4 * q + 2] * scale, v[16 * cc + 4 * q + 3] * scale);
                *(u32x4*)(blk + pg8::lds_byte((n0 & 127) + slot, ((k0 & 127) + 32 * hh + 16 * cc) >> 1)) = o; } }
    }
}
template <int SET> __device__ __forceinline__ void p0_weights(const Args& a, LAS unsigned char* lds, int gw, int NGW, int wave, int lane, const unsigned* wq) {
    asm volatile("" : "+v"(lane));
    LAS float* scr = (LAS float*)(lds + wave * 16384);
    unsigned char* ws = a.ws;
    constexpr int I_GU = (D / 64) * (FF / 32), I_DN = (FF / 64) * (D / 32), I_IN = (D / 64) * (NIN / 32), I_OUT = (D / 64) * (D / 32), I_BR = (1024 / 64) * (D / 32), I_PL = (256 / 64) * (256 / 32);
    constexpr int NITEMS = SET == 0 ? 4 * I_GU + I_DN + I_OUT + 2 * I_BR + 4 * I_PL : (SET == 1 ? I_IN : I_DN);
    for (int it = gw; it < NITEMS; it += NGW) {
        int r = it; const float* W; int K, N, mode = 0, q8 = 0  , d0 = -1, wslot = 0; bf16_t* WT;
        if (SET == 1) { W = KARG(const float*, win); K = D; N = NIN; WT = (bf16_t*)(ws + WS_WIN); const int col = 32 * (r % (NIN / 32));
            if (I8_IN) { if (col < (I8_POOL ? GA_OFF : POOL_OFF)) { q8 = 2; d0 = col; wslot = CM_WIN; } else if (col >= GA_OFF) { q8 = 2; d0 = col - GA_OFF; wslot = CM_WIN; WT = (bf16_t*)(ws + WS_WIN8); } }
            else if (col >= GA_OFF && col < GP_OFF) { q8 = 1; d0 = col - GA_OFF; WT = (bf16_t*)(ws + WS_WIN8); } }
        else if (SET == 2) { W = KARG(const float*, w2d); K = FF; N = D; WT = (bf16_t*)(ws + WS_WD2); const int col = 32 * (r % (D / 32)); if (col < 256 * F8_D2N) { q8 = 1; d0 = col; } }
        else if (r < I_GU) { W = KARG(const float*, w1g); K = D; N = FF; WT = (bf16_t*)(ws + WS_WGU1); mode = 1; if (I8_GU1) { q8 = 2; wslot = CM_W1G; } }
        else if ((r -= I_GU) < I_GU) { W = KARG(const float*, w1u); K = D; N = FF; WT = (bf16_t*)(ws + WS_WGU1); mode = 2; if (I8_GU1) { q8 = 2; wslot = CM_W1U; } }
        else if ((r -= I_GU) < I_GU) { W = KARG(const float*, w2g); K = D; N = FF; WT = (bf16_t*)(ws + WS_WGU2); mode = 1; if (I8_GU2) { q8 = 2; wslot = CM_W2G; } }
        else if ((r -= I_GU) < I_GU) { W = KARG(const float*, w2u); K = D; N = FF; WT = (bf16_t*)(ws + WS_WGU2); mode = 2; if (I8_GU2) { q8 = 2; wslot = CM_W2U; } }
        else if ((r -= I_GU) < I_DN) { if (I8_D1) continue; W = KARG(const float*, w1d); K = FF; N = D; WT = (bf16_t*)(ws + WS_WD1); }
        else if ((r -= I_DN) < I_OUT) { W = KARG(const float*, wout); K = D; N = D; WT = (bf16_t*)(ws + WS_WOUT); }
        else if ((r -= I_OUT) < I_BR) { W = KARG(const float*, wab); K = 1024; N = D; WT = (bf16_t*)(ws + WS_WBA); }
        else if ((r -= I_BR) < I_BR) { W = KARG(const float*, wpb); K = 1024; N = D; WT = (bf16_t*)(ws + WS_WBP); }
        else { r -= I_BR; const int g = r / I_PL; r -= g * I_PL; W = KARG(const float*, poolw) + (size_t)g * 65536; K = 256; N = 256; WT = (bf16_t*)(ws + WS_WPL) + (size_t)g * 65536; }
        if (q8) { const int nblk = N / 32, kb = r / nblk, nb = r % nblk, n0 = 32 * nb;
            if (mode == 1) d0 = (n0 >> 7) * 256 + (n0 & 127); else if (mode == 2) d0 = (n0 >> 7) * 256 + 128 + (n0 & 127);
            if (q8 == 2) continue;
            else transpose_item8<false>(W, K, N, (unsigned char*)WT, scr, kb, nb, d0, 64.f, nullptr, lane); }
        else transpose_item(W, K, N, WT, mode, scr, r, lane, (SET == 1 && I8_IN && POOL_FROM_H) ? KARG(const float*, nmpre) : nullptr);
    }
}

__device__ __forceinline__ void p0_norm(const float* x, const float* gain, bf16_t* xn, unsigned char* xq, float* rs, int gw, int NGW, int lane, unsigned* dctr = nullptr) {
    asm volatile("" : "+v"(lane));
    DYN_ROWS_BEGIN(dctr)
        const f32x4* xr = (const f32x4*)(x + (size_t)m * D) + lane; const f32x4* gr = (const f32x4*)gain + lane;
        f32x4 v[16]; float s = 0.f;
#pragma unroll
        for (int j = 0; j < 16; ++j) { v[j] = xr[64 * j]; s += (v[j][0] * v[j][0] + v[j][1] * v[j][1]) + (v[j][2] * v[j][2] + v[j][3] * v[j][3]); }
        const float rstd = 1.0f / sqrtf(wave_sum(s) * (1.0f / D) + RMS_EPS);
        float amax = 0.f;
#pragma unroll
        for (int j = 0; j < 16; ++j) { const f32x4 g = gr[64 * j]; v[j][0] *= rstd * g[0]; v[j][1] *= rstd * g[1]; v[j][2] *= rstd * g[2]; v[j][3] *= rstd * g[3];
            amax = fmaxf(fmaxf(amax, fmaxf(fabsf(v[j][0]), fabsf(v[j][1]))), fmaxf(fabsf(v[j][2]), fabsf(v[j][3]))); }
        if (xn) { u32x2* o = (u32x2*)(xn + (size_t)m * D) + lane;
#pragma unroll
            for (int j = 0; j < 16; ++j) { u32x2 w; w.x = cvt_pk_bf16(v[j][0], v[j][1]); w.y = cvt_pk_bf16(v[j][2], v[j][3]); o[64 * j] = w; } }
        if (xq) { amax = fmaxf(wave_max(amax), 1e-30f); const float qs = 127.0f / amax; if (lane == 0) rs[m] = amax * (1.0f / 127.f);
            unsigned* o = (unsigned*)(xq + (size_t)m * D) + lane;
#pragma unroll
            for (int j = 0; j < 16; ++j) o[64 * j] = pack4_i8(v[j][0] * qs, v[j][1] * qs, v[j][2] * qs, v[j][3] * qs); }
    DYN_ROWS_END()
}

template <bool BASE16, bool OUT16> __device__ __forceinline__ void norm_phase(LAS unsigned char* lds, const bf16_t* f, const void* base, void* hout, bf16_t* xn, unsigned char* xn8, float* rs, const float* gpost, const float* gpre, float coef, int gw, int NGW, int tid, float* rstd_out = nullptr, unsigned* dctr = nullptr) {
    asm volatile("" : "+v"(tid));
    const int lane = tid & 63;
    LAS f32x4* G1 = (LAS f32x4*)lds; LAS f32x4* G2 = (LAS f32x4*)(lds + 16384);
    for (int i = tid; i < D / 4; i += NTHREADS) { G1[i] = ((const f32x4*)gpost)[i]; if (xn || xn8) G2[i] = ((const f32x4*)gpre)[i]; }
    __syncthreads();
    DYN_ROWS_BEGIN(dctr)
        const u32x2* fr_ = (const u32x2*)(f + (size_t)m * D) + lane;
        u32x2 fw[16]; f32x4 v[16];
#pragma unroll
        for (int j = 0; j < 16; ++j) fw[j] = fr_[64 * j];
        if constexpr (BASE16) { const u32x2* br = (const u32x2*)((const bf16_t*)base + (size_t)m * D) + lane; u32x2 bw[16];
#pragma unroll
            for (int j = 0; j < 16; ++j) bw[j] = br[64 * j];
#pragma unroll
            for (int j = 0; j < 16; ++j) { v[j][0] = bf_lo(bw[j].x); v[j][1] = bf_hi(bw[j].x); v[j][2] = bf_lo(bw[j].y); v[j][3] = bf_hi(bw[j].y); } }
        else { const f32x4* br = (const f32x4*)((const float*)base + (size_t)m * D) + lane;
#pragma unroll
            for (int j = 0; j < 16; ++j) v[j] = br[64 * j]; }
        float s = 0.f;
#pragma unroll
        for (int j = 0; j < 16; ++j) { const float a0 = bf_lo(fw[j].x), a1 = bf_hi(fw[j].x), a2 = bf_lo(fw[j].y), a3 = bf_hi(fw[j].y); s += (a0 * a0 + a1 * a1) + (a2 * a2 + a3 * a3); }
        const float rstd = coef / sqrtf(wave_sum(s) * (1.0f / D) + RMS_EPS);
        float s2 = 0.f; f32x4* ho = (f32x4*)((float*)hout + (size_t)m * D) + lane; u32x2* ho16 = (u32x2*)((bf16_t*)hout + (size_t)m * D) + lane;
#pragma unroll
        for (int j = 0; j < 16; ++j) { const f32x4 g = G1[64 * j + lane]; f32x4 h;
            h[0] = v[j][0] + bf_lo(fw[j].x) * rstd * g[0]; h[1] = v[j][1] + bf_hi(fw[j].x) * rstd * g[1]; h[2] = v[j][2] + bf_lo(fw[j].y) * rstd * g[2]; h[3] = v[j][3] + bf_hi(fw[j].y) * rstd * g[3];
            v[j] = h; if constexpr (OUT16) { u32x2 w; w.x = cvt_pk_bf16(h[0], h[1]); w.y = cvt_pk_bf16(h[2], h[3]); ho16[64 * j] = w; } else ho[64 * j] = h; s2 += (h[0] * h[0] + h[1] * h[1]) + (h[2] * h[2] + h[3] * h[3]);
            if ((j & 3) == 3) __builtin_amdgcn_sched_barrier(0); }
        if (xn || xn8) {
            const float r2 = 1.0f / sqrtf(wave_sum(s2) * (1.0f / D) + RMS_EPS);
            if (rstd_out && lane == 0) rstd_out[m] = r2;
            float amax = 0.f;
#pragma unroll
            for (int j = 0; j < 16; ++j) { const f32x4 g = G2[64 * j + lane]; v[j][0] *= r2 * g[0]; v[j][1] *= r2 * g[1]; v[j][2] *= r2 * g[2]; v[j][3] *= r2 * g[3];
                amax = fmaxf(fmaxf(amax, fmaxf(fabsf(v[j][0]), fabsf(v[j][1]))), fmaxf(fabsf(v[j][2]), fabsf(v[j][3])));
                if ((j & 3) == 3) __builtin_amdgcn_sched_barrier(0); }
            if (xn) { u32x2* o = (u32x2*)(xn + (size_t)m * D) + lane;
#pragma unroll
                for (int j = 0; j < 16; ++j) { u32x2 w; w.x = cvt_pk_bf16(v[j][0], v[j][1]); w.y = cvt_pk_bf16(v[j][2], v[j][3]); o[64 * j] = w; } }
            if (xn8 && !rs) { unsigned* o = (unsigned*)(xn8 + (size_t)m * D) + lane;
#pragma unroll
                for (int j = 0; j < 16; ++j) o[64 * j] = cvt4_fp8(v[j][0], v[j][1], v[j][2], v[j][3]); }
            if (xn8 && rs) { amax = fmaxf(wave_max(amax), 1e-30f); const float qs = 127.0f / amax; if (lane == 0) rs[m] = amax * (1.0f / 127.f);
                unsigned* o = (unsigned*)(xn8 + (size_t)m * D) + lane;
#pragma unroll
                for (int j = 0; j < 16; ++j) o[64 * j] = pack4_i8(v[j][0] * qs, v[j][1] * qs, v[j][2] * qs, v[j][3] * qs); }
        }
    DYN_ROWS_END()
    __syncthreads();
}

template <int P> __device__ __forceinline__ void pool_delta_task(const bf16_t* proj, bf16_t* delta, int g, int mp, int lane) {
    const int m = 2 * mp + (lane >> 5), c = 8 * (lane & 31), t = m & (SEQ - 1);
    const bf16_t* zp = proj + (size_t)m * NIN + POOL_OFF + g * 256 + c;
    u32x4 w[P];
#pragma unroll
    for (int j = 0; j < P; ++j) w[j] = (j <= t) ? *(const u32x4*)(zp - (size_t)j * NIN) : (u32x4){0u, 0u, 0u, 0u};
    float s[8];
#pragma unroll
    for (int k = 0; k < 8; ++k) s[k] = 0.f;
#pragma unroll
    for (int j = 0; j < P; ++j) { s[0] += bf_lo(w[j].x); s[1] += bf_hi(w[j].x); s[2] += bf_lo(w[j].y); s[3] += bf_hi(w[j].y); s[4] += bf_lo(w[j].z); s[5] += bf_hi(w[j].z); s[6] += bf_lo(w[j].w); s[7] += bf_hi(w[j].w); }
    const int cnt = (t + 1) < P ? (t + 1) : P; const float ic = 1.0f / (float)cnt;
    u32x4 o; o.x = cvt_pk_bf16(s[0] * ic - bf_lo(w[0].x), s[1] * ic - bf_hi(w[0].x)); o.y = cvt_pk_bf16(s[2] * ic - bf_lo(w[0].y), s[3] * ic - bf_hi(w[0].y));
    o.z = cvt_pk_bf16(s[4] * ic - bf_lo(w[0].z), s[5] * ic - bf_hi(w[0].z)); o.w = cvt_pk_bf16(s[6] * ic - bf_lo(w[0].w), s[7] * ic - bf_hi(w[0].w));
    *(u32x4*)(delta + ((size_t)g * M + m) * 256 + c) = o;
}
__device__ __forceinline__ void pool_delta(const bf16_t* proj, bf16_t* delta, int gw, int NGW, int lane) {
    asm volatile("" : "+v"(lane));
    for (int task = gw; task < 2 * M; task += NGW) {
        const int g = task & 3, mp = task >> 2;
        if (g == 0) pool_delta_task<2>(proj, delta, 0, mp, lane);
        else if (g == 1) pool_delta_task<4>(proj, delta, 1, mp, lane);
        else if (g == 2) pool_delta_task<8>(proj, delta, 2, mp, lane);
        else pool_delta_task<16>(proj, delta, 3, mp, lane);
    }
}

namespace att {
__device__ __forceinline__ void attn_merge(const bf16_t* outg, const float* lse, bf16_t* attn, int gtid, int NT) {
    asm volatile("" : "+v"(gtid));
    for (int idx = gtid; idx < M * 128; idx += NT) {
        const int m = idx >> 7, c8 = (idx & 127) * 8, h = c8 >> 7;
        const float l0 = lse[(size_t)m * 8 + h], l1 = lse[((size_t)M + m) * 8 + h], l2 = lse[((size_t)2 * M + m) * 8 + h];
        const float mm = fmaxf(l0, fmaxf(l1, l2));
        float w0 = __expf(l0 - mm), w1 = __expf(l1 - mm), w2 = __expf(l2 - mm); const float inv = 1.0f / (w0 + w1 + w2); w0 *= inv; w1 *= inv; w2 *= inv;
        const u32x4 a = *(const u32x4*)(outg + (size_t)m * 1024 + c8), bq = *(const u32x4*)(outg + ((size_t)M + m) * 1024 + c8), c = *(const u32x4*)(outg + ((size_t)2 * M + m) * 1024 + c8);
        u32x4 o;
#pragma unroll
        for (int k = 0; k < 4; ++k) o[k] = cvt_pk_bf16(w0 * bf_lo(a[k]) + w1 * bf_lo(bq[k]) + w2 * bf_lo(c[k]), w0 * bf_hi(a[k]) + w1 * bf_hi(bq[k]) + w2 * bf_hi(c[k]));
        *(u32x4*)(attn + (size_t)m * 1024 + c8) = o;
    }
}
}


namespace att2 {
constexpr int VROW = 272, KBYTES = 32768, STG = KBYTES + 128 * VROW, N_UNITS = 3 * BATCH * 8 * 32;
static_assert(2 * STG <= MISC_OFF, "attention LDS");
struct Lane { int kR[2], kC[2]; unsigned ldsw; int koff, v_ch, v_kg, vcol, fr, fq, qbw, qi; };
struct UDec { const bf16_t* base; size_t rs; int qb, d, g, h, b, r; };
__device__ __forceinline__ UDec decode(const bf16_t* proj, int u) {
    UDec x; const int sub = u & 31; x.h = (u >> 5) & 7; x.b = (u >> 8) & 3; x.g = u >> 10;
    const int dsh = 2 * x.g, nbsh = 5 - dsh; x.d = 1 << dsh; x.qb = sub & ((1 << nbsh) - 1); x.r = sub >> nbsh;
    x.rs = (size_t)x.d * NIN; x.base = proj + ((size_t)x.b * SEQ + x.r) * NIN + x.g * 3072 + x.h * 128; return x;
}
__device__ __forceinline__ int first_half(int u) { const int g = u >> 10, nbsh = 5 - 2 * g; return ((u & 31) & ((1 << nbsh) - 1)) == 0 ? 1 : 0; }
template <int PAR> __device__ __forceinline__ void issue(LAS unsigned char* lds, const bf16_t* proj, int u, int half, const Lane& L, u32x4 (&vr)[4]) {
    const UDec x = decode(proj, u);
    const int i0 = 128 * x.qb - 128 * (1 - half);
    const bf16_t* kb = x.base + 1024 + (size_t)i0 * x.rs;
#pragma unroll
    for (int eh = 0; eh < 2; ++eh)
#pragma unroll
        for (int i = 0; i < 2; ++i)
            __builtin_amdgcn_global_load_lds((const unsigned*)(kb + 64 * eh + (size_t)L.kR[i] * x.rs + L.kC[i]), (LAS unsigned*)(lds + PAR * STG + eh * 16384 + L.ldsw + i * 8192), 16, 0, 0);
    const bf16_t* vp = x.base + 2048 + (size_t)(i0 + 4 * L.v_kg) * x.rs + 8 * L.v_ch;
#pragma unroll
    for (int c = 0; c < 4; ++c) vr[c] = *(const u32x4*)(vp + (size_t)c * x.rs);
}
template <int PAR> __device__ __forceinline__ void store_v(LAS unsigned char* lds, const Lane& L, const u32x4 (&vr)[4]) {
    LAS unsigned char* vdst = lds + PAR * STG + KBYTES + (8 * L.v_ch) * VROW + L.vcol;
#pragma unroll
    for (int wi = 0; wi < 4; ++wi) {
        u32x2 ev, od;
        ev.x = (vr[0][wi] & 0xffffu) | (vr[1][wi] << 16); ev.y = (vr[2][wi] & 0xffffu) | (vr[3][wi] << 16);
        od.x = (vr[0][wi] >> 16) | (vr[1][wi] & 0xffff0000u); od.y = (vr[2][wi] >> 16) | (vr[3][wi] & 0xffff0000u);
        *(LAS u32x2*)(vdst + (2 * wi) * VROW) = ev; *(LAS u32x2*)(vdst + (2 * wi + 1) * VROW) = od; }
}
__device__ __forceinline__ void load_q(const bf16_t* proj, int u, const Lane& L, bf16x8 (&q)[4]) {
    const UDec x = decode(proj, u);
    const bf16_t* qp = x.base + (size_t)(128 * x.qb + L.qi) * x.rs + 8 * L.fq;
#pragma unroll
    for (int ks = 0; ks < 4; ++ks) q[ks] = *(const bf16x8*)(qp + 32 * ks);
}
template <int PAR, int HALF, int QBW> __device__ __forceinline__ void compute(LAS unsigned char* lds, int u, const Lane& L, const bf16x8 (&qf)[4], float& mrun, float& lrun, f32x4 (&o)[8]) {
    const int g = u >> 10, h = (u >> 5) & 7, d = 1 << (2 * g);
    constexpr int KT0 = HALF ? 0 : QBW, KT1 = HALF ? QBW : 7;
    f32x4 s[8];
#pragma unroll
    for (int kt = KT0; kt <= KT1; ++kt) {
        s[kt] = (f32x4){0.f, 0.f, 0.f, 0.f};
#pragma unroll
        for (int ks = 0; ks < 4; ++ks) { const bf16x8 kf = *(const LAS bf16x8*)(lds + PAR * STG + (ks >> 1) * 16384 + L.koff + kt * 2048 + (ks & 1) * 1024);
            s[kt] = __builtin_amdgcn_mfma_f32_16x16x32_bf16(kf, qf[ks], s[kt], 0, 0, 0); }
        if ((kt - KT0) & 1) __builtin_amdgcn_sched_barrier(0);
    }
    const float slope = (g < 2) ? exp2f(-0.25f * (float)(g * 8 + h + 1)) : exp2f(-(4.5f + 0.5f * (float)h));
    const float sld = slope * (float)d * 1.4426950408889634f;
    int bi = 16 * QBW + L.fr + 128 * (1 - HALF) - 4 * L.fq; asm volatile("" : "+v"(bi));
    int dq = 4 * L.fq - L.fr; asm volatile("" : "+v"(dq));
    const float c0 = -sld * (float)bi;
    float mloc = -1e30f;
#pragma unroll
    for (int kt = KT0; kt <= KT1; ++kt) {
#pragma unroll
        for (int j = 0; j < 4; ++j) { float v = s[kt][j] * (0.08838834764831845f * 1.4426950408889634f) + (c0 + sld * (float)(16 * kt + j));
            if (kt == QBW) { const bool valid = HALF ? (dq + j <= 0) : (dq + j >= 0); v = valid ? v : -1e30f; }
            s[kt][j] = v; mloc = fmaxf(mloc, v); }
    }
    mloc = fmaxf(mloc, __shfl_xor(mloc, 16)); mloc = fmaxf(mloc, __shfl_xor(mloc, 32));
    const float mnew = fmaxf(mrun, mloc), alpha = __builtin_amdgcn_exp2f(mrun - mnew);
    float lsum = 0.f;
#pragma unroll
    for (int kt = KT0; kt <= KT1; ++kt)
#pragma unroll
        for (int j = 0; j < 4; ++j) { const float p = __builtin_amdgcn_exp2f(s[kt][j] - mnew); s[kt][j] = p; lsum += p; }
    lrun = lrun * alpha + lsum; mrun = mnew;
#pragma unroll
    for (int et = 0; et < 8; ++et) o[et] = o[et] * alpha;
#pragma unroll
    for (int ss = KT0 / 2; ss <= KT1 / 2; ++ss) {
        const bool l0 = (2 * ss >= KT0) && (2 * ss <= KT1), l1 = (2 * ss + 1 >= KT0) && (2 * ss + 1 <= KT1);
        u32x4 pw;
        pw.x = l0 ? cvt_pk_bf16(s[2 * ss][0], s[2 * ss][1]) : 0u; pw.y = l0 ? cvt_pk_bf16(s[2 * ss][2], s[2 * ss][3]) : 0u;
        pw.z = l1 ? cvt_pk_bf16(s[(2 * ss + 1) & 7][0], s[(2 * ss + 1) & 7][1]) : 0u; pw.w = l1 ? cvt_pk_bf16(s[(2 * ss + 1) & 7][2], s[(2 * ss + 1) & 7][3]) : 0u;
        const bf16x8 pf = __builtin_bit_cast(bf16x8, pw);
#pragma unroll
        for (int et = 0; et < 8; ++et) { const bf16x8 vf = *(const LAS bf16x8*)(lds + PAR * STG + KBYTES + (16 * et + L.fr) * VROW + 64 * ss + 16 * L.fq);
            o[et] = __builtin_amdgcn_mfma_f32_16x16x32_bf16(vf, pf, o[et], 0, 0, 0); }
        __builtin_amdgcn_sched_barrier(0);
    }
}
template <int PAR> __device__ __forceinline__ void compute_sel(LAS unsigned char* lds, int u, int half, const Lane& L, const bf16x8 (&qf)[4], float& mrun, float& lrun, f32x4 (&o)[8]) {
#define ATT_CASE(H, Q) case (H) * 8 + (Q): compute<PAR, H, Q>(lds, u, L, qf, mrun, lrun, o); break;
    switch (half * 8 + L.qbw) {
        ATT_CASE(0, 0) ATT_CASE(0, 1) ATT_CASE(0, 2) ATT_CASE(0, 3) ATT_CASE(0, 4) ATT_CASE(0, 5) ATT_CASE(0, 6) ATT_CASE(0, 7)
        ATT_CASE(1, 0) ATT_CASE(1, 1) ATT_CASE(1, 2) ATT_CASE(1, 3) ATT_CASE(1, 4) ATT_CASE(1, 5) ATT_CASE(1, 6) ATT_CASE(1, 7)
        default: break;
    }
#undef ATT_CASE
}
__device__ __forceinline__ void finalize(const bf16_t* proj, int u, const Lane& L, float mrun, float lrun, const f32x4 (&o)[8], bf16_t* outg, float* lse) {
    const UDec x = decode(proj, u);
    float l = lrun; l += __shfl_xor(l, 16); l += __shfl_xor(l, 32);
    const float inv = 1.0f / l;
    const size_t mrow = (size_t)x.g * M + (size_t)x.b * SEQ + (size_t)(128 * x.qb + L.qi) * x.d + x.r;
    bf16_t* op = outg + mrow * 1024 + x.h * 128 + 4 * L.fq;
#pragma unroll
    for (int et = 0; et < 8; ++et) { u32x2 w; w.x = cvt_pk_bf16(o[et][0] * inv, o[et][1] * inv); w.y = cvt_pk_bf16(o[et][2] * inv, o[et][3] * inv); *(u32x2*)(op + 16 * et) = w; }
    if (L.fq == 0) lse[mrow * 8 + x.h] = (mrun + __builtin_amdgcn_logf(l)) * 0.6931471805599453f;
}
template <int PAR> __device__ __forceinline__ bool step(LAS unsigned char* lds, const bf16_t* proj, bf16_t* outg, float* lse, int G, const Lane& L, int& u, int& half, bf16x8 (&qf)[4], float& mrun, float& lrun, f32x4 (&o)[8]) {
    int nu, nh; if (half == 0) { nu = u; nh = 1; } else { nu = u + G; nh = nu < N_UNITS ? first_half(nu) : 0; }
    const bool has_next = nu < N_UNITS, new_unit = has_next && (nu != u);
    u32x4 vr[4]; bf16x8 qn[4];
    if (has_next) issue<PAR ^ 1>(lds, proj, nu, nh, L, vr);
    if (new_unit) load_q(proj, nu, L, qn);
    __builtin_amdgcn_sched_barrier(0);
    compute_sel<PAR>(lds, u, half, L, qf, mrun, lrun, o);
    if (half == 1) { finalize(proj, u, L, mrun, lrun, o, outg, lse); mrun = -1e30f; lrun = 0.f;
#pragma unroll
        for (int et = 0; et < 8; ++et) o[et] = (f32x4){0.f, 0.f, 0.f, 0.f}; }
    __builtin_amdgcn_sched_barrier(0);
    if (has_next) store_v<PAR ^ 1>(lds, L, vr);
    if (new_unit) {
#pragma unroll
        for (int ks = 0; ks < 4; ++ks) qf[ks] = qn[ks]; }
    __builtin_amdgcn_s_waitcnt(0); asm volatile("" ::: "memory"); __builtin_amdgcn_s_barrier(); asm volatile("" ::: "memory");
    u = nu; half = nh;
    return has_next;
}
__device__ __forceinline__ void attn_phase(LAS unsigned char* lds, const bf16_t* proj, bf16_t* outg, float* lse, int vcu, int G) {
    int tid = threadIdx.x; asm volatile("" : "+v"(tid));
    const int lane = tid & 63, wid = __builtin_amdgcn_readfirstlane(tid >> 6);
    Lane L;
#pragma unroll
    for (int i = 0; i < 2; ++i) pg8::stage_rc(tid * 16 + i * 8192, L.kR[i], L.kC[i]);
    L.fr = lane & 15; L.fq = lane >> 4; L.ldsw = (unsigned)wid * 1024u; L.koff = pg8::lds_byte(L.fr, L.fq * 8);
    L.v_ch = (lane & 3) + 4 * ((lane >> 4) & 3); L.v_kg = ((lane >> 2) & 3) + 4 * wid;
    L.vcol = 64 * (wid >> 1) + 16 * ((lane >> 2) & 3) + 8 * (wid & 1);
    L.qbw = wid < 4 ? wid : 11 - wid; L.qi = 16 * L.qbw + L.fr;
    int u = vcu; if (u >= N_UNITS) return;
    int half = first_half(u);
    bf16x8 qf[4]; f32x4 o[8]; float mrun = -1e30f, lrun = 0.f;
#pragma unroll
    for (int et = 0; et < 8; ++et) o[et] = (f32x4){0.f, 0.f, 0.f, 0.f};
    { u32x4 vr[4]; issue<0>(lds, proj, u, half, L, vr); load_q(proj, u, L, qf); store_v<0>(lds, L, vr); }
    __builtin_amdgcn_s_waitcnt(0); asm volatile("" ::: "memory"); __builtin_amdgcn_s_barrier(); asm volatile("" ::: "memory");
    for (;;) {
        if (!step<0>(lds, proj, outg, lse, G, L, u, half, qf, mrun, lrun, o)) break;
        if (!step<1>(lds, proj, outg, lse, G, L, u, half, qf, mrun, lrun, o)) break;
    }
}
}

constexpr int NPHASE = 13;
__global__ void __launch_bounds__(NTHREADS, 2) mk_fwd(Args a) {
    extern __shared__ __attribute__((aligned(16))) unsigned char lds_raw[];
    LAS unsigned char* lds = (LAS unsigned char*)lds_raw;
    const int tid = threadIdx.x, lane = tid & 63, wave = __builtin_amdgcn_readfirstlane(tid >> 6);
    const int G = gridDim.x, bx = blockIdx.x;
    const int vcu = (G % 8 == 0) ? (bx % 8) * (G / 8) + bx / 8 : bx;
    const int gw = vcu * NWAVES + wave, NGW = G * NWAVES;
    unsigned char* ws = a.ws;
    unsigned* ctl = (unsigned*)(ws + WS_CTL);
    volatile LAS unsigned* MISC = (volatile LAS unsigned*)(lds + MISC_OFF);
    if (tid < 32) MISC[tid] = 0u;
    __syncthreads();
    XcdBarrier bar; bar.bar = ctl + CW_BAR; bar.x = 0; bar.st = nullptr;
    if (MK_ONE_LAUNCH) bar = xcd_barrier_post(ctl + CW_BAR, MISC + 8);
    const int lo = a.ph_lo, hi = a.ph_hi;
#ifdef DBG_ONLY
#define IN(k) ((k) == DBG_ONLY && lo <= (k) && (k) < hi)
#else
#define IN(k) (lo <= (k) && (k) < hi)
#endif
#define SEAM(k) do { if (MK_ONE_LAUNCH && IN(k) && IN((k) + 1)) xcd_barrier(bar); } while (0)

    bf16_t* XN = (bf16_t*)(ws + WS_XN); bf16_t* ACT = (bf16_t*)(ws + WS_ACT); bf16_t* Fb = (bf16_t*)(ws + WS_F); bf16_t* PROJ = (bf16_t*)(ws + WS_PROJ);
    bf16_t* ATT = (bf16_t*)(ws + WS_ATTN); bf16_t* DELTA = (bf16_t*)(ws + WS_DELTA); bf16_t* POOLED = (bf16_t*)(ws + WS_POOLED); bf16_t* MERGED = XN;

    const int xcc = (int)(xb_xcc_id() & 7u);
    unsigned* wq = ctl + CW_CMAX; const float* cmf = (const float*)wq;
    float* RS = (float*)(ws + WS_CTL + 512 * 1024);
    unsigned char* ACT8 = ws + WS_WGU1;
    bf16_t* H1 = (bf16_t*)(ws + WS_WGU1); bf16_t* H2 = (bf16_t*)(ws + WS_WIN);
    float* RSTD = RS + 2 * M;
    unsigned char* AQ = ws + WS_WGU1; float* RS2 = RS + M;
    unsigned char* XQ = ws + WS_T1;
    const bool tail_cvt = (G == 256);
    if (IN(0)) {
        p0_slabs<0>(a, lds, ctl, bx >> 1, G >> 1, bx & 1, tid);
        p0_slabs<1>(a, lds, ctl, bx >> 1, G >> 1, bx & 1, tid, 0, tail_cvt ? W_IN_P0_SLABS : 1 << 30);
        if (I8_D1) wd_pass<0>(KARG(const float*, w1d), nullptr, wq + CM_W1D, gw, NGW, lane);
        if (I8_D2 && !tail_cvt) wd_pass<0>(KARG(const float*, w2d), nullptr, wq + CM_W2D, gw, NGW, lane);
        p0_weights<0>(a, lds, gw, NGW, wave, lane, wq);
        if (!tail_cvt) { p0_weights<1>(a, lds, gw, NGW, wave, lane, wq); if (!I8_D2) p0_weights<2>(a, lds, gw, NGW, wave, lane, wq); }
        p0_norm(KARG(const float*, x), KARG(const float*, n1pre), I8_GU1 ? nullptr : XN, I8_GU1 ? XQ : nullptr, RS, gw, NGW, lane, ctl + CW_DYN); }
    SEAM(0);
    if (IN(1)) {
        if (DYN_GEMM) if (tail_cvt && bx >= 128) { p0_slabs<1>(a, lds, ctl, (bx - 128) >> 1, 64, bx & 1, tid, W_IN_P0_SLABS); if (!(I8_IN && I8_POOL)) p0_weights<1>(a, lds, (bx - 128) * NWAVES + wave, 128 * NWAVES, wave, lane, wq); }
#if I8_GU1
        { pg8::PlainSched S; S.T.init(M, 2 * FF, G, bx, WGM_G); S.A = (const char*)XQ; S.B = (const char*)(ws + WS_WGU1); S.tstep = (size_t)256 * D;
          pg8::EpiSwiGLUI8<0> E{ACT, nullptr, FF, RS, cmf + CM_W1G, cmf + CM_W1U};
          pg8::gemm_phase<pg8::EpiSwiGLUI8<0>, pg8::PlainSched, PG8_ALIGN, PG8_SP2, 2, DYN_GEMM>(lds, D / 2, S, E, ctl + CW_DQ, xcc); }
#else
        { pg8::PlainSched S; S.T.init(M, 2 * FF, G, bx, WGM_G); S.A = (const char*)XN; S.B = (const char*)(ws + WS_WGU1); S.tstep = (size_t)256 * D * 2;
          pg8::EpiSwiGLU E{ACT, FF};
          pg8::gemm_phase<pg8::EpiSwiGLU, pg8::PlainSched, PG8_ALIGN, PG8_SP2>(lds, D, S, E); }
#endif
        if (!DYN_GEMM) if (tail_cvt && bx >= 128) { p0_slabs<1>(a, lds, ctl, (bx - 128) >> 1, 64, bx & 1, tid, W_IN_P0_SLABS); if (!(I8_IN && I8_POOL)) p0_weights<1>(a, lds, (bx - 128) * NWAVES + wave, 128 * NWAVES, wave, lane, wq); }
    }
    SEAM(1);
    if (IN(2)) {
#if I8_D1
        wd_pass<1>(KARG(const float*, w1d), ws + WS_WD1, wq + CM_W1D, gw, NGW, lane);
        actq_phase(ACT, AQ, RS2, gw, NGW, lane, ctl + CW_DYN + 2048);
        xcd_barrier(bar);
        { pg8::PlainSched S; S.T.init(M, D, G, bx, WGM_D); S.A = (const char*)AQ; S.B = (const char*)(ws + WS_WD1); S.tstep = (size_t)256 * FF;
          pg8::EpiBf16SigI8 E{Fb, D, 1 << 20, RS2, cmf + CM_W1D, 1.0f / (8.f * 127.f)};
          pg8::gemm_phase<pg8::EpiBf16SigI8, pg8::PlainSched, PG8_ALIGN, PG8_SP2, 2>(lds, FF / 2, S, E); }
#else
        { pg8::PlainSched S; S.T.init(M, D, G, bx, WGM_D); S.A = (const char*)ACT; S.B = (const char*)(ws + WS_WD1); S.tstep = (size_t)256 * FF * 2;
          pg8::EpiBf16 E{Fb, D, 1.0f};
          pg8::gemm_phase<pg8::EpiBf16, pg8::PlainSched, PG8_ALIGN, PG8_SP2>(lds, FF, S, E); }
#endif
    }
    SEAM(2);
    if (IN(3)) norm_phase<false, true>(lds, Fb, KARG(const float*, x), H1, (I8_IN && (I8_POOL || POOL_FROM_H)) ? nullptr : XN, XQ, I8_IN ? RS : nullptr, KARG(const float*, n1post), KARG(const float*, nmpre), 0.5f, gw, NGW, tid, (I8_IN && POOL_FROM_H) ? RSTD : nullptr, ctl + CW_DYN + 4096);
    SEAM(3);
    if (IN(4)) {
#if I8_IN
        { pg8::PlainSched S; S.T.init(M, I8_POOL ? GA_OFF : POOL_OFF, G, bx, WGM_G); S.A = (const char*)XQ; S.B = (const char*)(ws + WS_WIN); S.tstep = (size_t)256 * D;
          pg8::EpiBf16SigI8 E{PROJ, NIN, 1 << 20, RS, cmf + CM_WIN, 1.0f / 127.f};
          pg8::gemm_phase<pg8::EpiBf16SigI8, pg8::PlainSched, PG8_ALIGN, PG8_SP2, 2, DYN_GEMM>(lds, D / 2, S, E, ctl + CW_DQ + 256, xcc); }
        if (!I8_POOL && POOL_FROM_H) { pg8::PlainSched S; S.T.init(M, GA_OFF - POOL_OFF, G, bx, WGM_G); S.A = (const char*)H1; S.B = (const char*)(ws + WS_WIN) + (size_t)POOL_OFF * D * 2; S.tstep = (size_t)256 * D * 2;
          pg8::EpiBf16Row E{PROJ + POOL_OFF, NIN, RSTD};
          pg8::gemm_phase<pg8::EpiBf16Row, pg8::PlainSched, PG8_ALIGN, PG8_SP2>(lds, D, S, E); }
        if (!I8_POOL && !POOL_FROM_H) { pg8::PlainSched S; S.T.init(M, GA_OFF - POOL_OFF, G, bx, WGM_G); S.A = (const char*)XN; S.B = (const char*)(ws + WS_WIN) + (size_t)POOL_OFF * D * 2; S.tstep = (size_t)256 * D * 2;
          pg8::EpiBf16Sig E{PROJ + POOL_OFF, NIN, 1 << 20, 1.0f};
          pg8::gemm_phase<pg8::EpiBf16Sig, pg8::PlainSched, PG8_ALIGN, PG8_SP2>(lds, D, S, E); }
        { pg8::PlainSched S; S.T.init(M, 2 * D, G, bx, WGM_G); S.A = (const char*)XQ; S.B = (const char*)(ws + WS_WIN8); S.tstep = (size_t)256 * D;
          pg8::EpiBf16SigI8 E{PROJ + GA_OFF, NIN, 0, RS, cmf + CM_WIN + GA_OFF, 1.0f / 127.f};
          pg8::gemm_phase<pg8::EpiBf16SigI8, pg8::PlainSched, PG8_ALIGN, PG8_SP2, 2, DYN_GEMM>(lds, D / 2, S, E, ctl + CW_DQ + 512, xcc); }
#else
        { pg8::PlainSched S; S.T.init(M, GA_OFF, G, bx, WGM_G); S.A = (const char*)XN; S.B = (const char*)(ws + WS_WIN); S.tstep = (size_t)256 * D * 2;
          pg8::EpiBf16Sig E{PROJ, NIN, 1 << 20, 1.0f};
          pg8::gemm_phase<pg8::EpiBf16Sig, pg8::PlainSched, PG8_ALIGN, PG8_SP2>(lds, D, S, E); }
        { pg8::PlainSched S; S.T.init(M, D, G, bx, WGM_G); S.A = (const char*)XN; S.B = (const char*)(ws + WS_WIN) + (size_t)GP_OFF * D * 2; S.tstep = (size_t)256 * D * 2;
          pg8::EpiBf16Sig E{PROJ + GP_OFF, NIN, 0, 1.0f};
          pg8::gemm_phase<pg8::EpiBf16Sig, pg8::PlainSched, PG8_ALIGN, PG8_SP2>(lds, D, S, E); }
        { pg8::PlainSched S; S.T.init(M, D, G, bx, WGM_G); S.A = (const char*)XQ; S.B = (const char*)(ws + WS_WIN8); S.tstep = (size_t)256 * D;
          pg8::EpiBf16Sig E{PROJ + GA_OFF, NIN, 0, 1.0f / 64.f};
          pg8::gemm_phase<pg8::EpiBf16Sig, pg8::PlainSched, PG8_ALIGN, PG8_SP2, 1>(lds, D / 2, S, E); }
#endif
    }
    SEAM(4);
    if (IN(5)) { att2::attn_phase(lds, PROJ, (bf16_t*)(ws + WS_OUTG), (float*)(ws + WS_LSE), vcu, G); pool_delta(PROJ, DELTA, gw, NGW, lane); }
    SEAM(5);
    if (IN(6)) { att::attn_merge((const bf16_t*)(ws + WS_OUTG), (const float*)(ws + WS_LSE), ATT, vcu * NTHREADS + tid, G * NTHREADS);
        pg8::PoolSched S; S.T.init(M, 1024, G, bx); S.A = (const char*)DELTA; S.B = (const char*)(ws + WS_WPL); S.tstep = (size_t)256 * 256 * 2; S.gstride = (size_t)M * 256 * 2;
        pg8::EpiPool E{POOLED, 1024, KARG(const float*, poolscale)};
        pg8::gemm_phase<pg8::EpiPool, pg8::PoolSched, PG8_ALIGN, PG8_SP2>(lds, 256, S, E); }
    SEAM(6);
    if (IN(7)) { pg8::BranchSched S; S.T.init(M, D, G, bx); S.A0 = (const char*)ATT; S.B0 = (const char*)(ws + WS_WBA); S.A1 = (const char*)POOLED; S.B1 = (const char*)(ws + WS_WBP); S.tstep = (size_t)256 * 1024 * 2;
        pg8::EpiBranch E{MERGED, D, PROJ};
        pg8::gemm_phase<pg8::EpiBranch, pg8::BranchSched, PG8_ALIGN, PG8_SP2>(lds, 1024, S, E); }
    SEAM(7);
    if (IN(8)) { pg8::PlainSched S; S.T.init(M, D, G, bx); S.A = (const char*)MERGED; S.B = (const char*)(ws + WS_WOUT); S.tstep = (size_t)256 * D * 2;
        pg8::EpiBf16 E{Fb, D, 1.0f};
        pg8::gemm_phase<pg8::EpiBf16, pg8::PlainSched, PG8_ALIGN, PG8_SP2, 0, DYN_GEMM>(lds, D, S, E, ctl + CW_DQ + 1024, xcc); }
    SEAM(8);
    if (IN(9)) norm_phase<true, true>(lds, Fb, H1, H2, I8_GU2 ? nullptr : XN, I8_GU2 ? XQ : nullptr, RS, KARG(const float*, nmpost), KARG(const float*, n2pre), 1.0f, gw, NGW, tid, nullptr, ctl + CW_DYN + 6144);
    SEAM(9);
    if (IN(10)) {
        if (DYN_GEMM) if (tail_cvt && bx >= 128) { if (I8_D2) wd_pass<0>(KARG(const float*, w2d), nullptr, wq + CM_W2D, (bx - 128) * NWAVES + wave, 128 * NWAVES, lane); else p0_weights<2>(a, lds, (bx - 128) * NWAVES + wave, 128 * NWAVES, wave, lane, wq); }
#if I8_GU2
        { pg8::PlainSched S; S.T.init(M, 2 * FF, G, bx, WGM_G); S.A = (const char*)XQ; S.B = (const char*)(ws + WS_WGU2); S.tstep = (size_t)256 * D;
          constexpr int OUT = F8_D2N == 0 ? 0 : (F8_D2N == 16 ? 1 : 2);
          pg8::EpiSwiGLUI8<OUT> E{ACT, F8_D2N == 16 ? (unsigned char*)ACT : ACT8, FF, RS, cmf + CM_W2G, cmf + CM_W2U};
          pg8::gemm_phase<pg8::EpiSwiGLUI8<OUT>, pg8::PlainSched, PG8_ALIGN, PG8_SP2, 2, DYN_GEMM>(lds, D / 2, S, E, ctl + CW_DQ + 768, xcc); }
#elif F8_D2
        { pg8::PlainSched S; S.T.init(M, 2 * FF, G, bx, WGM_G); S.A = (const char*)XN; S.B = (const char*)(ws + WS_WGU2); S.tstep = (size_t)256 * D * 2;
          pg8::EpiSwiGLU8 E{(unsigned char*)ACT, FF};
          pg8::gemm_phase<pg8::EpiSwiGLU8, pg8::PlainSched, PG8_ALIGN, PG8_SP2>(lds, D, S, E); }
#else
        { pg8::PlainSched S; S.T.init(M, 2 * FF, G, bx, WGM_G); S.A = (const char*)XN; S.B = (const char*)(ws + WS_WGU2); S.tstep = (size_t)256 * D * 2;
          pg8::EpiSwiGLU E{ACT, FF};
          pg8::gemm_phase<pg8::EpiSwiGLU, pg8::PlainSched, PG8_ALIGN, PG8_SP2>(lds, D, S, E); }
#endif
        if (!DYN_GEMM) if (tail_cvt && bx >= 128) { if (I8_D2) wd_pass<0>(KARG(const float*, w2d), nullptr, wq + CM_W2D, (bx - 128) * NWAVES + wave, 128 * NWAVES, lane); else p0_weights<2>(a, lds, (bx - 128) * NWAVES + wave, 128 * NWAVES, wave, lane, wq); }
    }
    SEAM(10);
    if (IN(11)) {
#if I8_D2
        static_assert(F8_D2N == 0, "int8 FFN2 down excludes the fp8 split");
        wd_pass<1>(KARG(const float*, w2d), ws + WS_WD2, wq + CM_W2D, gw, NGW, lane);
        actq_phase(ACT, AQ, RS2, gw, NGW, lane, ctl + CW_DYN + 8192);
        xcd_barrier(bar);
        { pg8::PlainSched S; S.T.init(M, D, G, bx, WGM_D); S.A = (const char*)AQ; S.B = (const char*)(ws + WS_WD2); S.tstep = (size_t)256 * FF;
          pg8::EpiBf16SigI8 E{Fb, D, 1 << 20, RS2, cmf + CM_W2D, 1.0f / (8.f * 127.f)};
          pg8::gemm_phase<pg8::EpiBf16SigI8, pg8::PlainSched, PG8_ALIGN, PG8_SP2, 2>(lds, FF / 2, S, E); }
#else
        if (F8_D2N > 0) { pg8::PlainSched S; S.T.init(M, 256 * F8_D2N, G, bx, WGM_D); S.A = (const char*)(F8_D2N == 16 ? (unsigned char*)ACT : ACT8); S.B = (const char*)(ws + WS_WD2); S.tstep = (size_t)256 * FF;
            pg8::EpiBf16 E{Fb, D, 1.0f / 64.f};
            pg8::gemm_phase<pg8::EpiBf16, pg8::PlainSched, PG8_ALIGN, PG8_SP2, 1>(lds, FF / 2, S, E); }
        if (F8_D2N < 16) { pg8::PlainSched S; S.T.init(M, D - 256 * F8_D2N, G, bx, WGM_D); S.A = (const char*)ACT; S.B = (const char*)(ws + WS_WD2) + (size_t)256 * F8_D2N * FF * 2; S.tstep = (size_t)256 * FF * 2;
            pg8::EpiBf16 E{Fb + 256 * F8_D2N, D, 1.0f};
            pg8::gemm_phase<pg8::EpiBf16, pg8::PlainSched, PG8_ALIGN, PG8_SP2>(lds, FF, S, E); }
#endif
    }
    SEAM(11);
    if (IN(12)) norm_phase<true, false>(lds, Fb, H2, KARG(float*, out), nullptr, nullptr, nullptr, KARG(const float*, n2post), nullptr, 0.5f, gw, NGW, tid, nullptr, ctl + CW_DYN + 10240);
#undef IN
#undef SEAM
}

extern "C" void kernel_launch(void* const* d_in, const int* in_sizes, int n_in, void* d_out, int out_size, void* d_ws, size_t ws_size, hipStream_t stream) {
    static int grid = 0;
    if (grid == 0) {
        if (n_in != 19 || in_sizes[0] != M * D || out_size != M * D || ws_size < WS_END) { fprintf(stderr, "kernel_launch: unexpected shapes (n_in %d, in0 %d, out %d, ws %zu < %zu)\n", n_in, n_in > 0 ? in_sizes[0] : -1, out_size, ws_size, (size_t)WS_END); grid = -1; return; }
        int dev = 0, cus = 0, per_cu = 0;
        if (hipGetDevice(&dev) != hipSuccess || hipDeviceGetAttribute(&cus, hipDeviceAttributeMultiprocessorCount, dev) != hipSuccess) { grid = -1; return; }
        if (hipFuncSetAttribute((const void*)mk_fwd, hipFuncAttributeMaxDynamicSharedMemorySize, LDS_BYTES) != hipSuccess) { fprintf(stderr, "kernel_launch: hipFuncSetAttribute failed\n"); grid = -1; return; }
        if (hipOccupancyMaxActiveBlocksPerMultiprocessor(&per_cu, (const void*)mk_fwd, NTHREADS, LDS_BYTES) != hipSuccess || per_cu < 1) { fprintf(stderr, "kernel_launch: occupancy query says %d\n", per_cu); }
        (void)hipGetLastError();
        grid = cus;
    }
    if (grid < 0) return;
    (void)hipMemsetAsync((char*)d_ws + WS_CTL, 0, CTL_ZERO_BYTES, stream);
    Args a{};
    a.x = (const float*)d_in[0]; a.n1pre = (const float*)d_in[1]; a.n1post = (const float*)d_in[2]; a.w1g = (const float*)d_in[3]; a.w1u = (const float*)d_in[4]; a.w1d = (const float*)d_in[5];
    a.nmpre = (const float*)d_in[6]; a.nmpost = (const float*)d_in[7]; a.win = (const float*)d_in[8]; a.poolw = (const float*)d_in[9]; a.poolscale = (const float*)d_in[10];
    a.wab = (const float*)d_in[11]; a.wpb = (const float*)d_in[12]; a.wout = (const float*)d_in[13];
    a.n2pre = (const float*)d_in[14]; a.n2post = (const float*)d_in[15]; a.w2g = (const float*)d_in[16]; a.w2u = (const float*)d_in[17]; a.w2d = (const float*)d_in[18];
    a.out = (float*)d_out; a.ws = (unsigned char*)d_ws;
#if MK_ONE_LAUNCH
    a.ph_lo = 0; a.ph_hi = NPHASE;
    hipLaunchKernelGGL(mk_fwd, dim3(grid), dim3(NTHREADS), LDS_BYTES, stream, a);
#else
    for (int p = 0; p < NPHASE; ++p) { a.ph_lo = p; a.ph_hi = p + 1; hipLaunchKernelGGL(mk_fwd, dim3(grid), dim3(NTHREADS), LDS_BYTES, stream, a); }
#endif
}
```

```cpp
#include <hip/hip_runtime.h>
#include <cstdio>
#include <cstdint>

#ifndef MK_ONE_LAUNCH
#define MK_ONE_LAUNCH 1
#endif

#define LAS __attribute__((address_space(3)))
#define GAS __attribute__((address_space(1)))
typedef unsigned short bf16_t;
typedef short bf16x8 __attribute__((ext_vector_type(8)));
typedef float f32x4 __attribute__((ext_vector_type(4)));
typedef float f32x2 __attribute__((ext_vector_type(2)));
typedef unsigned u32x4 __attribute__((ext_vector_type(4)));
typedef unsigned u32x2 __attribute__((ext_vector_type(2)));
typedef int i32x8 __attribute__((ext_vector_type(8)));
typedef int i32x4 __attribute__((ext_vector_type(4)));
typedef i32x8 i32x8a __attribute__((aligned(16)));

constexpr int BATCH = 4, SEQ = 4096, M = BATCH * SEQ, D = 4096, FF = 11008, NIN = 18432;
constexpr int POOL_OFF = 9216, GA_OFF = 10240, GP_OFF = 14336;
constexpr float RMS_EPS = 1e-6f;
constexpr int NWAVES = 8, NTHREADS = 512;

constexpr size_t MiB = (size_t)1 << 20;
constexpr size_t WS_CTL = 0, CTL_ZERO_BYTES = 1 * MiB;
constexpr size_t WS_WGU1 = 1 * MiB;
constexpr size_t WS_WD1 = 173 * MiB;
constexpr size_t WS_WIN = 259 * MiB;
constexpr size_t WS_WIN8 = WS_WIN + 80 * MiB;
constexpr size_t WS_WOUT = 403 * MiB;
constexpr size_t WS_WBA = 435 * MiB;
constexpr size_t WS_WBP = 443 * MiB;
constexpr size_t WS_WPL = 451 * MiB;
constexpr size_t WS_WGU2 = 452 * MiB;
constexpr size_t WS_WD2 = 624 * MiB;
constexpr size_t WS_XN = 710 * MiB;
constexpr size_t WS_ACT = 838 * MiB;
constexpr size_t WS_F = 1182 * MiB;
constexpr size_t WS_PROJ = 838 * MiB;
constexpr size_t WS_ATTN = 1438 * MiB;
constexpr size_t WS_DELTA = 1470 * MiB;
constexpr size_t WS_POOLED = 1502 * MiB;
constexpr size_t WS_T1 = 1534 * MiB;
constexpr size_t WS_OUTG = WS_XN;
constexpr size_t WS_LSE = WS_XN + 96 * MiB;
constexpr size_t WS_END = 1598 * MiB;
static_assert(WS_PROJ + (size_t)M * NIN * 2 <= WS_ATTN, "proj overlay");
constexpr int CW_BAR = 4096;
constexpr int CW_DYN = 180224;
constexpr int CW_SLAB = 12288;
constexpr int CW_CMAX = 16384;
constexpr int CM_W1G = 0, CM_W1U = FF, CM_W2G = 2 * FF, CM_W2U = 3 * FF, CM_WIN = 4 * FF, CM_W1D = 4 * FF + NIN, CM_W2D = CM_W1D + D;
static_assert((CW_CMAX + 4 * FF + NIN + 2 * D) * 4 <= 512 * 1024, "column maxima below the row-scale arrays");

__device__ __forceinline__ unsigned cvt_pk_bf16(float lo, float hi) { unsigned r; asm volatile("v_cvt_pk_bf16_f32 %0, %1, %2" : "=v"(r) : "v"(lo), "v"(hi)); return r; }
__device__ __forceinline__ float bf_lo(unsigned w) { return __uint_as_float(w << 16); }
__device__ __forceinline__ float bf_hi(unsigned w) { return __uint_as_float(w & 0xffff0000u); }
__device__ __forceinline__ float wave_sum(float v) {
#pragma unroll
    for (int o = 1; o < 64; o <<= 1) v += __shfl_xor(v, o);
    return v;
}
__device__ __forceinline__ unsigned cvt4_fp8(float a, float b, float c, float d) { int w = __builtin_amdgcn_cvt_pk_fp8_f32(a, b, 0, false); w = __builtin_amdgcn_cvt_pk_fp8_f32(c, d, w, true); return (unsigned)w; }
__device__ __forceinline__ unsigned pack4_i8(float a, float b, float c, float d) {
    const float MG = 12582912.0f;
    return __builtin_amdgcn_perm(__float_as_uint(b + MG), __float_as_uint(a + MG), 0x0c0c0400u) | __builtin_amdgcn_perm(__float_as_uint(d + MG), __float_as_uint(c + MG), 0x04000c0cu);
}
__device__ __forceinline__ float lane_xor1(float v) { return __int_as_float(__builtin_amdgcn_update_dpp(0, __float_as_int(v), 0xB1, 0xF, 0xF, true)); }
__device__ __forceinline__ float lane_xor2(float v) { return __int_as_float(__builtin_amdgcn_update_dpp(0, __float_as_int(v), 0x4E, 0xF, 0xF, true)); }
__device__ __forceinline__ float lane_xor4(float v) { return __int_as_float(__builtin_amdgcn_ds_swizzle(__float_as_int(v), 0x101F)); }
__device__ __forceinline__ float wave_max(float v) {
#pragma unroll
    for (int o = 1; o < 64; o <<= 1) v = fmaxf(v, __shfl_xor(v, o));
    return v;
}
__device__ __forceinline__ float fast_sigmoid(float x) { return __builtin_amdgcn_rcpf(1.0f + __builtin_amdgcn_exp2f(-1.4426950408889634f * x)); }

#define XB_TMO      128
#define XB_XCNT(j)  (256  + 64 * (j))
#define XB_XSUB(j)  (1280 + 64 * (j))
#define XB_XGEN(j)  (2304 + 64 * (j))
#define XB_TOP      3328
#define XB_TOPGEN   3392
#define XCD_BAR_WORDS 3456
#define XB_SPIN_CAP (1u << 18)

__device__ __forceinline__ unsigned xb_ld(unsigned* p)              { return __hip_atomic_load(p, __ATOMIC_RELAXED, __HIP_MEMORY_SCOPE_AGENT); }
__device__ __forceinline__ unsigned xb_add(unsigned* p, unsigned v) { return __hip_atomic_fetch_add(p, v, __ATOMIC_RELAXED, __HIP_MEMORY_SCOPE_AGENT); }
__device__ __forceinline__ unsigned xb_xcc_id() { return (unsigned)__builtin_amdgcn_s_getreg((3 << 11) | 20) & 0xFu; }
#define XB_SPIN(cond, bar) do { unsigned _sp = 0; while (cond) { __builtin_amdgcn_s_sleep(1); \
    if ((++_sp & 255u) == 0u) { if (xb_ld(&(bar)[XB_TMO])) break; if (_sp > XB_SPIN_CAP) { atomicAdd(&(bar)[XB_TMO], 1u); break; } } } } while (0)

struct XcdBarrier { unsigned* bar; unsigned x; volatile LAS unsigned* st; };

__device__ __forceinline__ XcdBarrier xcd_barrier_post(unsigned* bar, volatile LAS unsigned* st) {
    XcdBarrier b; b.bar = bar; b.x = xb_xcc_id(); b.st = st;
    if (threadIdx.x == 0) (void)xb_add(&bar[XB_XCNT(b.x)], 1u);
    return b;
}
__device__ __forceinline__ void xcd_barrier_complete(unsigned* bar, unsigned x, unsigned& nloc, unsigned& nx) {
    const unsigned G = gridDim.x * gridDim.y * gridDim.z;
    unsigned sum, cnt, mine, sp = 0u;
    for (;;) {
        sum = 0u; cnt = 0u; mine = 0u;
#pragma unroll
        for (unsigned j = 0; j < 16; ++j) { const unsigned c = xb_ld(&bar[XB_XCNT(j)]); sum += c; cnt += (c > 0u) ? 1u : 0u; mine = (j == x) ? c : mine; }
        if (sum == G) break;
        __builtin_amdgcn_s_sleep(1);
        if ((++sp & 255u) == 0u) { if (xb_ld(&bar[XB_TMO])) break; if (sp > XB_SPIN_CAP) { atomicAdd(&bar[XB_TMO], 1u); break; } }
    }
    nloc = mine > 0u ? mine : 1u; nx = cnt > 0u ? cnt : 1u;
}
__device__ __forceinline__ void xcd_barrier(const XcdBarrier& b) {
    asm volatile("s_waitcnt vmcnt(0)" ::: "memory");
    __syncthreads();
    if (threadIdx.x == 0) {
        unsigned* bar = b.bar;
        __builtin_amdgcn_s_waitcnt(0);
        unsigned nloc = b.st[0], nx = b.st[1];
        if (nloc == 0u) { xcd_barrier_complete(bar, b.x, nloc, nx); b.st[0] = nloc; b.st[1] = nx; }
        const unsigned old = xb_add(&bar[XB_XSUB(b.x)], 1u);
        const unsigned gen = old / nloc;
        if (old + 1u == (gen + 1u) * nloc) {
            __builtin_amdgcn_fence(__ATOMIC_RELEASE, "agent");
            asm volatile("s_waitcnt vmcnt(0)" ::: "memory");
            const unsigned og = xb_add(&bar[XB_TOP], 1u);
            const unsigned tg = og / nx;
            if (og + 1u == (tg + 1u) * nx) xb_add(&bar[XB_TOPGEN], 1u);
            else XB_SPIN(xb_ld(&bar[XB_TOPGEN]) == tg, bar);
            __builtin_amdgcn_fence(__ATOMIC_ACQUIRE, "agent");
            xb_add(&bar[XB_XGEN(b.x)], 1u);
            asm volatile("s_waitcnt vmcnt(0)" ::: "memory");
        } else {
            XB_SPIN(xb_ld(&bar[XB_XGEN(b.x)]) == gen, bar);
            __builtin_amdgcn_fence(__ATOMIC_ACQUIRE, "agent");
            asm volatile("s_waitcnt vmcnt(0)" ::: "memory");
        }
    }
    __syncthreads();
}

namespace pg8 {
constexpr int BM = 256, BK = 64, HALF = 128, HTB = HALF * BK * 2, STAGE_BYTES = 8 * HTB, NXCD = 8, WGM = 8;
__host__ __device__ __forceinline__ int lds_byte(int r, int c) { const int st = (r >> 4) * 2 + (c >> 5), rr = r & 15, cc = c & 31, ob = rr * 64 + cc * 2; return st * 1024 + (ob ^ (((ob >> 9) & 1) << 5)); }
__host__ __device__ __forceinline__ void stage_rc(int b, int& R, int& C) { const int st = b / 1024, sb = b % 1024, swz = sb ^ (((sb >> 9) & 1) << 5); R = (st >> 1) * 16 + swz / 64; C = (st & 1) * 32 + (swz % 64) / 2; }
__host__ __device__ __forceinline__ int perm32(int rho) { const int n = rho >> 4, i = rho & 15; return 8 * (i >> 2) + 4 * n + (i & 3); }

struct Unit { int pm, pn, sub; };
struct TileOrder {
    int nM, nN, nwg, G, c, wgm;
    __device__ __forceinline__ void init(int Mr, int Nc, int G_, int c_, int wgm_ = WGM) { nM = Mr / BM; nN = Nc / BM; nwg = nM * nN; G = G_; c = c_; wgm = wgm_; }
    __device__ __forceinline__ bool at(long L, int& pm, int& pn) const {
        if (L >= nwg) return false;
        int wgid = (int)L; { const int q = nwg / NXCD, r = nwg % NXCD, xcd = wgid % NXCD, off = wgid / NXCD; wgid = (xcd < r ? xcd * (q + 1) : r * (q + 1) + (xcd - r) * q) + off; }
        const int nig = wgm * nN, gid = wgid / nig, fm = gid * wgm, gsz = (nM - fm) < wgm ? (nM - fm) : wgm;
        pm = fm + ((wgid % nig) % gsz); pn = (wgid % nig) / gsz; return true;
    }
};
struct PlainSched {
    TileOrder T; const char* A; const char* B; size_t tstep;
    __device__ __forceinline__ bool next(int i, Unit& u) const { u.sub = 0; return T.at((long)i * T.G + T.c, u.pm, u.pn); }
    __device__ __forceinline__ const char* aptr(const Unit& u) const { return A + (size_t)u.pm * tstep; }
    __device__ __forceinline__ const char* bptr(const Unit& u) const { return B + (size_t)u.pn * tstep; }
};
struct BranchSched {
    TileOrder T; const char* A0; const char* B0; const char* A1; const char* B1; size_t tstep;
    __device__ __forceinline__ bool next(int i, Unit& u) const { u.sub = i & 1; return T.at((long)(i >> 1) * T.G + T.c, u.pm, u.pn); }
    __device__ __forceinline__ const char* aptr(const Unit& u) const { return (u.sub ? A1 : A0) + (size_t)u.pm * tstep; }
    __device__ __forceinline__ const char* bptr(const Unit& u) const { return (u.sub ? B1 : B0) + (size_t)u.pn * tstep; }
};
struct PoolSched {
    TileOrder T; const char* A; const char* B; size_t tstep, gstride;
    __device__ __forceinline__ bool next(int i, Unit& u) const { u.sub = 0; return T.at((long)i * T.G + T.c, u.pm, u.pn); }
    __device__ __forceinline__ const char* aptr(const Unit& u) const { return A + (size_t)u.pn * gstride + (size_t)u.pm * tstep; }
    __device__ __forceinline__ const char* bptr(const Unit& u) const { return B + (size_t)u.pn * tstep; }
};

struct EpiSwiGLU {
    static constexpr bool PERM = true, KEEP_SUB0 = false;
    bf16_t* O; int ldc;
    __device__ __forceinline__ void operator()(const f32x4 (&acc)[2][2][4][2], const Unit& u, int wr, int wc, int fr, int fq) const {
        const int row0 = u.pm * BM + wr * 64 + fr, col0 = u.pn * HALF + wc * 32 + 8 * fq;
#pragma unroll
        for (int ai = 0; ai < 2; ++ai)
#pragma unroll
            for (int m = 0; m < 4; ++m) { bf16_t* rowp = O + (size_t)(row0 + ai * HALF + m * 16) * ldc + col0;
                float o[8];
#pragma unroll
                for (int n = 0; n < 2; ++n)
#pragma unroll
                    for (int j = 0; j < 4; ++j) { const float g = acc[ai][0][m][n][j], uu = acc[ai][1][m][n][j]; o[n * 4 + j] = g * fast_sigmoid(g) * uu; }
                u32x4 w; w.x = cvt_pk_bf16(o[0], o[1]); w.y = cvt_pk_bf16(o[2], o[3]); w.z = cvt_pk_bf16(o[4], o[5]); w.w = cvt_pk_bf16(o[6], o[7]);
                *(u32x4*)rowp = w; }
    }
};
struct EpiBf16 {
    static constexpr bool PERM = true, KEEP_SUB0 = false;
    bf16_t* O; int ldc; float osc;
    __device__ __forceinline__ void operator()(const f32x4 (&acc)[2][2][4][2], const Unit& u, int wr, int wc, int fr, int fq) const {
        const int row0 = u.pm * BM + wr * 64 + fr, col0 = u.pn * BM + wc * 32 + 8 * fq;
#pragma unroll
        for (int ai = 0; ai < 2; ++ai)
#pragma unroll
            for (int m = 0; m < 4; ++m) { bf16_t* rowp = O + (size_t)(row0 + ai * HALF + m * 16) * ldc + col0;
#pragma unroll
                for (int bj = 0; bj < 2; ++bj) { const f32x4 v0 = acc[ai][bj][m][0] * osc, v1 = acc[ai][bj][m][1] * osc;
                    u32x4 w; w.x = cvt_pk_bf16(v0[0], v0[1]); w.y = cvt_pk_bf16(v0[2], v0[3]); w.z = cvt_pk_bf16(v1[0], v1[1]); w.w = cvt_pk_bf16(v1[2], v1[3]);
                    *(u32x4*)(rowp + bj * HALF) = w; } }
    }
};
struct EpiSwiGLU8 {
    static constexpr bool PERM = true, KEEP_SUB0 = false;
    unsigned char* O; int ldc;
    __device__ __forceinline__ void operator()(const f32x4 (&acc)[2][2][4][2], const Unit& u, int wr, int wc, int fr, int fq) const {
        const int row0 = u.pm * BM + wr * 64 + fr, col0 = u.pn * HALF + wc * 32 + 8 * fq;
#pragma unroll
        for (int ai = 0; ai < 2; ++ai)
#pragma unroll
            for (int m = 0; m < 4; ++m) { unsigned char* rowp = O + (size_t)(row0 + ai * HALF + m * 16) * ldc + col0;
                float o[8];
#pragma unroll
                for (int n = 0; n < 2; ++n)
#pragma unroll
                    for (int j = 0; j < 4; ++j) { const float g = acc[ai][0][m][n][j], uu = acc[ai][1][m][n][j]; o[n * 4 + j] = g * fast_sigmoid(g) * uu; }
                u32x2 w; w.x = cvt4_fp8(o[0], o[1], o[2], o[3]); w.y = cvt4_fp8(o[4], o[5], o[6], o[7]);
                *(u32x2*)rowp = w; }
    }
};
template <int OUT> struct EpiSwiGLUI8 {
    static constexpr bool PERM = true, KEEP_SUB0 = false;
    bf16_t* O16; unsigned char* O8; int ldc; const float* rs; const float* cg; const float* cu;
    __device__ __forceinline__ void operator()(const f32x4 (&acc)[2][2][4][2], const Unit& u, int wr, int wc, int fr, int fq) const {
        const int row0 = u.pm * BM + wr * 64 + fr, col0 = u.pn * HALF + wc * 32 + 8 * fq;
        f32x4 sg[2], su[2];
#pragma unroll
        for (int n = 0; n < 2; ++n) { sg[n] = *(const f32x4*)(cg + col0 + 4 * n) * (1.0f / 127.f); su[n] = *(const f32x4*)(cu + col0 + 4 * n) * (1.0f / 127.f); }
#pragma unroll
        for (int ai = 0; ai < 2; ++ai)
#pragma unroll
            for (int m = 0; m < 4; ++m) { const int row = row0 + ai * HALF + m * 16; const float r = rs[row];
                float o[8];
#pragma unroll
                for (int n = 0; n < 2; ++n)
#pragma unroll
                    for (int j = 0; j < 4; ++j) { const float g = (float)__float_as_int(acc[ai][0][m][n][j]) * (r * sg[n][j]), uu = (float)__float_as_int(acc[ai][1][m][n][j]) * (r * su[n][j]); o[n * 4 + j] = g * fast_sigmoid(g) * uu; }
                if constexpr (OUT != 0) { u32x2 w; w.x = cvt4_fp8(o[0], o[1], o[2], o[3]); w.y = cvt4_fp8(o[4], o[5], o[6], o[7]); *(u32x2*)(O8 + (size_t)row * ldc + col0) = w; }
                if constexpr (OUT != 1) { u32x4 w; w.x = cvt_pk_bf16(o[0], o[1]); w.y = cvt_pk_bf16(o[2], o[3]); w.z = cvt_pk_bf16(o[4], o[5]); w.w = cvt_pk_bf16(o[6], o[7]); *(u32x4*)(O16 + (size_t)row * ldc + col0) = w; } }
    }
};
struct EpiBf16SigI8 {
    static constexpr bool PERM = true, KEEP_SUB0 = false;
    bf16_t* O; int ldc; int sig_from; const float* rs; const float* cm; float cs;
    __device__ __forceinline__ void operator()(const f32x4 (&acc)[2][2][4][2], const Unit& u, int wr, int wc, int fr, int fq) const {
        const int row0 = u.pm * BM + wr * 64 + fr, col0 = u.pn * BM + wc * 32 + 8 * fq; const bool sg = u.pn >= sig_from;
#pragma unroll
        for (int bj = 0; bj < 2; ++bj) { f32x4 sw[2];
#pragma unroll
            for (int n = 0; n < 2; ++n) sw[n] = *(const f32x4*)(cm + col0 + bj * HALF + 4 * n) * cs;
#pragma unroll
            for (int ai = 0; ai < 2; ++ai)
#pragma unroll
                for (int m = 0; m < 4; ++m) { const int row = row0 + ai * HALF + m * 16; const float r = rs[row]; bf16_t* rowp = O + (size_t)row * ldc + col0; float v[8];
#pragma unroll
                    for (int n = 0; n < 2; ++n)
#pragma unroll
                        for (int j = 0; j < 4; ++j) { float x = (float)__float_as_int(acc[ai][bj][m][n][j]) * (r * sw[n][j]); v[n * 4 + j] = sg ? fast_sigmoid(x) : x; }
                    u32x4 w; w.x = cvt_pk_bf16(v[0], v[1]); w.y = cvt_pk_bf16(v[2], v[3]); w.z = cvt_pk_bf16(v[4], v[5]); w.w = cvt_pk_bf16(v[6], v[7]);
                    *(u32x4*)(rowp + bj * HALF) = w; } }
    }
};
struct EpiBf16Sig {
    static constexpr bool PERM = true, KEEP_SUB0 = false;
    bf16_t* O; int ldc; int sig_from; float osc;
    __device__ __forceinline__ void operator()(const f32x4 (&acc)[2][2][4][2], const Unit& u, int wr, int wc, int fr, int fq) const {
        const int row0 = u.pm * BM + wr * 64 + fr, col0 = u.pn * BM + wc * 32 + 8 * fq; const bool sg = u.pn >= sig_from;
#pragma unroll
        for (int ai = 0; ai < 2; ++ai)
#pragma unroll
            for (int m = 0; m < 4; ++m) { bf16_t* rowp = O + (size_t)(row0 + ai * HALF + m * 16) * ldc + col0;
#pragma unroll
                for (int bj = 0; bj < 2; ++bj) { f32x4 v0 = acc[ai][bj][m][0] * osc, v1 = acc[ai][bj][m][1] * osc;
                    if (sg) {
#pragma unroll
                        for (int j = 0; j < 4; ++j) { v0[j] = fast_sigmoid(v0[j]); v1[j] = fast_sigmoid(v1[j]); } }
                    u32x4 w; w.x = cvt_pk_bf16(v0[0], v0[1]); w.y = cvt_pk_bf16(v0[2], v0[3]); w.z = cvt_pk_bf16(v1[0], v1[1]); w.w = cvt_pk_bf16(v1[2], v1[3]);
                    *(u32x4*)(rowp + bj * HALF) = w; } }
    }
};
struct EpiBf16Row {
    static constexpr bool PERM = true, KEEP_SUB0 = false;
    bf16_t* O; int ldc; const float* rowscale;
    __device__ __forceinline__ void operator()(const f32x4 (&acc)[2][2][4][2], const Unit& u, int wr, int wc, int fr, int fq) const {
        const int row0 = u.pm * BM + wr * 64 + fr, col0 = u.pn * BM + wc * 32 + 8 * fq;
#pragma unroll
        for (int ai = 0; ai < 2; ++ai)
#pragma unroll
            for (int m = 0; m < 4; ++m) { const int row = row0 + ai * HALF + m * 16; const float r = rowscale[row]; bf16_t* rowp = O + (size_t)row * ldc + col0;
#pragma unroll
                for (int bj = 0; bj < 2; ++bj) { const f32x4 v0 = acc[ai][bj][m][0] * r, v1 = acc[ai][bj][m][1] * r;
                    u32x4 w; w.x = cvt_pk_bf16(v0[0], v0[1]); w.y = cvt_pk_bf16(v0[2], v0[3]); w.z = cvt_pk_bf16(v1[0], v1[1]); w.w = cvt_pk_bf16(v1[2], v1[3]);
                    *(u32x4*)(rowp + bj * HALF) = w; } }
    }
};
struct EpiPool {
    static constexpr bool PERM = true, KEEP_SUB0 = false;
    bf16_t* O; int ldc; const float* scale;
    __device__ __forceinline__ void operator()(const f32x4 (&acc)[2][2][4][2], const Unit& u, int, int, int, int) const {
        int tz = threadIdx.x; asm volatile("" : "+v"(tz));
        const int wid = tz >> 6, lane = tz & 63, wr = wid >> 2, wc = wid & 3, fr = lane & 15, fq = lane >> 4;
        const int row0 = u.pm * BM + wr * 64 + fr, col0 = u.pn * BM + wc * 32 + 8 * fq;
#pragma unroll
        for (int bj = 0; bj < 2; ++bj) { const f32x4 sv0 = *(const f32x4*)(scale + col0 + bj * HALF), sv1 = *(const f32x4*)(scale + col0 + bj * HALF + 4);
#pragma unroll
            for (int ai = 0; ai < 2; ++ai)
#pragma unroll
                for (int m = 0; m < 4; ++m) { bf16_t* rowp = O + (size_t)(row0 + ai * HALF + m * 16) * ldc + col0;
                    const f32x4 v0 = acc[ai][bj][m][0] * sv0, v1 = acc[ai][bj][m][1] * sv1;
                    u32x4 w; w.x = cvt_pk_bf16(v0[0], v0[1]); w.y = cvt_pk_bf16(v0[2], v0[3]); w.z = cvt_pk_bf16(v1[0], v1[1]); w.w = cvt_pk_bf16(v1[2], v1[3]);
                    *(u32x4*)(rowp + bj * HALF) = w; } }
    }
};
struct EpiBranch {
    static constexpr bool PERM = true, KEEP_SUB0 = true;
    bf16_t* O; int ldc; const bf16_t* proj;
    __device__ __forceinline__ void operator()(f32x4 (&acc)[2][2][4][2], const Unit& u, int, int, int, int) const {
        int tz = threadIdx.x; asm volatile("" : "+v"(tz));
        const int wid = tz >> 6, lane = tz & 63, wr = wid >> 2, wc = wid & 3, fr = lane & 15, fq = lane >> 4;
        const int row0 = u.pm * BM + wr * 64 + fr, col0 = u.pn * BM + wc * 32 + 8 * fq;
        if (u.sub == 0) {
#pragma unroll
            for (int ai = 0; ai < 2; ++ai)
#pragma unroll
                for (int mh = 0; mh < 2; ++mh) {
                    u32x4 ga[2][2], gp[2][2];
#pragma unroll
                    for (int mm = 0; mm < 2; ++mm)
#pragma unroll
                        for (int bj = 0; bj < 2; ++bj) { const bf16_t* gpt = proj + (size_t)(row0 + ai * HALF + (2 * mh + mm) * 16) * NIN + col0 + bj * HALF;
                            ga[mm][bj] = *(const u32x4*)(gpt + GA_OFF); gp[mm][bj] = *(const u32x4*)(gpt + GP_OFF); }
#pragma unroll
                    for (int mm = 0; mm < 2; ++mm)
#pragma unroll
                        for (int bj = 0; bj < 2; ++bj) { const int m = 2 * mh + mm;
#pragma unroll
                            for (int k = 0; k < 4; ++k) { const unsigned aw = ga[mm][bj][k], pw = gp[mm][bj][k];
                                const float r0 = bf_lo(aw) * __builtin_amdgcn_rcpf(fmaxf(bf_lo(pw), 1e-6f)), r1 = bf_hi(aw) * __builtin_amdgcn_rcpf(fmaxf(bf_hi(pw), 1e-6f));
                                acc[ai][bj][m][k >> 1][2 * (k & 1)] *= r0; acc[ai][bj][m][k >> 1][2 * (k & 1) + 1] *= r1; } }
                    asm volatile("" ::: "memory"); }
        } else {
#pragma unroll
            for (int ai = 0; ai < 2; ++ai) {
                u32x4 gp[4][2];
#pragma unroll
                for (int m = 0; m < 4; ++m)
#pragma unroll
                    for (int bj = 0; bj < 2; ++bj) gp[m][bj] = *(const u32x4*)(proj + (size_t)(row0 + ai * HALF + m * 16) * NIN + GP_OFF + col0 + bj * HALF);
#pragma unroll
                for (int m = 0; m < 4; ++m)
#pragma unroll
                    for (int bj = 0; bj < 2; ++bj) { u32x4 w;
#pragma unroll
                        for (int k = 0; k < 4; ++k) { const unsigned pw = gp[m][bj][k];
                            w[k] = cvt_pk_bf16(acc[ai][bj][m][k >> 1][2 * (k & 1)] * fmaxf(bf_lo(pw), 1e-6f), acc[ai][bj][m][k >> 1][2 * (k & 1) + 1] * fmaxf(bf_hi(pw), 1e-6f)); }
                        *(u32x4*)(O + (size_t)(row0 + ai * HALF + m * 16) * ldc + col0 + bj * HALF) = w; }
                asm volatile("" ::: "memory"); }
        }
    }
};

template <class Epi, class Sched, bool ALIGN_EPI, bool SP2, int PREC = 0>
__device__ __forceinline__ void gemm_phase(LAS unsigned char* lds, const int K, const Sched& S, const Epi& E) {
    constexpr bool FP8 = (PREC == 1), INT8 = (PREC == 2);
    int tid = threadIdx.x; asm volatile("" : "+v"(tid));
    const int wid = __builtin_amdgcn_readfirstlane(tid >> 6), lane = tid & 63, wr = wid >> 2, wc = wid & 3, fr = lane & 15, fq = lane >> 4;
    const int nt = K / BK;
    unsigned voffA[2], voffB[2];
#pragma unroll
    for (int i = 0; i < 2; ++i) { int R, C; stage_rc(tid * 16 + i * 8192, R, C);
        voffA[i] = (unsigned)(R * K + C) * 2u; voffB[i] = (unsigned)(tid * 16 + i * 8192); }
    const size_t kstep = (size_t)(BK * 2), kstepB = (size_t)HTB;
    const size_t hstep = (size_t)HALF * K * 2;
    const unsigned ldsw = (unsigned)wid * 1024u;
    const int aoff = FP8 ? lds_byte(wr * 64 + fr, fq * 16) : lds_byte(wr * 64 + fr, fq * 8), boff = FP8 ? lds_byte(wc * 32 + fr, fq * 16) : lds_byte(wc * 32 + fr, fq * 8);
    constexpr int KOFF = FP8 ? 16 : 1024;
#define PG8_SA(b, h) (((b) * 2 + (h)) * HTB)
#define PG8_SB(b, h) ((4 + (b) * 2 + (h)) * HTB)
#define PG8_STAGE(bufoff, gbase, voff) do { _Pragma("unroll") for (int _i = 0; _i < 2; ++_i) \
        __builtin_amdgcn_global_load_lds((const unsigned*)((const char*)(gbase) + (voff)[_i]), (LAS unsigned*)(lds + (bufoff) + ldsw + _i * 8192), 16, 0, 0); } while (0)
#define PG8_LD32(p) __builtin_shufflevector(*(const LAS i32x4*)(p), *(const LAS i32x4*)((p) + 16), 0, 1, 2, 3, 4, 5, 6, 7)
#define PG8_LDA(dst, b, h) do { if constexpr (FP8) { _Pragma("unroll") for (int m = 0; m < 4; ++m) dst##8[m] = PG8_LD32(lds + PG8_SA(b, h) + aoff + m * 2048); } \
        else { _Pragma("unroll") for (int m = 0; m < 4; ++m) _Pragma("unroll") for (int k = 0; k < 2; ++k) dst[m][k] = *(const LAS bf16x8*)(lds + PG8_SA(b, h) + aoff + m * 2048 + k * KOFF); } } while (0)
#define PG8_LDB(dst, b, h) do { if constexpr (FP8) { _Pragma("unroll") for (int n = 0; n < 2; ++n) dst##8[n] = PG8_LD32(lds + PG8_SB(b, h) + boff + n * 2048); } \
        else { _Pragma("unroll") for (int n = 0; n < 2; ++n) _Pragma("unroll") for (int k = 0; k < 2; ++k) dst[n][k] = *(const LAS bf16x8*)(lds + PG8_SB(b, h) + boff + n * 2048 + k * KOFF); } } while (0)
#define PG8_MMA(ai, bj, At, Bt) do { __builtin_amdgcn_s_setprio(1); _Pragma("unroll") for (int m = 0; m < 4; ++m) _Pragma("unroll") for (int n = 0; n < 2; ++n) { \
        if constexpr (FP8) asm volatile("v_mfma_scale_f32_16x16x128_f8f6f4 %0, %1, %2, %0, %3, %3 op_sel_hi:[0,0,0]" : "+v"(acc[ai][bj][m][n]) : "v"(Bt##8[n]), "v"(At##8[m]), "v"(one8));   \
        else if constexpr (INT8) { _Pragma("unroll") for (int k = 0; k < 2; ++k) acc[ai][bj][m][n] = __builtin_bit_cast(f32x4, __builtin_amdgcn_mfma_i32_16x16x64_i8(__builtin_bit_cast(i32x4, Bt[n][k]), __builtin_bit_cast(i32x4, At[m][k]), __builtin_bit_cast(i32x4, acc[ai][bj][m][n]), 0, 0, 0)); } \
        else { _Pragma("unroll") for (int k = 0; k < 2; ++k) acc[ai][bj][m][n] = __builtin_amdgcn_mfma_f32_16x16x32_bf16(Bt[n][k], At[m][k], acc[ai][bj][m][n], 0, 0, 0); } } \
        __builtin_amdgcn_s_setprio(0); } while (0)
#define PG8_WAIT_V(n) asm volatile("s_waitcnt vmcnt(" #n ")" ::: "memory")
#define PG8_WAIT_L(n) asm volatile("s_waitcnt lgkmcnt(" #n ")" ::: "memory")
#define PG8_BAR __builtin_amdgcn_s_barrier()
#define PG8_SCHED __builtin_amdgcn_sched_barrier(0)
    Unit cur, nxt; int ui = 0;
    if (!S.next(0, cur)) return;
    f32x4 acc[2][2][4][2];
#pragma unroll
    for (int a = 0; a < 2; ++a)
#pragma unroll
        for (int b = 0; b < 2; ++b)
#pragma unroll
            for (int m = 0; m < 4; ++m)
#pragma unroll
                for (int n = 0; n < 2; ++n) acc[a][b][m][n] = (f32x4){0.f, 0.f, 0.f, 0.f};
    const int one8 = 0x7F7F7F7F;
    bf16x8 At[4][2], B0[2][2], B1[2][2];
    i32x8 At8[4], B08[2], B18[2];
    const char* cA = S.aptr(cur); const char* cB = S.bptr(cur);
    if constexpr (SP2) {
        PG8_STAGE(PG8_SB(0, 0), cB, voffB); PG8_STAGE(PG8_SB(0, 1), cB + hstep, voffB); PG8_STAGE(PG8_SA(0, 0), cA, voffA); PG8_STAGE(PG8_SA(0, 1), cA + hstep, voffA);
        if (wr == 1) PG8_BAR;
        PG8_WAIT_V(2); PG8_BAR;
        PG8_STAGE(PG8_SB(1, 0), cB + kstepB, voffB); PG8_STAGE(PG8_SA(1, 0), cA + kstep, voffA); PG8_STAGE(PG8_SB(1, 1), cB + hstep + kstepB, voffB);
        PG8_WAIT_V(6); PG8_BAR;
    } else {
        PG8_STAGE(PG8_SB(0, 0), cB, voffB); PG8_STAGE(PG8_SA(0, 0), cA, voffA); PG8_STAGE(PG8_SB(0, 1), cB + hstep, voffB); PG8_STAGE(PG8_SA(0, 1), cA + hstep, voffA);
        if (wr == 1) PG8_BAR;
        PG8_WAIT_V(4); PG8_BAR;
        PG8_STAGE(PG8_SB(1, 0), cB + kstepB, voffB); PG8_STAGE(PG8_SA(1, 0), cA + kstep, voffA); PG8_STAGE(PG8_SB(1, 1), cB + hstep + kstepB, voffB);
        PG8_WAIT_V(6); PG8_BAR;
    }
    for (;;) {
        const bool has_next = S.next(ui + 1, nxt);
        const char* nA = has_next ? S.aptr(nxt) : cA; const char* nB = has_next ? S.bptr(nxt) : cB;
#pragma unroll 1
        for (int t = 0; t < nt; t += 2) {
            const bool last = (t == nt - 2);
            const char* a1 = cA + (size_t)(t + 1) * kstep;
            const char* a2 = last ? nA : cA + (size_t)(t + 2) * kstep; const char* b2 = last ? nB : cB + (size_t)(t + 2) * kstepB;
            const char* a3 = a2 + kstep; const char* b3 = b2 + kstepB;
            if constexpr (SP2) {
            PG8_LDB(B0, 0, 0); PG8_LDB(B1, 0, 1); PG8_SCHED; PG8_LDA(At, 0, 0); PG8_STAGE(PG8_SA(1, 1), a1 + hstep, voffA);
            PG8_WAIT_V(8); PG8_WAIT_L(0); PG8_BAR; PG8_MMA(0, 0, At, B0); PG8_MMA(0, 1, At, B1); PG8_BAR; PG8_SCHED;
            PG8_LDA(At, 0, 1); PG8_STAGE(PG8_SB(0, 0), b2, voffB); PG8_STAGE(PG8_SB(0, 1), b2 + hstep, voffB); PG8_STAGE(PG8_SA(0, 0), a2, voffA);
            PG8_WAIT_V(8); PG8_WAIT_L(0); PG8_BAR; PG8_MMA(1, 0, At, B0); PG8_MMA(1, 1, At, B1); PG8_BAR; PG8_SCHED;
            PG8_LDB(B0, 1, 0); PG8_LDB(B1, 1, 1); PG8_SCHED; PG8_LDA(At, 1, 0); PG8_STAGE(PG8_SA(0, 1), a2 + hstep, voffA);
            PG8_WAIT_V(8); PG8_WAIT_L(0); PG8_BAR; PG8_MMA(0, 0, At, B0); PG8_MMA(0, 1, At, B1); PG8_BAR; PG8_SCHED;
            PG8_LDA(At, 1, 1); PG8_STAGE(PG8_SB(1, 0), b3, voffB); PG8_STAGE(PG8_SB(1, 1), b3 + hstep, voffB); PG8_STAGE(PG8_SA(1, 0), a3, voffA);
            PG8_WAIT_V(8); PG8_WAIT_L(0); PG8_BAR; PG8_MMA(1, 0, At, B0); PG8_MMA(1, 1, At, B1); PG8_BAR; PG8_SCHED;
            } else {
            PG8_LDB(B0, 0, 0); PG8_SCHED; PG8_LDA(At, 0, 0); PG8_STAGE(PG8_SA(1, 1), a1 + hstep, voffA);
            PG8_WAIT_L(8); PG8_BAR; PG8_WAIT_L(0); PG8_MMA(0, 0, At, B0); PG8_BAR; PG8_SCHED;
            PG8_LDB(B1, 0, 1); PG8_STAGE(PG8_SB(0, 0), b2, voffB);
            PG8_BAR; PG8_WAIT_L(0); PG8_MMA(0, 1, At, B1); PG8_BAR;
            PG8_LDA(At, 0, 1); PG8_STAGE(PG8_SA(0, 0), a2, voffA);
            PG8_BAR; PG8_WAIT_L(0); PG8_MMA(1, 0, At, B0); PG8_BAR; PG8_SCHED;
            PG8_STAGE(PG8_SB(0, 1), b2 + hstep, voffB);
            PG8_WAIT_V(6); PG8_BAR; PG8_MMA(1, 1, At, B1); PG8_BAR;
            PG8_LDB(B0, 1, 0); PG8_SCHED; PG8_LDA(At, 1, 0); PG8_STAGE(PG8_SA(0, 1), a2 + hstep, voffA);
            PG8_WAIT_L(8); PG8_BAR; PG8_WAIT_L(0); PG8_MMA(0, 0, At, B0); PG8_BAR; PG8_SCHED;
            PG8_LDB(B1, 1, 1); PG8_STAGE(PG8_SB(1, 0), b3, voffB);
            PG8_BAR; PG8_WAIT_L(0); PG8_MMA(0, 1, At, B1); PG8_BAR;
            PG8_LDA(At, 1, 1); PG8_STAGE(PG8_SA(1, 0), a3, voffA);
            PG8_BAR; PG8_WAIT_L(0); PG8_MMA(1, 0, At, B0); PG8_BAR; PG8_SCHED;
            PG8_STAGE(PG8_SB(1, 1), b3 + hstep, voffB);
            PG8_WAIT_V(6); PG8_BAR; PG8_MMA(1, 1, At, B1); PG8_BAR;
            }
        }
        if constexpr (ALIGN_EPI) { if (wr == 0) PG8_BAR; }
        if constexpr (FP8) asm volatile("s_nop 15\n\ts_nop 15" ::: "memory");
        E(acc, cur, wr, wc, fr, fq);
        if (!has_next) break;
        if (!(Epi::KEEP_SUB0 && cur.sub == 0)) {
#pragma unroll
        for (int a = 0; a < 2; ++a)
#pragma unroll
            for (int b = 0; b < 2; ++b)
#pragma unroll
                for (int m = 0; m < 4; ++m)
#pragma unroll
                    for (int n = 0; n < 2; ++n) acc[a][b][m][n] = (f32x4){0.f, 0.f, 0.f, 0.f}; }
        cur = nxt; cA = nA; cB = nB; ++ui;
        if constexpr (ALIGN_EPI) { if (wr == 1) PG8_BAR; }
    }
    PG8_WAIT_V(0);
    if constexpr (!ALIGN_EPI) { if (wr == 0) PG8_BAR; }
    PG8_BAR;
#undef PG8_SA
#undef PG8_SB
#undef PG8_STAGE
#undef PG8_LDA
#undef PG8_LD32
#undef PG8_LDB
#undef PG8_MMA
#undef PG8_WAIT_V
#undef PG8_WAIT_L
#undef PG8_BAR
#undef PG8_SCHED
}
}

#ifndef I8_GU1
#define I8_GU1 1
#endif
#ifndef I8_GU2
#define I8_GU2 1
#endif
#ifndef I8_IN
#define I8_IN 1
#endif
#ifndef I8_D1
#define I8_D1 1
#endif
#ifndef I8_D2
#define I8_D2 1
#endif
#ifndef F8_D2N
#define F8_D2N (I8_D2 ? 0 : 8)
#endif
#define F8_D2 (F8_D2N == 16)
#ifndef POOL_FROM_H
#define POOL_FROM_H 1
#endif
#ifndef I8_POOL
#define I8_POOL 0
#endif
#ifndef W_IN_P0_SLABS
#define W_IN_P0_SLABS ((I8_POOL ? GA_OFF : POOL_OFF) / 32)
#endif
#ifndef WGM_G
#define WGM_G 8
#endif
#ifndef WGM_D
#define WGM_D 4
#endif
#ifndef PG8_SP2
#define PG8_SP2 true
#endif
#ifndef PG8_ALIGN
#define PG8_ALIGN true
#endif

constexpr int RING_BYTES = 131072;
constexpr int LDS_BYTES = 147456;
constexpr int MISC_OFF = LDS_BYTES - 256;

struct Args {
    const float* x; const float* n1pre; const float* n1post; const float* w1g; const float* w1u; const float* w1d;
    const float* nmpre; const float* nmpost; const float* win; const float* poolw; const float* poolscale; const float* wab; const float* wpb; const float* wout;
    const float* n2pre; const float* n2post; const float* w2g; const float* w2u; const float* w2d;
    float* out; unsigned char* ws; int ph_lo, ph_hi;
};


#define KARG(T, member) (karg_load<T>(__builtin_offsetof(Args, member)))
template <class T> __device__ __forceinline__ T karg_load(unsigned off) {
    const char __attribute__((address_space(4)))* kp = (const char __attribute__((address_space(4)))*)__builtin_amdgcn_kernarg_segment_ptr(); asm volatile("" : "+s"(kp));
    return *(const T __attribute__((address_space(4)))*)(kp + off);
}
__device__ __forceinline__ void transpose_item(const float* W, int K, int N, bf16_t* WT, int mode, LAS float* scr, int item, int lane, const float* kgain = nullptr) {
    const int nblk = N / 32, kb = item / nblk, nb = item % nblk, k0 = 64 * kb, n0 = 32 * nb;
    int drow = n0;
    if (mode == 1) drow = (n0 >> 7) * 256 + (n0 & 127);
    else if (mode == 2) drow = (n0 >> 7) * 256 + 128 + (n0 & 127);
#pragma unroll 8
    for (int i = 0; i < 32; ++i) { const int kk = 2 * i + (lane >> 5); scr[kk * 33 + (lane & 31)] = W[(size_t)(k0 + kk) * N + n0 + (lane & 31)] * (kgain ? kgain[k0 + kk] : 1.0f); }
    asm volatile("s_waitcnt lgkmcnt(0)" ::: "memory");
    const int c = lane & 7;
    unsigned char* blk = (unsigned char*)WT + ((size_t)(drow >> 7) * (K / 64) + kb) * 16384;
#pragma unroll
    for (int j = 0; j < 4; ++j) { const int n = (lane >> 3) + 8 * j; const LAS float* s = scr + (8 * c) * 33 + n;
        u32x4 o; o.x = cvt_pk_bf16(s[0 * 33], s[1 * 33]); o.y = cvt_pk_bf16(s[2 * 33], s[3 * 33]); o.z = cvt_pk_bf16(s[4 * 33], s[5 * 33]); o.w = cvt_pk_bf16(s[6 * 33], s[7 * 33]);
        const int slot = 16 * ((n >> 2) & 1) + 4 * (n >> 3) + (n & 3);
        *(u32x4*)(blk + pg8::lds_byte((drow & 127) + slot, 8 * c)) = o; }
    asm volatile("s_waitcnt lgkmcnt(0)" ::: "memory");
}

template <bool INT8> __device__ __forceinline__ void transpose_item8(const float* W, int K, int N, unsigned char* WT, LAS float* scr, int kb, int nb, int d0, float scale, const unsigned* cmax, int lane) {
    const int k0 = 64 * kb, n0 = 32 * nb;
#pragma unroll 8
    for (int i = 0; i < 32; ++i) { const int kk = 2 * i + (lane >> 5); scr[kk * 33 + (lane & 31)] = W[(size_t)(k0 + kk) * N + n0 + (lane & 31)]; }
    asm volatile("s_waitcnt lgkmcnt(0)" ::: "memory");
    const int c = lane & 3;
    unsigned char* blk = WT + ((size_t)(d0 >> 7) * (K / 128) + (k0 >> 7)) * 16384;
#pragma unroll
    for (int j = 0; j < 2; ++j) { const int n = (lane >> 2) + 16 * j; const LAS float* sp = scr + (16 * c) * 33 + n;
        if (INT8) scale = 127.0f / fmaxf(__uint_as_float(cmax[n0 + n]), 1e-30f);
        u32x4 o;
#pragma unroll
        for (int q = 0; q < 4; ++q) { const float e0 = sp[(4 * q) * 33] * scale, e1 = sp[(4 * q + 1) * 33] * scale, e2 = sp[(4 * q + 2) * 33] * scale, e3 = sp[(4 * q + 3) * 33] * scale;
            o[q] = INT8 ? pack4_i8(e0, e1, e2, e3) : cvt4_fp8(e0, e1, e2, e3); }
        const int slot = 16 * ((n >> 2) & 1) + 4 * (n >> 3) + (n & 3);
        *(u32x4*)(blk + pg8::lds_byte((d0 & 127) + slot, ((k0 & 127) + 16 * c) >> 1)) = o; }
    asm volatile("s_waitcnt lgkmcnt(0)" ::: "memory");
}
__device__ __forceinline__ void slab_convert_i8(const float* W, int N, unsigned char* WT, int n0, int d0, unsigned* cmax, unsigned* arrive, int khalf, LAS float* red, int tid) {
    const int lane = tid & 63, w = __builtin_amdgcn_readfirstlane(tid >> 6), c = lane & 31, h = lane >> 5, kb0 = khalf * (D / 2) + w * 256 + h * 128;
    const float* rowbase = W + (size_t)(khalf * (D / 2) + w * 256) * N + n0; const unsigned loff = (unsigned)(h * 128 * N + c);
    float v[128];
#pragma unroll
    for (int i = 0; i < 128; ++i) v[i] = (rowbase + (size_t)i * N)[loff];
    __builtin_amdgcn_sched_barrier(0);
    float m = 0.f;
#pragma unroll
    for (int i = 0; i < 128; ++i) m = fmaxf(m, fabsf(v[i]));
    m = fmaxf(m, __shfl_xor(m, 32));
    if (h == 0) red[w * 32 + c] = m;
    __syncthreads();
    if (tid < 32) { float mm = red[tid];
#pragma unroll
        for (int j = 1; j < 8; ++j) mm = fmaxf(mm, red[j * 32 + tid]);
        const unsigned old = atomicMax(cmax + n0 + tid, __float_as_uint(mm)); asm volatile("" :: "v"(old)); }
    __syncthreads();
    if (tid == 0) { xb_add(arrive, 1u); unsigned sp = 0; while (xb_ld(arrive) < 2u && ++sp < (1u << 22)) __builtin_amdgcn_s_sleep(1); }
    __syncthreads();
    const float scale = 127.0f / fmaxf(__uint_as_float(xb_ld(cmax + n0 + c)), 1e-30f);
    const int slot = 16 * ((c >> 2) & 1) + 4 * (c >> 3) + (c & 3);
    unsigned char* blk = WT + ((size_t)(d0 >> 7) * (D / 128) + (kb0 >> 7)) * 16384;
#pragma unroll
    for (int j = 0; j < 8; ++j) { u32x4 o;
#pragma unroll
        for (int q = 0; q < 4; ++q) o[q] = pack4_i8(v[16 * j + 4 * q] * scale, v[16 * j + 4 * q + 1] * scale, v[16 * j + 4 * q + 2] * scale, v[16 * j + 4 * q + 3] * scale);
        *(u32x4*)(blk + pg8::lds_byte((d0 & 127) + slot, 8 * j)) = o; }
}
template <int LIST> __device__ __forceinline__ void p0_slabs(const Args& a, LAS unsigned char* lds, unsigned* ctl, int pair, int npairs, int khalf, int tid, int s_lo = 0, int s_hi = 1 << 30) {
    asm volatile("" : "+v"(tid));
    unsigned char* ws = a.ws; unsigned* cm = ctl + CW_CMAX; LAS float* red = (LAS float*)lds;
    constexpr int SPT = FF / 32, NS0 = ((I8_GU1 ? 2 : 0) + (I8_GU2 ? 2 : 0)) * SPT, NQ = (I8_POOL ? GA_OFF : POOL_OFF) / 32, NS1 = I8_IN ? NQ + (NIN - GA_OFF) / 32 : 0;
    for (int sl = (LIST == 0 ? 0 : s_lo) + pair; sl < (LIST == 0 ? NS0 : (s_hi < NS1 ? s_hi : NS1)); sl += npairs) {
        if (LIST == 0) { int t = sl / SPT; const int n0 = 32 * (sl - t * SPT); if (!I8_GU1) t += 2;
            const float* W = t == 0 ? KARG(const float*, w1g) : t == 1 ? KARG(const float*, w1u) : t == 2 ? KARG(const float*, w2g) : KARG(const float*, w2u);
            slab_convert_i8(W, FF, ws + (t < 2 ? WS_WGU1 : WS_WGU2), n0, (n0 >> 7) * 256 + (t & 1) * 128 + (n0 & 127), cm + t * FF, ctl + CW_SLAB + sl, khalf, red, tid); }
        else { const bool qkv = sl < NQ; const int n0 = qkv ? 32 * sl : GA_OFF + 32 * (sl - NQ);
            slab_convert_i8(KARG(const float*, win), NIN, ws + (qkv ? WS_WIN : WS_WIN8), n0, qkv ? n0 : n0 - GA_OFF, cm + CM_WIN, ctl + CW_SLAB + 4 * SPT + sl, khalf, red, tid); }
        __syncthreads(); }
}
#define DYN_ROWS_BEGIN(ctr) { const int ks_ = ((M / NGW) * 5) / 8; const bool dyn_ = (ctr) != nullptr && ks_ >= 1; int k_ = 0; unsigned ndv_ = 0; unsigned* dc_ = (ctr) + (gw & 7) * 32; \
    for (int m = gw; m < M; ) { const bool nd_ = dyn_ && (k_ + 1 >= ks_); if (nd_) { ndv_ = 0; if (lane == 0) ndv_ = atomicAdd(dc_, 1u); }
#define DYN_ROWS_END() ++k_; m = !dyn_ ? m + NGW : (nd_ ? ks_ * NGW + (gw & 7) + 8 * (int)__builtin_amdgcn_readfirstlane(ndv_) : gw + k_ * NGW); } }
template <int N> __device__ __forceinline__ void fwht_regs(float (&v)[N]) {
#pragma unroll
    for (int h = 1; h < N; h <<= 1)
#pragma unroll
        for (int i = 0; i < N; i += 2 * h)
#pragma unroll
            for (int j = i; j < i + h; ++j) { const float a = v[j], b = v[j + h]; v[j] = a + b; v[j + h] = a - b; }
}
__device__ __forceinline__ void actq_phase(const bf16_t* act, unsigned char* aq, float* rs2, int gw, int NGW, int lane, unsigned* dctr = nullptr) {
    asm volatile("" : "+v"(lane));
    static_assert(FF == 21 * 512 + 256, "row = 21 full chunks of 512 + one of 256");
    DYN_ROWS_BEGIN(dctr)
        const u32x4* src = (const u32x4*)(act + (size_t)m * FF) + lane;
        u32x4 w[22];
#pragma unroll
        for (int i = 0; i < 21; ++i) w[i] = src[64 * i];
        w[21] = lane < 32 ? src[64 * 21] : (u32x4){0u, 0u, 0u, 0u};
        float amax = 0.f; const float sg1 = (lane & 1) ? -1.f : 1.f, sg2 = (lane & 2) ? -1.f : 1.f, sg4 = (lane & 4) ? -1.f : 1.f;
#pragma unroll
        for (int i = 0; i < 22; ++i) { float v[8] = {bf_lo(w[i].x), bf_hi(w[i].x), bf_lo(w[i].y), bf_hi(w[i].y), bf_lo(w[i].z), bf_hi(w[i].z), bf_lo(w[i].w), bf_hi(w[i].w)};
            fwht_regs<8>(v);
#pragma unroll
            for (int r = 0; r < 8; ++r) v[r] = fmaf(v[r], sg1, lane_xor1(v[r]));
#pragma unroll
            for (int r = 0; r < 8; ++r) v[r] = fmaf(v[r], sg2, lane_xor2(v[r]));
#pragma unroll
            for (int r = 0; r < 8; ++r) v[r] = fmaf(v[r], sg4, lane_xor4(v[r]));
            u32x4 o; o.x = cvt_pk_bf16(v[0], v[1]); o.y = cvt_pk_bf16(v[2], v[3]); o.z = cvt_pk_bf16(v[4], v[5]); o.w = cvt_pk_bf16(v[6], v[7]); w[i] = o;
            amax = fmaxf(fmaxf(fmaxf(amax, fmaxf(fabsf(v[0]), fabsf(v[1]))), fmaxf(fabsf(v[2]), fabsf(v[3]))), fmaxf(fmaxf(fabsf(v[4]), fabsf(v[5])), fmaxf(fabsf(v[6]), fabsf(v[7]))));
            if ((i & 3) == 3) __builtin_amdgcn_sched_barrier(0); }
        amax = fmaxf(wave_max(amax), 1e-30f); const float qs = 127.0f / amax; if (lane == 0) rs2[m] = amax * (1.0f / (8.f * 127.f));
        u32x2* dst = (u32x2*)(aq + (size_t)m * FF) + lane;
#pragma unroll
        for (int i = 0; i < 22; ++i) { u32x2 o; o.x = pack4_i8(bf_lo(w[i].x) * qs, bf_hi(w[i].x) * qs, bf_lo(w[i].y) * qs, bf_hi(w[i].y) * qs); o.y = pack4_i8(bf_lo(w[i].z) * qs, bf_hi(w[i].z) * qs, bf_lo(w[i].w) * qs, bf_hi(w[i].w) * qs);
            if (i < 21 || lane < 32) dst[64 * i] = o; }
    DYN_ROWS_END()
}
template <int PASS> __device__ __forceinline__ void wd_pass(const float* W, unsigned char* WT, unsigned* cmax, int gw, int NGW, int lane) {
    asm volatile("" : "+v"(lane));
    const int n = lane & 31, hh = lane >> 5; const float sgh = hh ? -1.f : 1.f;
    constexpr int NB = D / 32, ITEMS = (FF / 64) * NB;
    for (int it = gw; it < ITEMS; it += NGW) { const int kb = it / NB, nb = it - kb * NB, k0 = 64 * kb, n0 = 32 * nb;
        const float* src = W + (size_t)(k0 + 32 * hh) * D + n0 + n;
        float v[32];
#pragma unroll
        for (int i = 0; i < 32; ++i) v[i] = src[(size_t)i * D];
        fwht_regs<32>(v);
#pragma unroll
        for (int i = 0; i < 32; ++i) v[i] = fmaf(v[i], sgh, __shfl_xor(v[i], 32));
        if (PASS == 0) { float mx = 0.f;
#pragma unroll
            for (int i = 0; i < 32; ++i) mx = fmaxf(mx, fabsf(v[i]));
            mx = fmaxf(mx, __shfl_xor(mx, 32));
            if (hh == 0) atomicMax(cmax + n0 + n, __float_as_uint(mx)); }
        else { const float scale = 127.0f / fmaxf(__uint_as_float(cmax[n0 + n]), 1e-30f);
            const int slot = 16 * ((n >> 2) & 1) + 4 * (n >> 3) + (n & 3);
            unsigned char* blk = WT + ((size_t)(n0 >> 7) * (FF / 128) + (k0 >> 7)) * 16384;
#pragma unroll
            for (int cc = 0; cc < 2; ++cc) { u32x4 o;
#pragma unroll
                for (int q = 0; q < 4; ++q) o[q] = pack4_i8(v[16 * cc + 4 * q] * scale, v[16 * cc + 4 * q + 1] * scale, v[16 * cc + 4 * q + 2] * scale, v[16 * cc + 4 * q + 3] * scale);
                *(u32x4*)(blk + pg8::lds_byte((n0 & 127) + slot, ((k0 & 127) + 32 * hh + 16 * cc) >> 1)) = o; } }
    }
}
template <int SET> __device__ __forceinline__ void p0_weights(const Args& a, LAS unsigned char* lds, int gw, int NGW, int wave, int lane, const unsigned* wq) {
    asm volatile("" : "+v"(lane));
    LAS float* scr = (LAS float*)(lds + wave * 16384);
    unsigned char* ws = a.ws;
    constexpr int I_GU = (D / 64) * (FF / 32), I_DN = (FF / 64) * (D / 32), I_IN = (D / 64) * (NIN / 32), I_OUT = (D / 64) * (D / 32), I_BR = (1024 / 64) * (D / 32), I_PL = (256 / 64) * (256 / 32);
    constexpr int NITEMS = SET == 0 ? 4 * I_GU + I_DN + I_OUT + 2 * I_BR + 4 * I_PL : (SET == 1 ? I_IN : I_DN);
    for (int it = gw; it < NITEMS; it += NGW) {
        int r = it; const float* W; int K, N, mode = 0, q8 = 0  , d0 = -1, wslot = 0; bf16_t* WT;
        if (SET == 1) { W = KARG(const float*, win); K = D; N = NIN; WT = (bf16_t*)(ws + WS_WIN); const int col = 32 * (r % (NIN / 32));
            if (I8_IN) { if (col < (I8_POOL ? GA_OFF : POOL_OFF)) { q8 = 2; d0 = col; wslot = CM_WIN; } else if (col >= GA_OFF) { q8 = 2; d0 = col - GA_OFF; wslot = CM_WIN; WT = (bf16_t*)(ws + WS_WIN8); } }
            else if (col >= GA_OFF && col < GP_OFF) { q8 = 1; d0 = col - GA_OFF; WT = (bf16_t*)(ws + WS_WIN8); } }
        else if (SET == 2) { W = KARG(const float*, w2d); K = FF; N = D; WT = (bf16_t*)(ws + WS_WD2); const int col = 32 * (r % (D / 32)); if (col < 256 * F8_D2N) { q8 = 1; d0 = col; } }
        else if (r < I_GU) { W = KARG(const float*, w1g); K = D; N = FF; WT = (bf16_t*)(ws + WS_WGU1); mode = 1; if (I8_GU1) { q8 = 2; wslot = CM_W1G; } }
        else if ((r -= I_GU) < I_GU) { W = KARG(const float*, w1u); K = D; N = FF; WT = (bf16_t*)(ws + WS_WGU1); mode = 2; if (I8_GU1) { q8 = 2; wslot = CM_W1U; } }
        else if ((r -= I_GU) < I_GU) { W = KARG(const float*, w2g); K = D; N = FF; WT = (bf16_t*)(ws + WS_WGU2); mode = 1; if (I8_GU2) { q8 = 2; wslot = CM_W2G; } }
        else if ((r -= I_GU) < I_GU) { W = KARG(const float*, w2u); K = D; N = FF; WT = (bf16_t*)(ws + WS_WGU2); mode = 2; if (I8_GU2) { q8 = 2; wslot = CM_W2U; } }
        else if ((r -= I_GU) < I_DN) { if (I8_D1) continue; W = KARG(const float*, w1d); K = FF; N = D; WT = (bf16_t*)(ws + WS_WD1); }
        else if ((r -= I_DN) < I_OUT) { W = KARG(const float*, wout); K = D; N = D; WT = (bf16_t*)(ws + WS_WOUT); }
        else if ((r -= I_OUT) < I_BR) { W = KARG(const float*, wab); K = 1024; N = D; WT = (bf16_t*)(ws + WS_WBA); }
        else if ((r -= I_BR) < I_BR) { W = KARG(const float*, wpb); K = 1024; N = D; WT = (bf16_t*)(ws + WS_WBP); }
        else { r -= I_BR; const int g = r / I_PL; r -= g * I_PL; W = KARG(const float*, poolw) + (size_t)g * 65536; K = 256; N = 256; WT = (bf16_t*)(ws + WS_WPL) + (size_t)g * 65536; }
        if (q8) { const int nblk = N / 32, kb = r / nblk, nb = r % nblk, n0 = 32 * nb;
            if (mode == 1) d0 = (n0 >> 7) * 256 + (n0 & 127); else if (mode == 2) d0 = (n0 >> 7) * 256 + 128 + (n0 & 127);
            if (q8 == 2) continue;
            else transpose_item8<false>(W, K, N, (unsigned char*)WT, scr, kb, nb, d0, 64.f, nullptr, lane); }
        else transpose_item(W, K, N, WT, mode, scr, r, lane, (SET == 1 && I8_IN && POOL_FROM_H) ? KARG(const float*, nmpre) : nullptr);
    }
}

__device__ __forceinline__ void p0_norm(const float* x, const float* gain, bf16_t* xn, unsigned char* xq, float* rs, int gw, int NGW, int lane, unsigned* dctr = nullptr) {
    asm volatile("" : "+v"(lane));
    DYN_ROWS_BEGIN(dctr)
        const f32x4* xr = (const f32x4*)(x + (size_t)m * D) + lane; const f32x4* gr = (const f32x4*)gain + lane;
        f32x4 v[16]; float s = 0.f;
#pragma unroll
        for (int j = 0; j < 16; ++j) { v[j] = xr[64 * j]; s += (v[j][0] * v[j][0] + v[j][1] * v[j][1]) + (v[j][2] * v[j][2] + v[j][3] * v[j][3]); }
        const float rstd = 1.0f / sqrtf(wave_sum(s) * (1.0f / D) + RMS_EPS);
        float amax = 0.f;
#pragma unroll
        for (int j = 0; j < 16; ++j) { const f32x4 g = gr[64 * j]; v[j][0] *= rstd * g[0]; v[j][1] *= rstd * g[1]; v[j][2] *= rstd * g[2]; v[j][3] *= rstd * g[3];
            amax = fmaxf(fmaxf(amax, fmaxf(fabsf(v[j][0]), fabsf(v[j][1]))), fmaxf(fabsf(v[j][2]), fabsf(v[j][3]))); }
        if (xn) { u32x2* o = (u32x2*)(xn + (size_t)m * D) + lane;
#pragma unroll
            for (int j = 0; j < 16; ++j) { u32x2 w; w.x = cvt_pk_bf16(v[j][0], v[j][1]); w.y = cvt_pk_bf16(v[j][2], v[j][3]); o[64 * j] = w; } }
        if (xq) { amax = fmaxf(wave_max(amax), 1e-30f); const float qs = 127.0f / amax; if (lane == 0) rs[m] = amax * (1.0f / 127.f);
            unsigned* o = (unsigned*)(xq + (size_t)m * D) + lane;
#pragma unroll
            for (int j = 0; j < 16; ++j) o[64 * j] = pack4_i8(v[j][0] * qs, v[j][1] * qs, v[j][2] * qs, v[j][3] * qs); }
    DYN_ROWS_END()
}

template <bool BASE16, bool OUT16> __device__ __forceinline__ void norm_phase(LAS unsigned char* lds, const bf16_t* f, const void* base, void* hout, bf16_t* xn, unsigned char* xn8, float* rs, const float* gpost, const float* gpre, float coef, int gw, int NGW, int tid, float* rstd_out = nullptr, unsigned* dctr = nullptr) {
    asm volatile("" : "+v"(tid));
    const int lane = tid & 63;
    LAS f32x4* G1 = (LAS f32x4*)lds; LAS f32x4* G2 = (LAS f32x4*)(lds + 16384);
    for (int i = tid; i < D / 4; i += NTHREADS) { G1[i] = ((const f32x4*)gpost)[i]; if (xn || xn8) G2[i] = ((const f32x4*)gpre)[i]; }
    __syncthreads();
    DYN_ROWS_BEGIN(dctr)
        const u32x2* fr_ = (const u32x2*)(f + (size_t)m * D) + lane;
        u32x2 fw[16]; f32x4 v[16];
#pragma unroll
        for (int j = 0; j < 16; ++j) fw[j] = fr_[64 * j];
        if constexpr (BASE16) { const u32x2* br = (const u32x2*)((const bf16_t*)base + (size_t)m * D) + lane; u32x2 bw[16];
#pragma unroll
            for (int j = 0; j < 16; ++j) bw[j] = br[64 * j];
#pragma unroll
            for (int j = 0; j < 16; ++j) { v[j][0] = bf_lo(bw[j].x); v[j][1] = bf_hi(bw[j].x); v[j][2] = bf_lo(bw[j].y); v[j][3] = bf_hi(bw[j].y); } }
        else { const f32x4* br = (const f32x4*)((const float*)base + (size_t)m * D) + lane;
#pragma unroll
            for (int j = 0; j < 16; ++j) v[j] = br[64 * j]; }
        float s = 0.f;
#pragma unroll
        for (int j = 0; j < 16; ++j) { const float a0 = bf_lo(fw[j].x), a1 = bf_hi(fw[j].x), a2 = bf_lo(fw[j].y), a3 = bf_hi(fw[j].y); s += (a0 * a0 + a1 * a1) + (a2 * a2 + a3 * a3); }
        const float rstd = coef / sqrtf(wave_sum(s) * (1.0f / D) + RMS_EPS);
        float s2 = 0.f; f32x4* ho = (f32x4*)((float*)hout + (size_t)m * D) + lane; u32x2* ho16 = (u32x2*)((bf16_t*)hout + (size_t)m * D) + lane;
#pragma unroll
        for (int j = 0; j < 16; ++j) { const f32x4 g = G1[64 * j + lane]; f32x4 h;
            h[0] = v[j][0] + bf_lo(fw[j].x) * rstd * g[0]; h[1] = v[j][1] + bf_hi(fw[j].x) * rstd * g[1]; h[2] = v[j][2] + bf_lo(fw[j].y) * rstd * g[2]; h[3] = v[j][3] + bf_hi(fw[j].y) * rstd * g[3];
            v[j] = h; if constexpr (OUT16) { u32x2 w; w.x = cvt_pk_bf16(h[0], h[1]); w.y = cvt_pk_bf16(h[2], h[3]); ho16[64 * j] = w; } else ho[64 * j] = h; s2 += (h[0] * h[0] + h[1] * h[1]) + (h[2] * h[2] + h[3] * h[3]);
            if ((j & 3) == 3) __builtin_amdgcn_sched_barrier(0); }
        if (xn || xn8) {
            const float r2 = 1.0f / sqrtf(wave_sum(s2) * (1.0f / D) + RMS_EPS);
            if (rstd_out && lane == 0) rstd_out[m] = r2;
            float amax = 0.f;
#pragma unroll
            for (int j = 0; j < 16; ++j) { const f32x4 g = G2[64 * j + lane]; v[j][0] *= r2 * g[0]; v[j][1] *= r2 * g[1]; v[j][2] *= r2 * g[2]; v[j][3] *= r2 * g[3];
                amax = fmaxf(fmaxf(amax, fmaxf(fabsf(v[j][0]), fabsf(v[j][1]))), fmaxf(fabsf(v[j][2]), fabsf(v[j][3])));
                if ((j & 3) == 3) __builtin_amdgcn_sched_barrier(0); }
            if (xn) { u32x2* o = (u32x2*)(xn + (size_t)m * D) + lane;
#pragma unroll
                for (int j = 0; j < 16; ++j) { u32x2 w; w.x = cvt_pk_bf16(v[j][0], v[j][1]); w.y = cvt_pk_bf16(v[j][2], v[j][3]); o[64 * j] = w; } }
            if (xn8 && !rs) { unsigned* o = (unsigned*)(xn8 + (size_t)m * D) + lane;
#pragma unroll
                for (int j = 0; j < 16; ++j) o[64 * j] = cvt4_fp8(v[j][0], v[j][1], v[j][2], v[j][3]); }
            if (xn8 && rs) { amax = fmaxf(wave_max(amax), 1e-30f); const float qs = 127.0f / amax; if (lane == 0) rs[m] = amax * (1.0f / 127.f);
                unsigned* o = (unsigned*)(xn8 + (size_t)m * D) + lane;
#pragma unroll
                for (int j = 0; j < 16; ++j) o[64 * j] = pack4_i8(v[j][0] * qs, v[j][1] * qs, v[j][2] * qs, v[j][3] * qs); }
        }
    DYN_ROWS_END()
    __syncthreads();
}

template <int P> __device__ __forceinline__ void pool_delta_task(const bf16_t* proj, bf16_t* delta, int g, int mp, int lane) {
    const int m = 2 * mp + (lane >> 5), c = 8 * (lane & 31), t = m & (SEQ - 1);
    const bf16_t* zp = proj + (size_t)m * NIN + POOL_OFF + g * 256 + c;
    u32x4 w[P];
#pragma unroll
    for (int j = 0; j < P; ++j) w[j] = (j <= t) ? *(const u32x4*)(zp - (size_t)j * NIN) : (u32x4){0u, 0u, 0u, 0u};
    float s[8];
#pragma unroll
    for (int k = 0; k < 8; ++k) s[k] = 0.f;
#pragma unroll
    for (int j = 0; j < P; ++j) { s[0] += bf_lo(w[j].x); s[1] += bf_hi(w[j].x); s[2] += bf_lo(w[j].y); s[3] += bf_hi(w[j].y); s[4] += bf_lo(w[j].z); s[5] += bf_hi(w[j].z); s[6] += bf_lo(w[j].w); s[7] += bf_hi(w[j].w); }
    const int cnt = (t + 1) < P ? (t + 1) : P; const float ic = 1.0f / (float)cnt;
    u32x4 o; o.x = cvt_pk_bf16(s[0] * ic - bf_lo(w[0].x), s[1] * ic - bf_hi(w[0].x)); o.y = cvt_pk_bf16(s[2] * ic - bf_lo(w[0].y), s[3] * ic - bf_hi(w[0].y));
    o.z = cvt_pk_bf16(s[4] * ic - bf_lo(w[0].z), s[5] * ic - bf_hi(w[0].z)); o.w = cvt_pk_bf16(s[6] * ic - bf_lo(w[0].w), s[7] * ic - bf_hi(w[0].w));
    *(u32x4*)(delta + ((size_t)g * M + m) * 256 + c) = o;
}
__device__ __forceinline__ void pool_delta(const bf16_t* proj, bf16_t* delta, int gw, int NGW, int lane) {
    asm volatile("" : "+v"(lane));
    for (int task = gw; task < 2 * M; task += NGW) {
        const int g = task & 3, mp = task >> 2;
        if (g == 0) pool_delta_task<2>(proj, delta, 0, mp, lane);
        else if (g == 1) pool_delta_task<4>(proj, delta, 1, mp, lane);
        else if (g == 2) pool_delta_task<8>(proj, delta, 2, mp, lane);
        else pool_delta_task<16>(proj, delta, 3, mp, lane);
    }
}

namespace att {
__device__ __forceinline__ void attn_merge(const bf16_t* outg, const float* lse, bf16_t* attn, int gtid, int NT) {
    asm volatile("" : "+v"(gtid));
    for (int idx = gtid; idx < M * 128; idx += NT) {
        const int m = idx >> 7, c8 = (idx & 127) * 8, h = c8 >> 7;
        const float l0 = lse[(size_t)m * 8 + h], l1 = lse[((size_t)M + m) * 8 + h], l2 = lse[((size_t)2 * M + m) * 8 + h];
        const float mm = fmaxf(l0, fmaxf(l1, l2));
        float w0 = __expf(l0 - mm), w1 = __expf(l1 - mm), w2 = __expf(l2 - mm); const float inv = 1.0f / (w0 + w1 + w2); w0 *= inv; w1 *= inv; w2 *= inv;
        const u32x4 a = *(const u32x4*)(outg + (size_t)m * 1024 + c8), bq = *(const u32x4*)(outg + ((size_t)M + m) * 1024 + c8), c = *(const u32x4*)(outg + ((size_t)2 * M + m) * 1024 + c8);
        u32x4 o;
#pragma unroll
        for (int k = 0; k < 4; ++k) o[k] = cvt_pk_bf16(w0 * bf_lo(a[k]) + w1 * bf_lo(bq[k]) + w2 * bf_lo(c[k]), w0 * bf_hi(a[k]) + w1 * bf_hi(bq[k]) + w2 * bf_hi(c[k]));
        *(u32x4*)(attn + (size_t)m * 1024 + c8) = o;
    }
}
}


namespace att2 {
constexpr int VROW = 272, KBYTES = 32768, STG = KBYTES + 128 * VROW, N_UNITS = 3 * BATCH * 8 * 32;
static_assert(2 * STG <= MISC_OFF, "attention LDS");
struct Lane { int kR[2], kC[2]; unsigned ldsw; int koff, v_ch, v_kg, vcol, fr, fq, qbw, qi; };
struct UDec { const bf16_t* base; size_t rs; int qb, d, g, h, b, r; };
__device__ __forceinline__ UDec decode(const bf16_t* proj, int u) {
    UDec x; const int sub = u & 31; x.h = (u >> 5) & 7; x.b = (u >> 8) & 3; x.g = u >> 10;
    const int dsh = 2 * x.g, nbsh = 5 - dsh; x.d = 1 << dsh; x.qb = sub & ((1 << nbsh) - 1); x.r = sub >> nbsh;
    x.rs = (size_t)x.d * NIN; x.base = proj + ((size_t)x.b * SEQ + x.r) * NIN + x.g * 3072 + x.h * 128; return x;
}
__device__ __forceinline__ int first_half(int u) { const int g = u >> 10, nbsh = 5 - 2 * g; return ((u & 31) & ((1 << nbsh) - 1)) == 0 ? 1 : 0; }
template <int PAR> __device__ __forceinline__ void issue(LAS unsigned char* lds, const bf16_t* proj, int u, int half, const Lane& L, u32x4 (&vr)[4]) {
    const UDec x = decode(proj, u);
    const int i0 = 128 * x.qb - 128 * (1 - half);
    const bf16_t* kb = x.base + 1024 + (size_t)i0 * x.rs;
#pragma unroll
    for (int eh = 0; eh < 2; ++eh)
#pragma unroll
        for (int i = 0; i < 2; ++i)
            __builtin_amdgcn_global_load_lds((const unsigned*)(kb + 64 * eh + (size_t)L.kR[i] * x.rs + L.kC[i]), (LAS unsigned*)(lds + PAR * STG + eh * 16384 + L.ldsw + i * 8192), 16, 0, 0);
    const bf16_t* vp = x.base + 2048 + (size_t)(i0 + 4 * L.v_kg) * x.rs + 8 * L.v_ch;
#pragma unroll
    for (int c = 0; c < 4; ++c) vr[c] = *(const u32x4*)(vp + (size_t)c * x.rs);
}
template <int PAR> __device__ __forceinline__ void store_v(LAS unsigned char* lds, const Lane& L, const u32x4 (&vr)[4]) {
    LAS unsigned char* vdst = lds + PAR * STG + KBYTES + (8 * L.v_ch) * VROW + L.vcol;
#pragma unroll
    for (int wi = 0; wi < 4; ++wi) {
        u32x2 ev, od;
        ev.x = (vr[0][wi] & 0xffffu) | (vr[1][wi] << 16); ev.y = (vr[2][wi] & 0xffffu) | (vr[3][wi] << 16);
        od.x = (vr[0][wi] >> 16) | (vr[1][wi] & 0xffff0000u); od.y = (vr[2][wi] >> 16) | (vr[3][wi] & 0xffff0000u);
        *(LAS u32x2*)(vdst + (2 * wi) * VROW) = ev; *(LAS u32x2*)(vdst + (2 * wi + 1) * VROW) = od; }
}
__device__ __forceinline__ void load_q(const bf16_t* proj, int u, const Lane& L, bf16x8 (&q)[4]) {
    const UDec x = decode(proj, u);
    const bf16_t* qp = x.base + (size_t)(128 * x.qb + L.qi) * x.rs + 8 * L.fq;
#pragma unroll
    for (int ks = 0; ks < 4; ++ks) q[ks] = *(const bf16x8*)(qp + 32 * ks);
}
template <int PAR, int HALF, int QBW> __device__ __forceinline__ void compute(LAS unsigned char* lds, int u, const Lane& L, const bf16x8 (&qf)[4], float& mrun, float& lrun, f32x4 (&o)[8]) {
    const int g = u >> 10, h = (u >> 5) & 7, d = 1 << (2 * g);
    constexpr int KT0 = HALF ? 0 : QBW, KT1 = HALF ? QBW : 7;
    f32x4 s[8];
#pragma unroll
    for (int kt = KT0; kt <= KT1; ++kt) {
        s[kt] = (f32x4){0.f, 0.f, 0.f, 0.f};
#pragma unroll
        for (int ks = 0; ks < 4; ++ks) { const bf16x8 kf = *(const LAS bf16x8*)(lds + PAR * STG + (ks >> 1) * 16384 + L.koff + kt * 2048 + (ks & 1) * 1024);
            s[kt] = __builtin_amdgcn_mfma_f32_16x16x32_bf16(kf, qf[ks], s[kt], 0, 0, 0); }
        if ((kt - KT0) & 1) __builtin_amdgcn_sched_barrier(0);
    }
    const float slope = (g < 2) ? exp2f(-0.25f * (float)(g * 8 + h + 1)) : exp2f(-(4.5f + 0.5f * (float)h));
    const float sld = slope * (float)d * 1.4426950408889634f;
    int bi = 16 * QBW + L.fr + 128 * (1 - HALF) - 4 * L.fq; asm volatile("" : "+v"(bi));
    int dq = 4 * L.fq - L.fr; asm volatile("" : "+v"(dq));
    const float c0 = -sld * (float)bi;
    float mloc = -1e30f;
#pragma unroll
    for (int kt = KT0; kt <= KT1; ++kt) {
#pragma unroll
        for (int j = 0; j < 4; ++j) { float v = s[kt][j] * (0.08838834764831845f * 1.4426950408889634f) + (c0 + sld * (float)(16 * kt + j));
            if (kt == QBW) { const bool valid = HALF ? (dq + j <= 0) : (dq + j >= 0); v = valid ? v : -1e30f; }
            s[kt][j] = v; mloc = fmaxf(mloc, v); }
    }
    mloc = fmaxf(mloc, __shfl_xor(mloc, 16)); mloc = fmaxf(mloc, __shfl_xor(mloc, 32));
    const float mnew = fmaxf(mrun, mloc), alpha = __builtin_amdgcn_exp2f(mrun - mnew);
    float lsum = 0.f;
#pragma unroll
    for (int kt = KT0; kt <= KT1; ++kt)
#pragma unroll
        for (int j = 0; j < 4; ++j) { const float p = __builtin_amdgcn_exp2f(s[kt][j] - mnew); s[kt][j] = p; lsum += p; }
    lrun = lrun * alpha + lsum; mrun = mnew;
#pragma unroll
    for (int et = 0; et < 8; ++et) o[et] = o[et] * alpha;
#pragma unroll
    for (int ss = KT0 / 2; ss <= KT1 / 2; ++ss) {
        const bool l0 = (2 * ss >= KT0) && (2 * ss <= KT1), l1 = (2 * ss + 1 >= KT0) && (2 * ss + 1 <= KT1);
        u32x4 pw;
        pw.x = l0 ? cvt_pk_bf16(s[2 * ss][0], s[2 * ss][1]) : 0u; pw.y = l0 ? cvt_pk_bf16(s[2 * ss][2], s[2 * ss][3]) : 0u;
        pw.z = l1 ? cvt_pk_bf16(s[(2 * ss + 1) & 7][0], s[(2 * ss + 1) & 7][1]) : 0u; pw.w = l1 ? cvt_pk_bf16(s[(2 * ss + 1) & 7][2], s[(2 * ss + 1) & 7][3]) : 0u;
        const bf16x8 pf = __builtin_bit_cast(bf16x8, pw);
#pragma unroll
        for (int et = 0; et < 8; ++et) { const bf16x8 vf = *(const LAS bf16x8*)(lds + PAR * STG + KBYTES + (16 * et + L.fr) * VROW + 64 * ss + 16 * L.fq);
            o[et] = __builtin_amdgcn_mfma_f32_16x16x32_bf16(vf, pf, o[et], 0, 0, 0); }
        __builtin_amdgcn_sched_barrier(0);
    }
}
template <int PAR> __device__ __forceinline__ void compute_sel(LAS unsigned char* lds, int u, int half, const Lane& L, const bf16x8 (&qf)[4], float& mrun, float& lrun, f32x4 (&o)[8]) {
#define ATT_CASE(H, Q) case (H) * 8 + (Q): compute<PAR, H, Q>(lds, u, L, qf, mrun, lrun, o); break;
    switch (half * 8 + L.qbw) {
        ATT_CASE(0, 0) ATT_CASE(0, 1) ATT_CASE(0, 2) ATT_CASE(0, 3) ATT_CASE(0, 4) ATT_CASE(0, 5) ATT_CASE(0, 6) ATT_CASE(0, 7)
        ATT_CASE(1, 0) ATT_CASE(1, 1) ATT_CASE(1, 2) ATT_CASE(1, 3) ATT_CASE(1, 4) ATT_CASE(1, 5) ATT_CASE(1, 6) ATT_CASE(1, 7)
        default: break;
    }
#undef ATT_CASE
}
__device__ __forceinline__ void finalize(const bf16_t* proj, int u, const Lane& L, float mrun, float lrun, const f32x4 (&o)[8], bf16_t* outg, float* lse) {
    const UDec x = decode(proj, u);
    float l = lrun; l += __shfl_xor(l, 16); l += __shfl_xor(l, 32);
    const float inv = 1.0f / l;
    const size_t mrow = (size_t)x.g * M + (size_t)x.b * SEQ + (size_t)(128 * x.qb + L.qi) * x.d + x.r;
    bf16_t* op = outg + mrow * 1024 + x.h * 128 + 4 * L.fq;
#pragma unroll
    for (int et = 0; et < 8; ++et) { u32x2 w; w.x = cvt_pk_bf16(o[et][0] * inv, o[et][1] * inv); w.y = cvt_pk_bf16(o[et][2] * inv, o[et][3] * inv); *(u32x2*)(op + 16 * et) = w; }
    if (L.fq == 0) lse[mrow * 8 + x.h] = (mrun + __builtin_amdgcn_logf(l)) * 0.6931471805599453f;
}
template <int PAR> __device__ __forceinline__ bool step(LAS unsigned char* lds, const bf16_t* proj, bf16_t* outg, float* lse, int G, const Lane& L, int& u, int& half, bf16x8 (&qf)[4], float& mrun, float& lrun, f32x4 (&o)[8]) {
    int nu, nh; if (half == 0) { nu = u; nh = 1; } else { nu = u + G; nh = nu < N_UNITS ? first_half(nu) : 0; }
    const bool has_next = nu < N_UNITS, new_unit = has_next && (nu != u);
    u32x4 vr[4]; bf16x8 qn[4];
    if (has_next) issue<PAR ^ 1>(lds, proj, nu, nh, L, vr);
    if (new_unit) load_q(proj, nu, L, qn);
    __builtin_amdgcn_sched_barrier(0);
    compute_sel<PAR>(lds, u, half, L, qf, mrun, lrun, o);
    if (half == 1) { finalize(proj, u, L, mrun, lrun, o, outg, lse); mrun = -1e30f; lrun = 0.f;
#pragma unroll
        for (int et = 0; et < 8; ++et) o[et] = (f32x4){0.f, 0.f, 0.f, 0.f}; }
    __builtin_amdgcn_sched_barrier(0);
    if (has_next) store_v<PAR ^ 1>(lds, L, vr);
    if (new_unit) {
#pragma unroll
        for (int ks = 0; ks < 4; ++ks) qf[ks] = qn[ks]; }
    __builtin_amdgcn_s_waitcnt(0); asm volatile("" ::: "memory"); __builtin_amdgcn_s_barrier(); asm volatile("" ::: "memory");
    u = nu; half = nh;
    return has_next;
}
__device__ __forceinline__ void attn_phase(LAS unsigned char* lds, const bf16_t* proj, bf16_t* outg, float* lse, int vcu, int G) {
    int tid = threadIdx.x; asm volatile("" : "+v"(tid));
    const int lane = tid & 63, wid = __builtin_amdgcn_readfirstlane(tid >> 6);
    Lane L;
#pragma unroll
    for (int i = 0; i < 2; ++i) pg8::stage_rc(tid * 16 + i * 8192, L.kR[i], L.kC[i]);
    L.fr = lane & 15; L.fq = lane >> 4; L.ldsw = (unsigned)wid * 1024u; L.koff = pg8::lds_byte(L.fr, L.fq * 8);
    L.v_ch = (lane & 3) + 4 * ((lane >> 4) & 3); L.v_kg = ((lane >> 2) & 3) + 4 * wid;
    L.vcol = 64 * (wid >> 1) + 16 * ((lane >> 2) & 3) + 8 * (wid & 1);
    L.qbw = wid < 4 ? wid : 11 - wid; L.qi = 16 * L.qbw + L.fr;
    int u = vcu; if (u >= N_UNITS) return;
    int half = first_half(u);
    bf16x8 qf[4]; f32x4 o[8]; float mrun = -1e30f, lrun = 0.f;
#pragma unroll
    for (int et = 0; et < 8; ++et) o[et] = (f32x4){0.f, 0.f, 0.f, 0.f};
    { u32x4 vr[4]; issue<0>(lds, proj, u, half, L, vr); load_q(proj, u, L, qf); store_v<0>(lds, L, vr); }
    __builtin_amdgcn_s_waitcnt(0); asm volatile("" ::: "memory"); __builtin_amdgcn_s_barrier(); asm volatile("" ::: "memory");
    for (;;) {
        if (!step<0>(lds, proj, outg, lse, G, L, u, half, qf, mrun, lrun, o)) break;
        if (!step<1>(lds, proj, outg, lse, G, L, u, half, qf, mrun, lrun, o)) break;
    }
}
}

constexpr int NPHASE = 13;
__global__ void __launch_bounds__(NTHREADS, 2) mk_fwd(Args a) {
    extern __shared__ __attribute__((aligned(16))) unsigned char lds_raw[];
    LAS unsigned char* lds = (LAS unsigned char*)lds_raw;
    const int tid = threadIdx.x, lane = tid & 63, wave = __builtin_amdgcn_readfirstlane(tid >> 6);
    const int G = gridDim.x, bx = blockIdx.x;
    const int vcu = (G % 8 == 0) ? (bx % 8) * (G / 8) + bx / 8 : bx;
    const int gw = vcu * NWAVES + wave, NGW = G * NWAVES;
    unsigned char* ws = a.ws;
    unsigned* ctl = (unsigned*)(ws + WS_CTL);
    volatile LAS unsigned* MISC = (volatile LAS unsigned*)(lds + MISC_OFF);
    if (tid < 32) MISC[tid] = 0u;
    __syncthreads();
    XcdBarrier bar; bar.bar = ctl + CW_BAR; bar.x = 0; bar.st = nullptr;
    if (MK_ONE_LAUNCH) bar = xcd_barrier_post(ctl + CW_BAR, MISC + 8);
    const int lo = a.ph_lo, hi = a.ph_hi;
#ifdef DBG_ONLY
#define IN(k) ((k) == DBG_ONLY && lo <= (k) && (k) < hi)
#else
#define IN(k) (lo <= (k) && (k) < hi)
#endif
#define SEAM(k) do { if (MK_ONE_LAUNCH && IN(k) && IN((k) + 1)) xcd_barrier(bar); } while (0)

    bf16_t* XN = (bf16_t*)(ws + WS_XN); bf16_t* ACT = (bf16_t*)(ws + WS_ACT); bf16_t* Fb = (bf16_t*)(ws + WS_F); bf16_t* PROJ = (bf16_t*)(ws + WS_PROJ);
    bf16_t* ATT = (bf16_t*)(ws + WS_ATTN); bf16_t* DELTA = (bf16_t*)(ws + WS_DELTA); bf16_t* POOLED = (bf16_t*)(ws + WS_POOLED); bf16_t* MERGED = XN;

    unsigned* wq = ctl + CW_CMAX; const float* cmf = (const float*)wq;
    float* RS = (float*)(ws + WS_CTL + 512 * 1024);
    unsigned char* ACT8 = ws + WS_WGU1;
    bf16_t* H1 = (bf16_t*)(ws + WS_WGU1); bf16_t* H2 = (bf16_t*)(ws + WS_WIN);
    float* RSTD = RS + 2 * M;
    unsigned char* AQ = ws + WS_WGU1; float* RS2 = RS + M;
    unsigned char* XQ = ws + WS_T1;
    const bool tail_cvt = (G == 256);
    if (IN(0)) {
        p0_slabs<0>(a, lds, ctl, bx >> 1, G >> 1, bx & 1, tid);
        p0_slabs<1>(a, lds, ctl, bx >> 1, G >> 1, bx & 1, tid, 0, tail_cvt ? W_IN_P0_SLABS : 1 << 30);
        if (I8_D1) wd_pass<0>(KARG(const float*, w1d), nullptr, wq + CM_W1D, gw, NGW, lane);
        if (I8_D2 && !tail_cvt) wd_pass<0>(KARG(const float*, w2d), nullptr, wq + CM_W2D, gw, NGW, lane);
        p0_weights<0>(a, lds, gw, NGW, wave, lane, wq);
        if (!tail_cvt) { p0_weights<1>(a, lds, gw, NGW, wave, lane, wq); if (!I8_D2) p0_weights<2>(a, lds, gw, NGW, wave, lane, wq); }
        p0_norm(KARG(const float*, x), KARG(const float*, n1pre), I8_GU1 ? nullptr : XN, I8_GU1 ? XQ : nullptr, RS, gw, NGW, lane, ctl + CW_DYN); }
    SEAM(0);
    if (IN(1)) {
#if I8_GU1
        { pg8::PlainSched S; S.T.init(M, 2 * FF, G, bx, WGM_G); S.A = (const char*)XQ; S.B = (const char*)(ws + WS_WGU1); S.tstep = (size_t)256 * D;
          pg8::EpiSwiGLUI8<0> E{ACT, nullptr, FF, RS, cmf + CM_W1G, cmf + CM_W1U};
          pg8::gemm_phase<pg8::EpiSwiGLUI8<0>, pg8::PlainSched, PG8_ALIGN, PG8_SP2, 2>(lds, D / 2, S, E); }
#else
        { pg8::PlainSched S; S.T.init(M, 2 * FF, G, bx, WGM_G); S.A = (const char*)XN; S.B = (const char*)(ws + WS_WGU1); S.tstep = (size_t)256 * D * 2;
          pg8::EpiSwiGLU E{ACT, FF};
          pg8::gemm_phase<pg8::EpiSwiGLU, pg8::PlainSched, PG8_ALIGN, PG8_SP2>(lds, D, S, E); }
#endif
        if (tail_cvt && bx >= 128) { p0_slabs<1>(a, lds, ctl, (bx - 128) >> 1, 64, bx & 1, tid, W_IN_P0_SLABS); if (!(I8_IN && I8_POOL)) p0_weights<1>(a, lds, (bx - 128) * NWAVES + wave, 128 * NWAVES, wave, lane, wq); } }
    SEAM(1);
    if (IN(2)) {
#if I8_D1
        wd_pass<1>(KARG(const float*, w1d), ws + WS_WD1, wq + CM_W1D, gw, NGW, lane);
        actq_phase(ACT, AQ, RS2, gw, NGW, lane, ctl + CW_DYN + 2048);
        xcd_barrier(bar);
        { pg8::PlainSched S; S.T.init(M, D, G, bx, WGM_D); S.A = (const char*)AQ; S.B = (const char*)(ws + WS_WD1); S.tstep = (size_t)256 * FF;
          pg8::EpiBf16SigI8 E{Fb, D, 1 << 20, RS2, cmf + CM_W1D, 1.0f / (8.f * 127.f)};
          pg8::gemm_phase<pg8::EpiBf16SigI8, pg8::PlainSched, PG8_ALIGN, PG8_SP2, 2>(lds, FF / 2, S, E); }
#else
        { pg8::PlainSched S; S.T.init(M, D, G, bx, WGM_D); S.A = (const char*)ACT; S.B = (const char*)(ws + WS_WD1); S.tstep = (size_t)256 * FF * 2;
          pg8::EpiBf16 E{Fb, D, 1.0f};
          pg8::gemm_phase<pg8::EpiBf16, pg8::PlainSched, PG8_ALIGN, PG8_SP2>(lds, FF, S, E); }
#endif
    }
    SEAM(2);
    if (IN(3)) norm_phase<false, true>(lds, Fb, KARG(const float*, x), H1, (I8_IN && (I8_POOL || POOL_FROM_H)) ? nullptr : XN, XQ, I8_IN ? RS : nullptr, KARG(const float*, n1post), KARG(const float*, nmpre), 0.5f, gw, NGW, tid, (I8_IN && POOL_FROM_H) ? RSTD : nullptr, ctl + CW_DYN + 4096);
    SEAM(3);
    if (IN(4)) {
#if I8_IN
        { pg8::PlainSched S; S.T.init(M, I8_POOL ? GA_OFF : POOL_OFF, G, bx, WGM_G); S.A = (const char*)XQ; S.B = (const char*)(ws + WS_WIN); S.tstep = (size_t)256 * D;
          pg8::EpiBf16SigI8 E{PROJ, NIN, 1 << 20, RS, cmf + CM_WIN, 1.0f / 127.f};
          pg8::gemm_phase<pg8::EpiBf16SigI8, pg8::PlainSched, PG8_ALIGN, PG8_SP2, 2>(lds, D / 2, S, E); }
        if (!I8_POOL && POOL_FROM_H) { pg8::PlainSched S; S.T.init(M, GA_OFF - POOL_OFF, G, bx, WGM_G); S.A = (const char*)H1; S.B = (const char*)(ws + WS_WIN) + (size_t)POOL_OFF * D * 2; S.tstep = (size_t)256 * D * 2;
          pg8::EpiBf16Row E{PROJ + POOL_OFF, NIN, RSTD};
          pg8::gemm_phase<pg8::EpiBf16Row, pg8::PlainSched, PG8_ALIGN, PG8_SP2>(lds, D, S, E); }
        if (!I8_POOL && !POOL_FROM_H) { pg8::PlainSched S; S.T.init(M, GA_OFF - POOL_OFF, G, bx, WGM_G); S.A = (const char*)XN; S.B = (const char*)(ws + WS_WIN) + (size_t)POOL_OFF * D * 2; S.tstep = (size_t)256 * D * 2;
          pg8::EpiBf16Sig E{PROJ + POOL_OFF, NIN, 1 << 20, 1.0f};
          pg8::gemm_phase<pg8::EpiBf16Sig, pg8::PlainSched, PG8_ALIGN, PG8_SP2>(lds, D, S, E); }
        { pg8::PlainSched S; S.T.init(M, 2 * D, G, bx, WGM_G); S.A = (const char*)XQ; S.B = (const char*)(ws + WS_WIN8); S.tstep = (size_t)256 * D;
          pg8::EpiBf16SigI8 E{PROJ + GA_OFF, NIN, 0, RS, cmf + CM_WIN + GA_OFF, 1.0f / 127.f};
          pg8::gemm_phase<pg8::EpiBf16SigI8, pg8::PlainSched, PG8_ALIGN, PG8_SP2, 2>(lds, D / 2, S, E); }
#else
        { pg8::PlainSched S; S.T.init(M, GA_OFF, G, bx, WGM_G); S.A = (const char*)XN; S.B = (const char*)(ws + WS_WIN); S.tstep = (size_t)256 * D * 2;
          pg8::EpiBf16Sig E{PROJ, NIN, 1 << 20, 1.0f};
          pg8::gemm_phase<pg8::EpiBf16Sig, pg8::PlainSched, PG8_ALIGN, PG8_SP2>(lds, D, S, E); }
        { pg8::PlainSched S; S.T.init(M, D, G, bx, WGM_G); S.A = (const char*)XN; S.B = (const char*)(ws + WS_WIN) + (size_t)GP_OFF * D * 2; S.tstep = (size_t)256 * D * 2;
          pg8::EpiBf16Sig E{PROJ + GP_OFF, NIN, 0, 1.0f};
          pg8::gemm_phase<pg8::EpiBf16Sig, pg8::PlainSched, PG8_ALIGN, PG8_SP2>(lds, D, S, E); }
        { pg8::PlainSched S; S.T.init(M, D, G, bx, WGM_G); S.A = (const char*)XQ; S.B = (const char*)(ws + WS_WIN8); S.tstep = (size_t)256 * D;
          pg8::EpiBf16Sig E{PROJ + GA_OFF, NIN, 0, 1.0f / 64.f};
          pg8::gemm_phase<pg8::EpiBf16Sig, pg8::PlainSched, PG8_ALIGN, PG8_SP2, 1>(lds, D / 2, S, E); }
#endif
    }
    SEAM(4);
    if (IN(5)) { att2::attn_phase(lds, PROJ, (bf16_t*)(ws + WS_OUTG), (float*)(ws + WS_LSE), vcu, G); pool_delta(PROJ, DELTA, gw, NGW, lane); }
    SEAM(5);
    if (IN(6)) { att::attn_merge((const bf16_t*)(ws + WS_OUTG), (const float*)(ws + WS_LSE), ATT, vcu * NTHREADS + tid, G * NTHREADS);
        pg8::PoolSched S; S.T.init(M, 1024, G, bx); S.A = (const char*)DELTA; S.B = (const char*)(ws + WS_WPL); S.tstep = (size_t)256 * 256 * 2; S.gstride = (size_t)M * 256 * 2;
        pg8::EpiPool E{POOLED, 1024, KARG(const float*, poolscale)};
        pg8::gemm_phase<pg8::EpiPool, pg8::PoolSched, PG8_ALIGN, PG8_SP2>(lds, 256, S, E); }
    SEAM(6);
    if (IN(7)) { pg8::BranchSched S; S.T.init(M, D, G, bx); S.A0 = (const char*)ATT; S.B0 = (const char*)(ws + WS_WBA); S.A1 = (const char*)POOLED; S.B1 = (const char*)(ws + WS_WBP); S.tstep = (size_t)256 * 1024 * 2;
        pg8::EpiBranch E{MERGED, D, PROJ};
        pg8::gemm_phase<pg8::EpiBranch, pg8::BranchSched, PG8_ALIGN, PG8_SP2>(lds, 1024, S, E); }
    SEAM(7);
    if (IN(8)) { pg8::PlainSched S; S.T.init(M, D, G, bx); S.A = (const char*)MERGED; S.B = (const char*)(ws + WS_WOUT); S.tstep = (size_t)256 * D * 2;
        pg8::EpiBf16 E{Fb, D, 1.0f};
        pg8::gemm_phase<pg8::EpiBf16, pg8::PlainSched, PG8_ALIGN, PG8_SP2>(lds, D, S, E); }
    SEAM(8);
    if (IN(9)) norm_phase<true, true>(lds, Fb, H1, H2, I8_GU2 ? nullptr : XN, I8_GU2 ? XQ : nullptr, RS, KARG(const float*, nmpost), KARG(const float*, n2pre), 1.0f, gw, NGW, tid, nullptr, ctl + CW_DYN + 6144);
    SEAM(9);
    if (IN(10)) {
#if I8_GU2
        { pg8::PlainSched S; S.T.init(M, 2 * FF, G, bx, WGM_G); S.A = (const char*)XQ; S.B = (const char*)(ws + WS_WGU2); S.tstep = (size_t)256 * D;
          constexpr int OUT = F8_D2N == 0 ? 0 : (F8_D2N == 16 ? 1 : 2);
          pg8::EpiSwiGLUI8<OUT> E{ACT, F8_D2N == 16 ? (unsigned char*)ACT : ACT8, FF, RS, cmf + CM_W2G, cmf + CM_W2U};
          pg8::gemm_phase<pg8::EpiSwiGLUI8<OUT>, pg8::PlainSched, PG8_ALIGN, PG8_SP2, 2>(lds, D / 2, S, E); }
#elif F8_D2
        { pg8::PlainSched S; S.T.init(M, 2 * FF, G, bx, WGM_G); S.A = (const char*)XN; S.B = (const char*)(ws + WS_WGU2); S.tstep = (size_t)256 * D * 2;
          pg8::EpiSwiGLU8 E{(unsigned char*)ACT, FF};
          pg8::gemm_phase<pg8::EpiSwiGLU8, pg8::PlainSched, PG8_ALIGN, PG8_SP2>(lds, D, S, E); }
#else
        { pg8::PlainSched S; S.T.init(M, 2 * FF, G, bx, WGM_G); S.A = (const char*)XN; S.B = (const char*)(ws + WS_WGU2); S.tstep = (size_t)256 * D * 2;
          pg8::EpiSwiGLU E{ACT, FF};
          pg8::gemm_phase<pg8::EpiSwiGLU, pg8::PlainSched, PG8_ALIGN, PG8_SP2>(lds, D, S, E); }
#endif
        if (tail_cvt && bx >= 128) { if (I8_D2) wd_pass<0>(KARG(const float*, w2d), nullptr, wq + CM_W2D, (bx - 128) * NWAVES + wave, 128 * NWAVES, lane);
            else p0_weights<2>(a, lds, (bx - 128) * NWAVES + wave, 128 * NWAVES, wave, lane, wq); } }
    SEAM(10);
    if (IN(11)) {
#if I8_D2
        static_assert(F8_D2N == 0, "int8 FFN2 down excludes the fp8 split");
        wd_pass<1>(KARG(const float*, w2d), ws + WS_WD2, wq + CM_W2D, gw, NGW, lane);
        actq_phase(ACT, AQ, RS2, gw, NGW, lane, ctl + CW_DYN + 8192);
        xcd_barrier(bar);
        { pg8::PlainSched S; S.T.init(M, D, G, bx, WGM_D); S.A = (const char*)AQ; S.B = (const char*)(ws + WS_WD2); S.tstep = (size_t)256 * FF;
          pg8::EpiBf16SigI8 E{Fb, D, 1 << 20, RS2, cmf + CM_W2D, 1.0f / (8.f * 127.f)};
          pg8::gemm_phase<pg8::EpiBf16SigI8, pg8::PlainSched, PG8_ALIGN, PG8_SP2, 2>(lds, FF / 2, S, E); }
#else
        if (F8_D2N > 0) { pg8::PlainSched S; S.T.init(M, 256 * F8_D2N, G, bx, WGM_D); S.A = (const char*)(F8_D2N == 16 ? (unsigned char*)ACT : ACT8); S.B = (const char*)(ws + WS_WD2); S.tstep = (size_t)256 * FF;
            pg8::EpiBf16 E{Fb, D, 1.0f / 64.f};
            pg8::gemm_phase<pg8::EpiBf16, pg8::PlainSched, PG8_ALIGN, PG8_SP2, 1>(lds, FF / 2, S, E); }
        if (F8_D2N < 16) { pg8::PlainSched S; S.T.init(M, D - 256 * F8_D2N, G, bx, WGM_D); S.A = (const char*)ACT; S.B = (const char*)(ws + WS_WD2) + (size_t)256 * F8_D2N * FF * 2; S.tstep = (size_t)256 * FF * 2;
            pg8::EpiBf16 E{Fb + 256 * F8_D2N, D, 1.0f};
            pg8::gemm_phase<pg8::EpiBf16, pg8::PlainSched, PG8_ALIGN, PG8_SP2>(lds, FF, S, E); }
#endif
    }
    SEAM(11);
    if (IN(12)) norm_phase<true, false>(lds, Fb, H2, KARG(float*, out), nullptr, nullptr, nullptr, KARG(const float*, n2post), nullptr, 0.5f, gw, NGW, tid, nullptr, ctl + CW_DYN + 10240);
#undef IN
#undef SEAM
}

extern "C" void kernel_launch(void* const* d_in, const int* in_sizes, int n_in, void* d_out, int out_size, void* d_ws, size_t ws_size, hipStream_t stream) {
    static int grid = 0;
    if (grid == 0) {
        if (n_in != 19 || in_sizes[0] != M * D || out_size != M * D || ws_size < WS_END) { fprintf(stderr, "kernel_launch: unexpected shapes (n_in %d, in0 %d, out %d, ws %zu < %zu)\n", n_in, n_in > 0 ? in_sizes[0] : -1, out_size, ws_size, (size_t)WS_END); grid = -1; return; }
        int dev = 0, cus = 0, per_cu = 0;
        if (hipGetDevice(&dev) != hipSuccess || hipDeviceGetAttribute(&cus, hipDeviceAttributeMultiprocessorCount, dev) != hipSuccess) { grid = -1; return; }
        if (hipFuncSetAttribute((const void*)mk_fwd, hipFuncAttributeMaxDynamicSharedMemorySize, LDS_BYTES) != hipSuccess) { fprintf(stderr, "kernel_launch: hipFuncSetAttribute failed\n"); grid = -1; return; }
        if (hipOccupancyMaxActiveBlocksPerMultiprocessor(&per_cu, (const void*)mk_fwd, NTHREADS, LDS_BYTES) != hipSuccess || per_cu < 1) { fprintf(stderr, "kernel_launch: occupancy query says %d\n", per_cu); }
        (void)hipGetLastError();
        grid = cus;
    }
    if (grid < 0) return;
    (void)hipMemsetAsync((char*)d_ws + WS_CTL, 0, CTL_ZERO_BYTES, stream);
    Args a{};
    a.x = (const float*)d_in[0]; a.n1pre = (const float*)d_in[1]; a.n1post = (const float*)d_in[2]; a.w1g = (const float*)d_in[3]; a.w1u = (const float*)d_in[4]; a.w1d = (const float*)d_in[5];
    a.nmpre = (const float*)d_in[6]; a.nmpost = (const float*)d_in[7]; a.win = (const float*)d_in[8]; a.poolw = (const float*)d_in[9]; a.poolscale = (const float*)d_in[10];
    a.wab = (const float*)d_in[11]; a.wpb = (const float*)d_in[12]; a.wout = (const float*)d_in[13];
    a.n2pre = (const float*)d_in[14]; a.n2post = (const float*)d_in[15]; a.w2g = (const float*)d_in[16]; a.w2u = (const float*)d_in[17]; a.w2d = (const float*)d_in[18];
    a.out = (float*)d_out; a.ws = (unsigned char*)d_ws;
#if MK_ONE_LAUNCH
    a.ph_lo = 0; a.ph_hi = NPHASE;
    hipLaunchKernelGGL(mk_fwd, dim3(grid), dim3(NTHREADS), LDS_BYTES, stream, a);
#else
    for (int p = 0; p < NPHASE; ++p) { a.ph_lo = p; a.ph_hi = p + 1; hipLaunchKernelGGL(mk_fwd, dim3(grid), dim3(NTHREADS), LDS_BYTES, stream, a); }
#endif
}
```

```cpp
#include <hip/hip_runtime.h>
#include <cstdio>
#include <cstdint>

#ifndef MK_ONE_LAUNCH
#define MK_ONE_LAUNCH 1
#endif

#define LAS __attribute__((address_space(3)))
#define GAS __attribute__((address_space(1)))
typedef unsigned short bf16_t;
typedef short bf16x8 __attribute__((ext_vector_type(8)));
typedef float f32x4 __attribute__((ext_vector_type(4)));
typedef float f32x2 __attribute__((ext_vector_type(2)));
typedef unsigned u32x4 __attribute__((ext_vector_type(4)));
typedef unsigned u32x2 __attribute__((ext_vector_type(2)));
typedef int i32x8 __attribute__((ext_vector_type(8)));
typedef int i32x4 __attribute__((ext_vector_type(4)));
typedef i32x8 i32x8a __attribute__((aligned(16)));

constexpr int BATCH = 4, SEQ = 4096, M = BATCH * SEQ, D = 4096, FF = 11008, NIN = 18432;
constexpr int POOL_OFF = 9216, GA_OFF = 10240, GP_OFF = 14336;
constexpr float RMS_EPS = 1e-6f;
constexpr int NWAVES = 8, NTHREADS = 512;

constexpr size_t MiB = (size_t)1 << 20;
constexpr size_t WS_CTL = 0, CTL_ZERO_BYTES = 1 * MiB;
constexpr size_t WS_WGU1 = 1 * MiB;
constexpr size_t WS_WD1 = 173 * MiB;
constexpr size_t WS_WIN = 259 * MiB;
constexpr size_t WS_WIN8 = WS_WIN + 80 * MiB;
constexpr size_t WS_WOUT = 403 * MiB;
constexpr size_t WS_WBA = 435 * MiB;
constexpr size_t WS_WBP = 443 * MiB;
constexpr size_t WS_WPL = 451 * MiB;
constexpr size_t WS_WGU2 = 452 * MiB;
constexpr size_t WS_WD2 = 624 * MiB;
constexpr size_t WS_XN = 710 * MiB;
constexpr size_t WS_ACT = 838 * MiB;
constexpr size_t WS_F = 1182 * MiB;
constexpr size_t WS_PROJ = 838 * MiB;
constexpr size_t WS_ATTN = 1438 * MiB;
constexpr size_t WS_DELTA = 1470 * MiB;
constexpr size_t WS_POOLED = 1502 * MiB;
constexpr size_t WS_T1 = 1534 * MiB;
constexpr size_t WS_OUTG = WS_XN;
constexpr size_t WS_LSE = WS_XN + 96 * MiB;
constexpr size_t WS_END = 1598 * MiB;
static_assert(WS_PROJ + (size_t)M * NIN * 2 <= WS_ATTN, "proj overlay");
constexpr int CW_BAR = 4096;
constexpr int CW_DYN = 180224;
constexpr int CW_SLAB = 12288;
constexpr int CW_CMAX = 16384;
constexpr int CM_W1G = 0, CM_W1U = FF, CM_W2G = 2 * FF, CM_W2U = 3 * FF, CM_WIN = 4 * FF, CM_W1D = 4 * FF + NIN, CM_W2D = CM_W1D + D;
static_assert((CW_CMAX + 4 * FF + NIN + 2 * D) * 4 <= 512 * 1024, "column maxima below the row-scale arrays");

__device__ __forceinline__ unsigned cvt_pk_bf16(float lo, float hi) { unsigned r; asm volatile("v_cvt_pk_bf16_f32 %0, %1, %2" : "=v"(r) : "v"(lo), "v"(hi)); return r; }
__device__ __forceinline__ float bf_lo(unsigned w) { return __uint_as_float(w << 16); }
__device__ __forceinline__ float bf_hi(unsigned w) { return __uint_as_float(w & 0xffff0000u); }
__device__ __forceinline__ float wave_sum(float v) {
#pragma unroll
    for (int o = 1; o < 64; o <<= 1) v += __shfl_xor(v, o);
    return v;
}
__device__ __forceinline__ unsigned cvt4_fp8(float a, float b, float c, float d) { int w = __builtin_amdgcn_cvt_pk_fp8_f32(a, b, 0, false); w = __builtin_amdgcn_cvt_pk_fp8_f32(c, d, w, true); return (unsigned)w; }
__device__ __forceinline__ unsigned pack4_i8(float a, float b, float c, float d) {
    const float MG = 12582912.0f;
    return __builtin_amdgcn_perm(__float_as_uint(b + MG), __float_as_uint(a + MG), 0x0c0c0400u) | __builtin_amdgcn_perm(__float_as_uint(d + MG), __float_as_uint(c + MG), 0x04000c0cu);
}
__device__ __forceinline__ float lane_xor1(float v) { return __int_as_float(__builtin_amdgcn_update_dpp(0, __float_as_int(v), 0xB1, 0xF, 0xF, true)); }
__device__ __forceinline__ float lane_xor2(float v) { return __int_as_float(__builtin_amdgcn_update_dpp(0, __float_as_int(v), 0x4E, 0xF, 0xF, true)); }
__device__ __forceinline__ float lane_xor4(float v) { return __int_as_float(__builtin_amdgcn_ds_swizzle(__float_as_int(v), 0x101F)); }
__device__ __forceinline__ float wave_max(float v) {
#pragma unroll
    for (int o = 1; o < 64; o <<= 1) v = fmaxf(v, __shfl_xor(v, o));
    return v;
}
__device__ __forceinline__ float fast_sigmoid(float x) { return __builtin_amdgcn_rcpf(1.0f + __builtin_amdgcn_exp2f(-1.4426950408889634f * x)); }

#define XB_TMO      128
#define XB_XCNT(j)  (256  + 64 * (j))
#define XB_XSUB(j)  (1280 + 64 * (j))
#define XB_XGEN(j)  (2304 + 64 * (j))
#define XB_TOP      3328
#define XB_TOPGEN   3392
#define XCD_BAR_WORDS 3456
#define XB_SPIN_CAP (1u << 18)

__device__ __forceinline__ unsigned xb_ld(unsigned* p)              { return __hip_atomic_load(p, __ATOMIC_RELAXED, __HIP_MEMORY_SCOPE_AGENT); }
__device__ __forceinline__ unsigned xb_add(unsigned* p, unsigned v) { return __hip_atomic_fetch_add(p, v, __ATOMIC_RELAXED, __HIP_MEMORY_SCOPE_AGENT); }
__device__ __forceinline__ unsigned xb_xcc_id() { return (unsigned)__builtin_amdgcn_s_getreg((3 << 11) | 20) & 0xFu; }
#define XB_SPIN(cond, bar) do { unsigned _sp = 0; while (cond) { __builtin_amdgcn_s_sleep(1); \
    if ((++_sp & 255u) == 0u) { if (xb_ld(&(bar)[XB_TMO])) break; if (_sp > XB_SPIN_CAP) { atomicAdd(&(bar)[XB_TMO], 1u); break; } } } } while (0)

struct XcdBarrier { unsigned* bar; unsigned x; volatile LAS unsigned* st; };

__device__ __forceinline__ XcdBarrier xcd_barrier_post(unsigned* bar, volatile LAS unsigned* st) {
    XcdBarrier b; b.bar = bar; b.x = xb_xcc_id(); b.st = st;
    if (threadIdx.x == 0) (void)xb_add(&bar[XB_XCNT(b.x)], 1u);
    return b;
}
__device__ __forceinline__ void xcd_barrier_complete(unsigned* bar, unsigned x, unsigned& nloc, unsigned& nx) {
    const unsigned G = gridDim.x * gridDim.y * gridDim.z;
    unsigned sum, cnt, mine, sp = 0u;
    for (;;) {
        sum = 0u; cnt = 0u; mine = 0u;
#pragma unroll
        for (unsigned j = 0; j < 16; ++j) { const unsigned c = xb_ld(&bar[XB_XCNT(j)]); sum += c; cnt += (c > 0u) ? 1u : 0u; mine = (j == x) ? c : mine; }
        if (sum == G) break;
        __builtin_amdgcn_s_sleep(1);
        if ((++sp & 255u) == 0u) { if (xb_ld(&bar[XB_TMO])) break; if (sp > XB_SPIN_CAP) { atomicAdd(&bar[XB_TMO], 1u); break; } }
    }
    nloc = mine > 0u ? mine : 1u; nx = cnt > 0u ? cnt : 1u;
}
__device__ __forceinline__ void xcd_barrier(const XcdBarrier& b) {
    asm volatile("s_waitcnt vmcnt(0)" ::: "memory");
    __syncthreads();
    if (threadIdx.x == 0) {
        unsigned* bar = b.bar;
        __builtin_amdgcn_s_waitcnt(0);
        unsigned nloc = b.st[0], nx = b.st[1];
        if (nloc == 0u) { xcd_barrier_complete(bar, b.x, nloc, nx); b.st[0] = nloc; b.st[1] = nx; }
        const unsigned old = xb_add(&bar[XB_XSUB(b.x)], 1u);
        const unsigned gen = old / nloc;
        if (old + 1u == (gen + 1u) * nloc) {
            __builtin_amdgcn_fence(__ATOMIC_RELEASE, "agent");
            asm volatile("s_waitcnt vmcnt(0)" ::: "memory");
            const unsigned og = xb_add(&bar[XB_TOP], 1u);
            const unsigned tg = og / nx;
            if (og + 1u == (tg + 1u) * nx) xb_add(&bar[XB_TOPGEN], 1u);
            else XB_SPIN(xb_ld(&bar[XB_TOPGEN]) == tg, bar);
            __builtin_amdgcn_fence(__ATOMIC_ACQUIRE, "agent");
            xb_add(&bar[XB_XGEN(b.x)], 1u);
            asm volatile("s_waitcnt vmcnt(0)" ::: "memory");
        } else {
            XB_SPIN(xb_ld(&bar[XB_XGEN(b.x)]) == gen, bar);
            __builtin_amdgcn_fence(__ATOMIC_ACQUIRE, "agent");
            asm volatile("s_waitcnt vmcnt(0)" ::: "memory");
        }
    }
    __syncthreads();
}

namespace pg8 {
constexpr int BM = 256, BK = 64, HALF = 128, HTB = HALF * BK * 2, STAGE_BYTES = 8 * HTB, NXCD = 8, WGM = 8;
__host__ __device__ __forceinline__ int lds_byte(int r, int c) { const int st = (r >> 4) * 2 + (c >> 5), rr = r & 15, cc = c & 31, ob = rr * 64 + cc * 2; return st * 1024 + (ob ^ (((ob >> 9) & 1) << 5)); }
__host__ __device__ __forceinline__ void stage_rc(int b, int& R, int& C) { const int st = b / 1024, sb = b % 1024, swz = sb ^ (((sb >> 9) & 1) << 5); R = (st >> 1) * 16 + swz / 64; C = (st & 1) * 32 + (swz % 64) / 2; }
__host__ __device__ __forceinline__ int perm32(int rho) { const int n = rho >> 4, i = rho & 15; return 8 * (i >> 2) + 4 * n + (i & 3); }

struct Unit { int pm, pn, sub; };
struct TileOrder {
    int nM, nN, nwg, G, c, wgm;
    __device__ __forceinline__ void init(int Mr, int Nc, int G_, int c_, int wgm_ = WGM) { nM = Mr / BM; nN = Nc / BM; nwg = nM * nN; G = G_; c = c_; wgm = wgm_; }
    __device__ __forceinline__ bool at(long L, int& pm, int& pn) const {
        if (L >= nwg) return false;
        int wgid = (int)L; { const int q = nwg / NXCD, r = nwg % NXCD, xcd = wgid % NXCD, off = wgid / NXCD; wgid = (xcd < r ? xcd * (q + 1) : r * (q + 1) + (xcd - r) * q) + off; }
        const int nig = wgm * nN, gid = wgid / nig, fm = gid * wgm, gsz = (nM - fm) < wgm ? (nM - fm) : wgm;
        pm = fm + ((wgid % nig) % gsz); pn = (wgid % nig) / gsz; return true;
    }
};
struct PlainSched {
    TileOrder T; const char* A; const char* B; size_t tstep;
    __device__ __forceinline__ bool next(int i, Unit& u) const { u.sub = 0; return T.at((long)i * T.G + T.c, u.pm, u.pn); }
    __device__ __forceinline__ const char* aptr(const Unit& u) const { return A + (size_t)u.pm * tstep; }
    __device__ __forceinline__ const char* bptr(const Unit& u) const { return B + (size_t)u.pn * tstep; }
};
struct BranchSched {
    TileOrder T; const char* A0; const char* B0; const char* A1; const char* B1; size_t tstep;
    __device__ __forceinline__ bool next(int i, Unit& u) const { u.sub = i & 1; return T.at((long)(i >> 1) * T.G + T.c, u.pm, u.pn); }
    __device__ __forceinline__ const char* aptr(const Unit& u) const { return (u.sub ? A1 : A0) + (size_t)u.pm * tstep; }
    __device__ __forceinline__ const char* bptr(const Unit& u) const { return (u.sub ? B1 : B0) + (size_t)u.pn * tstep; }
};
struct PoolSched {
    TileOrder T; const char* A; const char* B; size_t tstep, gstride;
    __device__ __forceinline__ bool next(int i, Unit& u) const { u.sub = 0; return T.at((long)i * T.G + T.c, u.pm, u.pn); }
    __device__ __forceinline__ const char* aptr(const Unit& u) const { return A + (size_t)u.pn * gstride + (size_t)u.pm * tstep; }
    __device__ __forceinline__ const char* bptr(const Unit& u) const { return B + (size_t)u.pn * tstep; }
};

struct EpiSwiGLU {
    static constexpr bool PERM = true, KEEP_SUB0 = false;
    bf16_t* O; int ldc;
    __device__ __forceinline__ void operator()(const f32x4 (&acc)[2][2][4][2], const Unit& u, int wr, int wc, int fr, int fq) const {
        const int row0 = u.pm * BM + wr * 64 + fr, col0 = u.pn * HALF + wc * 32 + 8 * fq;
#pragma unroll
        for (int ai = 0; ai < 2; ++ai)
#pragma unroll
            for (int m = 0; m < 4; ++m) { bf16_t* rowp = O + (size_t)(row0 + ai * HALF + m * 16) * ldc + col0;
                float o[8];
#pragma unroll
                for (int n = 0; n < 2; ++n)
#pragma unroll
                    for (int j = 0; j < 4; ++j) { const float g = acc[ai][0][m][n][j], uu = acc[ai][1][m][n][j]; o[n * 4 + j] = g * fast_sigmoid(g) * uu; }
                u32x4 w; w.x = cvt_pk_bf16(o[0], o[1]); w.y = cvt_pk_bf16(o[2], o[3]); w.z = cvt_pk_bf16(o[4], o[5]); w.w = cvt_pk_bf16(o[6], o[7]);
                *(u32x4*)rowp = w; }
    }
};
struct EpiBf16 {
    static constexpr bool PERM = true, KEEP_SUB0 = false;
    bf16_t* O; int ldc; float osc;
    __device__ __forceinline__ void operator()(const f32x4 (&acc)[2][2][4][2], const Unit& u, int wr, int wc, int fr, int fq) const {
        const int row0 = u.pm * BM + wr * 64 + fr, col0 = u.pn * BM + wc * 32 + 8 * fq;
#pragma unroll
        for (int ai = 0; ai < 2; ++ai)
#pragma unroll
            for (int m = 0; m < 4; ++m) { bf16_t* rowp = O + (size_t)(row0 + ai * HALF + m * 16) * ldc + col0;
#pragma unroll
                for (int bj = 0; bj < 2; ++bj) { const f32x4 v0 = acc[ai][bj][m][0] * osc, v1 = acc[ai][bj][m][1] * osc;
                    u32x4 w; w.x = cvt_pk_bf16(v0[0], v0[1]); w.y = cvt_pk_bf16(v0[2], v0[3]); w.z = cvt_pk_bf16(v1[0], v1[1]); w.w = cvt_pk_bf16(v1[2], v1[3]);
                    *(u32x4*)(rowp + bj * HALF) = w; } }
    }
};
struct EpiSwiGLU8 {
    static constexpr bool PERM = true, KEEP_SUB0 = false;
    unsigned char* O; int ldc;
    __device__ __forceinline__ void operator()(const f32x4 (&acc)[2][2][4][2], const Unit& u, int wr, int wc, int fr, int fq) const {
        const int row0 = u.pm * BM + wr * 64 + fr, col0 = u.pn * HALF + wc * 32 + 8 * fq;
#pragma unroll
        for (int ai = 0; ai < 2; ++ai)
#pragma unroll
            for (int m = 0; m < 4; ++m) { unsigned char* rowp = O + (size_t)(row0 + ai * HALF + m * 16) * ldc + col0;
                float o[8];
#pragma unroll
                for (int n = 0; n < 2; ++n)
#pragma unroll
                    for (int j = 0; j < 4; ++j) { const float g = acc[ai][0][m][n][j], uu = acc[ai][1][m][n][j]; o[n * 4 + j] = g * fast_sigmoid(g) * uu; }
                u32x2 w; w.x = cvt4_fp8(o[0], o[1], o[2], o[3]); w.y = cvt4_fp8(o[4], o[5], o[6], o[7]);
                *(u32x2*)rowp = w; }
    }
};
template <int OUT> struct EpiSwiGLUI8 {
    static constexpr bool PERM = true, KEEP_SUB0 = false;
    bf16_t* O16; unsigned char* O8; int ldc; const float* rs; const float* cg; const float* cu;
    __device__ __forceinline__ void operator()(const f32x4 (&acc)[2][2][4][2], const Unit& u, int wr, int wc, int fr, int fq) const {
        const int row0 = u.pm * BM + wr * 64 + fr, col0 = u.pn * HALF + wc * 32 + 8 * fq;
        f32x4 sg[2], su[2];
#pragma unroll
        for (int n = 0; n < 2; ++n) { sg[n] = *(const f32x4*)(cg + col0 + 4 * n) * (1.0f / 127.f); su[n] = *(const f32x4*)(cu + col0 + 4 * n) * (1.0f / 127.f); }
#pragma unroll
        for (int ai = 0; ai < 2; ++ai)
#pragma unroll
            for (int m = 0; m < 4; ++m) { const int row = row0 + ai * HALF + m * 16; const float r = rs[row];
                float o[8];
#pragma unroll
                for (int n = 0; n < 2; ++n)
#pragma unroll
                    for (int j = 0; j < 4; ++j) { const float g = (float)__float_as_int(acc[ai][0][m][n][j]) * (r * sg[n][j]), uu = (float)__float_as_int(acc[ai][1][m][n][j]) * (r * su[n][j]); o[n * 4 + j] = g * fast_sigmoid(g) * uu; }
                if constexpr (OUT != 0) { u32x2 w; w.x = cvt4_fp8(o[0], o[1], o[2], o[3]); w.y = cvt4_fp8(o[4], o[5], o[6], o[7]); *(u32x2*)(O8 + (size_t)row * ldc + col0) = w; }
                if constexpr (OUT != 1) { u32x4 w; w.x = cvt_pk_bf16(o[0], o[1]); w.y = cvt_pk_bf16(o[2], o[3]); w.z = cvt_pk_bf16(o[4], o[5]); w.w = cvt_pk_bf16(o[6], o[7]); *(u32x4*)(O16 + (size_t)row * ldc + col0) = w; } }
    }
};
struct EpiBf16SigI8 {
    static constexpr bool PERM = true, KEEP_SUB0 = false;
    bf16_t* O; int ldc; int sig_from; const float* rs; const float* cm; float cs;
    __device__ __forceinline__ void operator()(const f32x4 (&acc)[2][2][4][2], const Unit& u, int wr, int wc, int fr, int fq) const {
        const int row0 = u.pm * BM + wr * 64 + fr, col0 = u.pn * BM + wc * 32 + 8 * fq; const bool sg = u.pn >= sig_from;
#pragma unroll
        for (int bj = 0; bj < 2; ++bj) { f32x4 sw[2];
#pragma unroll
            for (int n = 0; n < 2; ++n) sw[n] = *(const f32x4*)(cm + col0 + bj * HALF + 4 * n) * cs;
#pragma unroll
            for (int ai = 0; ai < 2; ++ai)
#pragma unroll
                for (int m = 0; m < 4; ++m) { const int row = row0 + ai * HALF + m * 16; const float r = rs[row]; bf16_t* rowp = O + (size_t)row * ldc + col0; float v[8];
#pragma unroll
                    for (int n = 0; n < 2; ++n)
#pragma unroll
                        for (int j = 0; j < 4; ++j) { float x = (float)__float_as_int(acc[ai][bj][m][n][j]) * (r * sw[n][j]); v[n * 4 + j] = sg ? fast_sigmoid(x) : x; }
                    u32x4 w; w.x = cvt_pk_bf16(v[0], v[1]); w.y = cvt_pk_bf16(v[2], v[3]); w.z = cvt_pk_bf16(v[4], v[5]); w.w = cvt_pk_bf16(v[6], v[7]);
                    *(u32x4*)(rowp + bj * HALF) = w; } }
    }
};
struct EpiBf16Sig {
    static constexpr bool PERM = true, KEEP_SUB0 = false;
    bf16_t* O; int ldc; int sig_from; float osc;
    __device__ __forceinline__ void operator()(const f32x4 (&acc)[2][2][4][2], const Unit& u, int wr, int wc, int fr, int fq) const {
        const int row0 = u.pm * BM + wr * 64 + fr, col0 = u.pn * BM + wc * 32 + 8 * fq; const bool sg = u.pn >= sig_from;
#pragma unroll
        for (int ai = 0; ai < 2; ++ai)
#pragma unroll
            for (int m = 0; m < 4; ++m) { bf16_t* rowp = O + (size_t)(row0 + ai * HALF + m * 16) * ldc + col0;
#pragma unroll
                for (int bj = 0; bj < 2; ++bj) { f32x4 v0 = acc[ai][bj][m][0] * osc, v1 = acc[ai][bj][m][1] * osc;
                    if (sg) {
#pragma unroll
                        for (int j = 0; j < 4; ++j) { v0[j] = fast_sigmoid(v0[j]); v1[j] = fast_sigmoid(v1[j]); } }
                    u32x4 w; w.x = cvt_pk_bf16(v0[0], v0[1]); w.y = cvt_pk_bf16(v0[2], v0[3]); w.z = cvt_pk_bf16(v1[0], v1[1]); w.w = cvt_pk_bf16(v1[2], v1[3]);
                    *(u32x4*)(rowp + bj * HALF) = w; } }
    }
};
struct EpiBf16Row {
    static constexpr bool PERM = true, KEEP_SUB0 = false;
    bf16_t* O; int ldc; const float* rowscale;
    __device__ __forceinline__ void operator()(const f32x4 (&acc)[2][2][4][2], const Unit& u, int wr, int wc, int fr, int fq) const {
        const int row0 = u.pm * BM + wr * 64 + fr, col0 = u.pn * BM + wc * 32 + 8 * fq;
#pragma unroll
        for (int ai = 0; ai < 2; ++ai)
#pragma unroll
            for (int m = 0; m < 4; ++m) { const int row = row0 + ai * HALF + m * 16; const float r = rowscale[row]; bf16_t* rowp = O + (size_t)row * ldc + col0;
#pragma unroll
                for (int bj = 0; bj < 2; ++bj) { const f32x4 v0 = acc[ai][bj][m][0] * r, v1 = acc[ai][bj][m][1] * r;
                    u32x4 w; w.x = cvt_pk_bf16(v0[0], v0[1]); w.y = cvt_pk_bf16(v0[2], v0[3]); w.z = cvt_pk_bf16(v1[0], v1[1]); w.w = cvt_pk_bf16(v1[2], v1[3]);
                    *(u32x4*)(rowp + bj * HALF) = w; } }
    }
};
struct EpiPool {
    static constexpr bool PERM = true, KEEP_SUB0 = false;
    bf16_t* O; int ldc; const float* scale;
    __device__ __forceinline__ void operator()(const f32x4 (&acc)[2][2][4][2], const Unit& u, int, int, int, int) const {
        int tz = threadIdx.x; asm volatile("" : "+v"(tz));
        const int wid = tz >> 6, lane = tz & 63, wr = wid >> 2, wc = wid & 3, fr = lane & 15, fq = lane >> 4;
        const int row0 = u.pm * BM + wr * 64 + fr, col0 = u.pn * BM + wc * 32 + 8 * fq;
#pragma unroll
        for (int bj = 0; bj < 2; ++bj) { const f32x4 sv0 = *(const f32x4*)(scale + col0 + bj * HALF), sv1 = *(const f32x4*)(scale + col0 + bj * HALF + 4);
#pragma unroll
            for (int ai = 0; ai < 2; ++ai)
#pragma unroll
                for (int m = 0; m < 4; ++m) { bf16_t* rowp = O + (size_t)(row0 + ai * HALF + m * 16) * ldc + col0;
                    const f32x4 v0 = acc[ai][bj][m][0] * sv0, v1 = acc[ai][bj][m][1] * sv1;
                    u32x4 w; w.x = cvt_pk_bf16(v0[0], v0[1]); w.y = cvt_pk_bf16(v0[2], v0[3]); w.z = cvt_pk_bf16(v1[0], v1[1]); w.w = cvt_pk_bf16(v1[2], v1[3]);
                    *(u32x4*)(rowp + bj * HALF) = w; } }
    }
};
struct EpiBranch {
    static constexpr bool PERM = true, KEEP_SUB0 = true;
    bf16_t* O; int ldc; const bf16_t* proj;
    __device__ __forceinline__ void operator()(f32x4 (&acc)[2][2][4][2], const Unit& u, int, int, int, int) const {
        int tz = threadIdx.x; asm volatile("" : "+v"(tz));
        const int wid = tz >> 6, lane = tz & 63, wr = wid >> 2, wc = wid & 3, fr = lane & 15, fq = lane >> 4;
        const int row0 = u.pm * BM + wr * 64 + fr, col0 = u.pn * BM + wc * 32 + 8 * fq;
        if (u.sub == 0) {
#pragma unroll
            for (int ai = 0; ai < 2; ++ai)
#pragma unroll
                for (int mh = 0; mh < 2; ++mh) {
                    u32x4 ga[2][2], gp[2][2];
#pragma unroll
                    for (int mm = 0; mm < 2; ++mm)
#pragma unroll
                        for (int bj = 0; bj < 2; ++bj) { const bf16_t* gpt = proj + (size_t)(row0 + ai * HALF + (2 * mh + mm) * 16) * NIN + col0 + bj * HALF;
                            ga[mm][bj] = *(const u32x4*)(gpt + GA_OFF); gp[mm][bj] = *(const u32x4*)(gpt + GP_OFF); }
#pragma unroll
                    for (int mm = 0; mm < 2; ++mm)
#pragma unroll
                        for (int bj = 0; bj < 2; ++bj) { const int m = 2 * mh + mm;
#pragma unroll
                            for (int k = 0; k < 4; ++k) { const unsigned aw = ga[mm][bj][k], pw = gp[mm][bj][k];
                                const float r0 = bf_lo(aw) * __builtin_amdgcn_rcpf(fmaxf(bf_lo(pw), 1e-6f)), r1 = bf_hi(aw) * __builtin_amdgcn_rcpf(fmaxf(bf_hi(pw), 1e-6f));
                                acc[ai][bj][m][k >> 1][2 * (k & 1)] *= r0; acc[ai][bj][m][k >> 1][2 * (k & 1) + 1] *= r1; } }
                    asm volatile("" ::: "memory"); }
        } else {
#pragma unroll
            for (int ai = 0; ai < 2; ++ai) {
                u32x4 gp[4][2];
#pragma unroll
                for (int m = 0; m < 4; ++m)
#pragma unroll
                    for (int bj = 0; bj < 2; ++bj) gp[m][bj] = *(const u32x4*)(proj + (size_t)(row0 + ai * HALF + m * 16) * NIN + GP_OFF + col0 + bj * HALF);
#pragma unroll
                for (int m = 0; m < 4; ++m)
#pragma unroll
                    for (int bj = 0; bj < 2; ++bj) { u32x4 w;
#pragma unroll
                        for (int k = 0; k < 4; ++k) { const unsigned pw = gp[m][bj][k];
                            w[k] = cvt_pk_bf16(acc[ai][bj][m][k >> 1][2 * (k & 1)] * fmaxf(bf_lo(pw), 1e-6f), acc[ai][bj][m][k >> 1][2 * (k & 1) + 1] * fmaxf(bf_hi(pw), 1e-6f)); }
                        *(u32x4*)(O + (size_t)(row0 + ai * HALF + m * 16) * ldc + col0 + bj * HALF) = w; }
                asm volatile("" ::: "memory"); }
        }
    }
};

template <class Epi, class Sched, bool ALIGN_EPI, bool SP2, int PREC = 0>
__device__ __forceinline__ void gemm_phase(LAS unsigned char* lds, const int K, const Sched& S, const Epi& E) {
    constexpr bool FP8 = (PREC == 1), INT8 = (PREC == 2);
    int tid = threadIdx.x; asm volatile("" : "+v"(tid));
    const int wid = __builtin_amdgcn_readfirstlane(tid >> 6), lane = tid & 63, wr = wid >> 2, wc = wid & 3, fr = lane & 15, fq = lane >> 4;
    const int nt = K / BK;
    unsigned voffA[2], voffB[2];
#pragma unroll
    for (int i = 0; i < 2; ++i) { int R, C; stage_rc(tid * 16 + i * 8192, R, C);
        voffA[i] = (unsigned)(R * K + C) * 2u; voffB[i] = (unsigned)(tid * 16 + i * 8192); }
    const size_t kstep = (size_t)(BK * 2), kstepB = (size_t)HTB;
    const size_t hstep = (size_t)HALF * K * 2;
    const unsigned ldsw = (unsigned)wid * 1024u;
    const int aoff = FP8 ? lds_byte(wr * 64 + fr, fq * 16) : lds_byte(wr * 64 + fr, fq * 8), boff = FP8 ? lds_byte(wc * 32 + fr, fq * 16) : lds_byte(wc * 32 + fr, fq * 8);
    constexpr int KOFF = FP8 ? 16 : 1024;
#define PG8_SA(b, h) (((b) * 2 + (h)) * HTB)
#define PG8_SB(b, h) ((4 + (b) * 2 + (h)) * HTB)
#define PG8_STAGE(bufoff, gbase, voff) do { _Pragma("unroll") for (int _i = 0; _i < 2; ++_i) \
        __builtin_amdgcn_global_load_lds((const unsigned*)((const char*)(gbase) + (voff)[_i]), (LAS unsigned*)(lds + (bufoff) + ldsw + _i * 8192), 16, 0, 0); } while (0)
#define PG8_LD32(p) __builtin_shufflevector(*(const LAS i32x4*)(p), *(const LAS i32x4*)((p) + 16), 0, 1, 2, 3, 4, 5, 6, 7)
#define PG8_LDA(dst, b, h) do { if constexpr (FP8) { _Pragma("unroll") for (int m = 0; m < 4; ++m) dst##8[m] = PG8_LD32(lds + PG8_SA(b, h) + aoff + m * 2048); } \
        else { _Pragma("unroll") for (int m = 0; m < 4; ++m) _Pragma("unroll") for (int k = 0; k < 2; ++k) dst[m][k] = *(const LAS bf16x8*)(lds + PG8_SA(b, h) + aoff + m * 2048 + k * KOFF); } } while (0)
#define PG8_LDB(dst, b, h) do { if constexpr (FP8) { _Pragma("unroll") for (int n = 0; n < 2; ++n) dst##8[n] = PG8_LD32(lds + PG8_SB(b, h) + boff + n * 2048); } \
        else { _Pragma("unroll") for (int n = 0; n < 2; ++n) _Pragma("unroll") for (int k = 0; k < 2; ++k) dst[n][k] = *(const LAS bf16x8*)(lds + PG8_SB(b, h) + boff + n * 2048 + k * KOFF); } } while (0)
#define PG8_MMA(ai, bj, At, Bt) do { __builtin_amdgcn_s_setprio(1); _Pragma("unroll") for (int m = 0; m < 4; ++m) _Pragma("unroll") for (int n = 0; n < 2; ++n) { \
        if constexpr (FP8) asm volatile("v_mfma_scale_f32_16x16x128_f8f6f4 %0, %1, %2, %0, %3, %3 op_sel_hi:[0,0,0]" : "+v"(acc[ai][bj][m][n]) : "v"(Bt##8[n]), "v"(At##8[m]), "v"(one8));   \
        else if constexpr (INT8) { _Pragma("unroll") for (int k = 0; k < 2; ++k) acc[ai][bj][m][n] = __builtin_bit_cast(f32x4, __builtin_amdgcn_mfma_i32_16x16x64_i8(__builtin_bit_cast(i32x4, Bt[n][k]), __builtin_bit_cast(i32x4, At[m][k]), __builtin_bit_cast(i32x4, acc[ai][bj][m][n]), 0, 0, 0)); } \
        else { _Pragma("unroll") for (int k = 0; k < 2; ++k) acc[ai][bj][m][n] = __builtin_amdgcn_mfma_f32_16x16x32_bf16(Bt[n][k], At[m][k], acc[ai][bj][m][n], 0, 0, 0); } } \
        __builtin_amdgcn_s_setprio(0); } while (0)
#define PG8_WAIT_V(n) asm volatile("s_waitcnt vmcnt(" #n ")" ::: "memory")
#define PG8_WAIT_L(n) asm volatile("s_waitcnt lgkmcnt(" #n ")" ::: "memory")
#define PG8_BAR __builtin_amdgcn_s_barrier()
#define PG8_SCHED __builtin_amdgcn_sched_barrier(0)
    Unit cur, nxt; int ui = 0;
    if (!S.next(0, cur)) return;
    f32x4 acc[2][2][4][2];
#pragma unroll
    for (int a = 0; a < 2; ++a)
#pragma unroll
        for (int b = 0; b < 2; ++b)
#pragma unroll
            for (int m = 0; m < 4; ++m)
#pragma unroll
                for (int n = 0; n < 2; ++n) acc[a][b][m][n] = (f32x4){0.f, 0.f, 0.f, 0.f};
    const int one8 = 0x7F7F7F7F;
    bf16x8 At[4][2], B0[2][2], B1[2][2];
    i32x8 At8[4], B08[2], B18[2];
    const char* cA = S.aptr(cur); const char* cB = S.bptr(cur);
    if constexpr (SP2) {
        PG8_STAGE(PG8_SB(0, 0), cB, voffB); PG8_STAGE(PG8_SB(0, 1), cB + hstep, voffB); PG8_STAGE(PG8_SA(0, 0), cA, voffA); PG8_STAGE(PG8_SA(0, 1), cA + hstep, voffA);
        if (wr == 1) PG8_BAR;
        PG8_WAIT_V(2); PG8_BAR;
        PG8_STAGE(PG8_SB(1, 0), cB + kstepB, voffB); PG8_STAGE(PG8_SA(1, 0), cA + kstep, voffA); PG8_STAGE(PG8_SB(1, 1), cB + hstep + kstepB, voffB);
        PG8_WAIT_V(6); PG8_BAR;
    } else {
        PG8_STAGE(PG8_SB(0, 0), cB, voffB); PG8_STAGE(PG8_SA(0, 0), cA, voffA); PG8_STAGE(PG8_SB(0, 1), cB + hstep, voffB); PG8_STAGE(PG8_SA(0, 1), cA + hstep, voffA);
        if (wr == 1) PG8_BAR;
        PG8_WAIT_V(4); PG8_BAR;
        PG8_STAGE(PG8_SB(1, 0), cB + kstepB, voffB); PG8_STAGE(PG8_SA(1, 0), cA + kstep, voffA); PG8_STAGE(PG8_SB(1, 1), cB + hstep + kstepB, voffB);
        PG8_WAIT_V(6); PG8_BAR;
    }
    for (;;) {
        const bool has_next = S.next(ui + 1, nxt);
        const char* nA = has_next ? S.aptr(nxt) : cA; const char* nB = has_next ? S.bptr(nxt) : cB;
#pragma unroll 1
        for (int t = 0; t < nt; t += 2) {
            const bool last = (t == nt - 2);
            const char* a1 = cA + (size_t)(t + 1) * kstep;
            const char* a2 = last ? nA : cA + (size_t)(t + 2) * kstep; const char* b2 = last ? nB : cB + (size_t)(t + 2) * kstepB;
            const char* a3 = a2 + kstep; const char* b3 = b2 + kstepB;
            if constexpr (SP2) {
            PG8_LDB(B0, 0, 0); PG8_LDB(B1, 0, 1); PG8_SCHED; PG8_LDA(At, 0, 0); PG8_STAGE(PG8_SA(1, 1), a1 + hstep, voffA);
            PG8_WAIT_V(8); PG8_WAIT_L(0); PG8_BAR; PG8_MMA(0, 0, At, B0); PG8_MMA(0, 1, At, B1); PG8_BAR; PG8_SCHED;
            PG8_LDA(At, 0, 1); PG8_STAGE(PG8_SB(0, 0), b2, voffB); PG8_STAGE(PG8_SB(0, 1), b2 + hstep, voffB); PG8_STAGE(PG8_SA(0, 0), a2, voffA);
            PG8_WAIT_V(8); PG8_WAIT_L(0); PG8_BAR; PG8_MMA(1, 0, At, B0); PG8_MMA(1, 1, At, B1); PG8_BAR; PG8_SCHED;
            PG8_LDB(B0, 1, 0); PG8_LDB(B1, 1, 1); PG8_SCHED; PG8_LDA(At, 1, 0); PG8_STAGE(PG8_SA(0, 1), a2 + hstep, voffA);
            PG8_WAIT_V(8); PG8_WAIT_L(0); PG8_BAR; PG8_MMA(0, 0, At, B0); PG8_MMA(0, 1, At, B1); PG8_BAR; PG8_SCHED;
            PG8_LDA(At, 1, 1); PG8_STAGE(PG8_SB(1, 0), b3, voffB); PG8_STAGE(PG8_SB(1, 1), b3 + hstep, voffB); PG8_STAGE(PG8_SA(1, 0), a3, voffA);
            PG8_WAIT_V(8); PG8_WAIT_L(0); PG8_BAR; PG8_MMA(1, 0, At, B0); PG8_MMA(1, 1, At, B1); PG8_BAR; PG8_SCHED;
            } else {
            PG8_LDB(B0, 0, 0); PG8_SCHED; PG8_LDA(At, 0, 0); PG8_STAGE(PG8_SA(1, 1), a1 + hstep, voffA);
            PG8_WAIT_L(8); PG8_BAR; PG8_WAIT_L(0); PG8_MMA(0, 0, At, B0); PG8_BAR; PG8_SCHED;
            PG8_LDB(B1, 0, 1); PG8_STAGE(PG8_SB(0, 0), b2, voffB);
            PG8_BAR; PG8_WAIT_L(0); PG8_MMA(0, 1, At, B1); PG8_BAR;
            PG8_LDA(At, 0, 1); PG8_STAGE(PG8_SA(0, 0), a2, voffA);
            PG8_BAR; PG8_WAIT_L(0); PG8_MMA(1, 0, At, B0); PG8_BAR; PG8_SCHED;
            PG8_STAGE(PG8_SB(0, 1), b2 + hstep, voffB);
            PG8_WAIT_V(6); PG8_BAR; PG8_MMA(1, 1, At, B1); PG8_BAR;
            PG8_LDB(B0, 1, 0); PG8_SCHED; PG8_LDA(At, 1, 0); PG8_STAGE(PG8_SA(0, 1), a2 + hstep, voffA);
            PG8_WAIT_L(8); PG8_BAR; PG8_WAIT_L(0); PG8_MMA(0, 0, At, B0); PG8_BAR; PG8_SCHED;
            PG8_LDB(B1, 1, 1); PG8_STAGE(PG8_SB(1, 0), b3, voffB);
            PG8_BAR; PG8_WAIT_L(0); PG8_MMA(0, 1, At, B1); PG8_BAR;
            PG8_LDA(At, 1, 1); PG8_STAGE(PG8_SA(1, 0), a3, voffA);
            PG8_BAR; PG8_WAIT_L(0); PG8_MMA(1, 0, At, B0); PG8_BAR; PG8_SCHED;
            PG8_STAGE(PG8_SB(1, 1), b3 + hstep, voffB);
            PG8_WAIT_V(6); PG8_BAR; PG8_MMA(1, 1, At, B1); PG8_BAR;
            }
        }
        if constexpr (ALIGN_EPI) { if (wr == 0) PG8_BAR; }
        if constexpr (FP8) asm volatile("s_nop 15\n\ts_nop 15" ::: "memory");
        E(acc, cur, wr, wc, fr, fq);
        if (!has_next) break;
        if (!(Epi::KEEP_SUB0 && cur.sub == 0)) {
#pragma unroll
        for (int a = 0; a < 2; ++a)
#pragma unroll
            for (int b = 0; b < 2; ++b)
#pragma unroll
                for (int m = 0; m < 4; ++m)
#pragma unroll
                    for (int n = 0; n < 2; ++n) acc[a][b][m][n] = (f32x4){0.f, 0.f, 0.f, 0.f}; }
        cur = nxt; cA = nA; cB = nB; ++ui;
        if constexpr (ALIGN_EPI) { if (wr == 1) PG8_BAR; }
    }
    PG8_WAIT_V(0);
    if constexpr (!ALIGN_EPI) { if (wr == 0) PG8_BAR; }
    PG8_BAR;
#undef PG8_SA
#undef PG8_SB
#undef PG8_STAGE
#undef PG8_LDA
#undef PG8_LD32
#undef PG8_LDB
#undef PG8_MMA
#undef PG8_WAIT_V
#undef PG8_WAIT_L
#undef PG8_BAR
#undef PG8_SCHED
}
}

#ifndef I8_GU1
#define I8_GU1 1
#endif
#ifndef I8_GU2
#define I8_GU2 1
#endif
#ifndef I8_IN
#define I8_IN 1
#endif
#ifndef I8_D1
#define I8_D1 1
#endif
#ifndef I8_D2
#define I8_D2 1
#endif
#ifndef F8_D2N
#define F8_D2N (I8_D2 ? 0 : 8)
#endif
#define F8_D2 (F8_D2N == 16)
#ifndef POOL_FROM_H
#define POOL_FROM_H 1
#endif
#ifndef I8_POOL
#define I8_POOL 0
#endif
#ifndef W_IN_P0_SLABS
#define W_IN_P0_SLABS ((I8_POOL ? GA_OFF : POOL_OFF) / 32)
#endif
#ifndef WGM_G
#define WGM_G 8
#endif
#ifndef WGM_D
#define WGM_D 4
#endif
#ifndef PG8_SP2
#define PG8_SP2 true
#endif
#ifndef PG8_ALIGN
#define PG8_ALIGN true
#endif

constexpr int RING_BYTES = 131072;
constexpr int LDS_BYTES = 147456;
constexpr int MISC_OFF = LDS_BYTES - 256;

struct Args {
    const float* x; const float* n1pre; const float* n1post; const float* w1g; const float* w1u; const float* w1d;
    const float* nmpre; const float* nmpost; const float* win; const float* poolw; const float* poolscale; const float* wab; const float* wpb; const float* wout;
    const float* n2pre; const float* n2post; const float* w2g; const float* w2u; const float* w2d;
    float* out; unsigned char* ws; int ph_lo, ph_hi;
};


#define KARG(T, member) (karg_load<T>(__builtin_offsetof(Args, member)))
template <class T> __device__ __forceinline__ T karg_load(unsigned off) {
    const char __attribute__((address_space(4)))* kp = (const char __attribute__((address_space(4)))*)__builtin_amdgcn_kernarg_segment_ptr(); asm volatile("" : "+s"(kp));
    return *(const T __attribute__((address_space(4)))*)(kp + off);
}
__device__ __forceinline__ void transpose_item(const float* W, int K, int N, bf16_t* WT, int mode, LAS float* scr, int item, int lane, const float* kgain = nullptr) {
    const int nblk = N / 32, kb = item / nblk, nb = item % nblk, k0 = 64 * kb, n0 = 32 * nb;
    int drow = n0;
    if (mode == 1) drow = (n0 >> 7) * 256 + (n0 & 127);
    else if (mode == 2) drow = (n0 >> 7) * 256 + 128 + (n0 & 127);
#pragma unroll 8
    for (int i = 0; i < 32; ++i) { const int kk = 2 * i + (lane >> 5); scr[kk * 33 + (lane & 31)] = __builtin_nontemporal_load(&W[(size_t)(k0 + kk) * N + n0 + (lane & 31)]) * (kgain ? kgain[k0 + kk] : 1.0f); }
    asm volatile("s_waitcnt lgkmcnt(0)" ::: "memory");
    const int c = lane & 7;
    unsigned char* blk = (unsigned char*)WT + ((size_t)(drow >> 7) * (K / 64) + kb) * 16384;
#pragma unroll
    for (int j = 0; j < 4; ++j) { const int n = (lane >> 3) + 8 * j; const LAS float* s = scr + (8 * c) * 33 + n;
        u32x4 o; o.x = cvt_pk_bf16(s[0 * 33], s[1 * 33]); o.y = cvt_pk_bf16(s[2 * 33], s[3 * 33]); o.z = cvt_pk_bf16(s[4 * 33], s[5 * 33]); o.w = cvt_pk_bf16(s[6 * 33], s[7 * 33]);
        const int slot = 16 * ((n >> 2) & 1) + 4 * (n >> 3) + (n & 3);
        *(u32x4*)(blk + pg8::lds_byte((drow & 127) + slot, 8 * c)) = o; }
    asm volatile("s_waitcnt lgkmcnt(0)" ::: "memory");
}

template <bool INT8> __device__ __forceinline__ void transpose_item8(const float* W, int K, int N, unsigned char* WT, LAS float* scr, int kb, int nb, int d0, float scale, const unsigned* cmax, int lane) {
    const int k0 = 64 * kb, n0 = 32 * nb;
#pragma unroll 8
    for (int i = 0; i < 32; ++i) { const int kk = 2 * i + (lane >> 5); scr[kk * 33 + (lane & 31)] = __builtin_nontemporal_load(&W[(size_t)(k0 + kk) * N + n0 + (lane & 31)]); }
    asm volatile("s_waitcnt lgkmcnt(0)" ::: "memory");
    const int c = lane & 3;
    unsigned char* blk = WT + ((size_t)(d0 >> 7) * (K / 128) + (k0 >> 7)) * 16384;
#pragma unroll
    for (int j = 0; j < 2; ++j) { const int n = (lane >> 2) + 16 * j; const LAS float* sp = scr + (16 * c) * 33 + n;
        if (INT8) scale = 127.0f / fmaxf(__uint_as_float(cmax[n0 + n]), 1e-30f);
        u32x4 o;
#pragma unroll
        for (int q = 0; q < 4; ++q) { const float e0 = sp[(4 * q) * 33] * scale, e1 = sp[(4 * q + 1) * 33] * scale, e2 = sp[(4 * q + 2) * 33] * scale, e3 = sp[(4 * q + 3) * 33] * scale;
            o[q] = INT8 ? pack4_i8(e0, e1, e2, e3) : cvt4_fp8(e0, e1, e2, e3); }
        const int slot = 16 * ((n >> 2) & 1) + 4 * (n >> 3) + (n & 3);
        *(u32x4*)(blk + pg8::lds_byte((d0 & 127) + slot, ((k0 & 127) + 16 * c) >> 1)) = o; }
    asm volatile("s_waitcnt lgkmcnt(0)" ::: "memory");
}
__device__ __forceinline__ void slab_convert_i8(const float* W, int N, unsigned char* WT, int n0, int d0, unsigned* cmax, unsigned* arrive, int khalf, LAS float* red, int tid) {
    const int lane = tid & 63, w = __builtin_amdgcn_readfirstlane(tid >> 6), c = lane & 31, h = lane >> 5, kb0 = khalf * (D / 2) + w * 256 + h * 128;
    const float* rowbase = W + (size_t)(khalf * (D / 2) + w * 256) * N + n0; const unsigned loff = (unsigned)(h * 128 * N + c);
    float v[128];
#pragma unroll
    for (int i = 0; i < 128; ++i) v[i] = __builtin_nontemporal_load(&(rowbase + (size_t)i * N)[loff]);
    __builtin_amdgcn_sched_barrier(0);
    float m = 0.f;
#pragma unroll
    for (int i = 0; i < 128; ++i) m = fmaxf(m, fabsf(v[i]));
    m = fmaxf(m, __shfl_xor(m, 32));
    if (h == 0) red[w * 32 + c] = m;
    __syncthreads();
    if (tid < 32) { float mm = red[tid];
#pragma unroll
        for (int j = 1; j < 8; ++j) mm = fmaxf(mm, red[j * 32 + tid]);
        const unsigned old = atomicMax(cmax + n0 + tid, __float_as_uint(mm)); asm volatile("" :: "v"(old)); }
    __syncthreads();
    if (tid == 0) { xb_add(arrive, 1u); unsigned sp = 0; while (xb_ld(arrive) < 2u && ++sp < (1u << 22)) __builtin_amdgcn_s_sleep(1); }
    __syncthreads();
    const float scale = 127.0f / fmaxf(__uint_as_float(xb_ld(cmax + n0 + c)), 1e-30f);
    const int slot = 16 * ((c >> 2) & 1) + 4 * (c >> 3) + (c & 3);
    unsigned char* blk = WT + ((size_t)(d0 >> 7) * (D / 128) + (kb0 >> 7)) * 16384;
#pragma unroll
    for (int j = 0; j < 8; ++j) { u32x4 o;
#pragma unroll
        for (int q = 0; q < 4; ++q) o[q] = pack4_i8(v[16 * j + 4 * q] * scale, v[16 * j + 4 * q + 1] * scale, v[16 * j + 4 * q + 2] * scale, v[16 * j + 4 * q + 3] * scale);
        *(u32x4*)(blk + pg8::lds_byte((d0 & 127) + slot, 8 * j)) = o; }
}
template <int LIST> __device__ __forceinline__ void p0_slabs(const Args& a, LAS unsigned char* lds, unsigned* ctl, int pair, int npairs, int khalf, int tid, int s_lo = 0, int s_hi = 1 << 30) {
    asm volatile("" : "+v"(tid));
    unsigned char* ws = a.ws; unsigned* cm = ctl + CW_CMAX; LAS float* red = (LAS float*)lds;
    constexpr int SPT = FF / 32, NS0 = ((I8_GU1 ? 2 : 0) + (I8_GU2 ? 2 : 0)) * SPT, NQ = (I8_POOL ? GA_OFF : POOL_OFF) / 32, NS1 = I8_IN ? NQ + (NIN - GA_OFF) / 32 : 0;
    for (int sl = (LIST == 0 ? 0 : s_lo) + pair; sl < (LIST == 0 ? NS0 : (s_hi < NS1 ? s_hi : NS1)); sl += npairs) {
        if (LIST == 0) { int t = sl / SPT; const int n0 = 32 * (sl - t * SPT); if (!I8_GU1) t += 2;
            const float* W = t == 0 ? KARG(const float*, w1g) : t == 1 ? KARG(const float*, w1u) : t == 2 ? KARG(const float*, w2g) : KARG(const float*, w2u);
            slab_convert_i8(W, FF, ws + (t < 2 ? WS_WGU1 : WS_WGU2), n0, (n0 >> 7) * 256 + (t & 1) * 128 + (n0 & 127), cm + t * FF, ctl + CW_SLAB + sl, khalf, red, tid); }
        else { const bool qkv = sl < NQ; const int n0 = qkv ? 32 * sl : GA_OFF + 32 * (sl - NQ);
            slab_convert_i8(KARG(const float*, win), NIN, ws + (qkv ? WS_WIN : WS_WIN8), n0, qkv ? n0 : n0 - GA_OFF, cm + CM_WIN, ctl + CW_SLAB + 4 * SPT + sl, khalf, red, tid); }
        __syncthreads(); }
}
#define DYN_ROWS_BEGIN(ctr) { const int ks_ = ((M / NGW) * 5) / 8; const bool dyn_ = (ctr) != nullptr && ks_ >= 1; int k_ = 0; unsigned ndv_ = 0; unsigned* dc_ = (ctr) + (gw & 7) * 32; \
    for (int m = gw; m < M; ) { const bool nd_ = dyn_ && (k_ + 1 >= ks_); if (nd_) { ndv_ = 0; if (lane == 0) ndv_ = atomicAdd(dc_, 1u); }
#define DYN_ROWS_END() ++k_; m = !dyn_ ? m + NGW : (nd_ ? ks_ * NGW + (gw & 7) + 8 * (int)__builtin_amdgcn_readfirstlane(ndv_) : gw + k_ * NGW); } }
template <int N> __device__ __forceinline__ void fwht_regs(float (&v)[N]) {
#pragma unroll
    for (int h = 1; h < N; h <<= 1)
#pragma unroll
        for (int i = 0; i < N; i += 2 * h)
#pragma unroll
            for (int j = i; j < i + h; ++j) { const float a = v[j], b = v[j + h]; v[j] = a + b; v[j + h] = a - b; }
}
__device__ __forceinline__ void actq_phase(const bf16_t* act, unsigned char* aq, float* rs2, int gw, int NGW, int lane, unsigned* dctr = nullptr) {
    asm volatile("" : "+v"(lane));
    static_assert(FF == 21 * 512 + 256, "row = 21 full chunks of 512 + one of 256");
    DYN_ROWS_BEGIN(dctr)
        const u32x4* src = (const u32x4*)(act + (size_t)m * FF) + lane;
        u32x4 w[22];
#pragma unroll
        for (int i = 0; i < 21; ++i) w[i] = src[64 * i];
        w[21] = lane < 32 ? src[64 * 21] : (u32x4){0u, 0u, 0u, 0u};
        float amax = 0.f; const float sg1 = (lane & 1) ? -1.f : 1.f, sg2 = (lane & 2) ? -1.f : 1.f, sg4 = (lane & 4) ? -1.f : 1.f;
#pragma unroll
        for (int i = 0; i < 22; ++i) { float v[8] = {bf_lo(w[i].x), bf_hi(w[i].x), bf_lo(w[i].y), bf_hi(w[i].y), bf_lo(w[i].z), bf_hi(w[i].z), bf_lo(w[i].w), bf_hi(w[i].w)};
            fwht_regs<8>(v);
#pragma unroll
            for (int r = 0; r < 8; ++r) v[r] = fmaf(v[r], sg1, lane_xor1(v[r]));
#pragma unroll
            for (int r = 0; r < 8; ++r) v[r] = fmaf(v[r], sg2, lane_xor2(v[r]));
#pragma unroll
            for (int r = 0; r < 8; ++r) v[r] = fmaf(v[r], sg4, lane_xor4(v[r]));
            u32x4 o; o.x = cvt_pk_bf16(v[0], v[1]); o.y = cvt_pk_bf16(v[2], v[3]); o.z = cvt_pk_bf16(v[4], v[5]); o.w = cvt_pk_bf16(v[6], v[7]); w[i] = o;
            amax = fmaxf(fmaxf(fmaxf(amax, fmaxf(fabsf(v[0]), fabsf(v[1]))), fmaxf(fabsf(v[2]), fabsf(v[3]))), fmaxf(fmaxf(fabsf(v[4]), fabsf(v[5])), fmaxf(fabsf(v[6]), fabsf(v[7]))));
            if ((i & 3) == 3) __builtin_amdgcn_sched_barrier(0); }
        amax = fmaxf(wave_max(amax), 1e-30f); const float qs = 127.0f / amax; if (lane == 0) rs2[m] = amax * (1.0f / (8.f * 127.f));
        u32x2* dst = (u32x2*)(aq + (size_t)m * FF) + lane;
#pragma unroll
        for (int i = 0; i < 22; ++i) { u32x2 o; o.x = pack4_i8(bf_lo(w[i].x) * qs, bf_hi(w[i].x) * qs, bf_lo(w[i].y) * qs, bf_hi(w[i].y) * qs); o.y = pack4_i8(bf_lo(w[i].z) * qs, bf_hi(w[i].z) * qs, bf_lo(w[i].w) * qs, bf_hi(w[i].w) * qs);
            if (i < 21 || lane < 32) dst[64 * i] = o; }
    DYN_ROWS_END()
}
template <int PASS> __device__ __forceinline__ void wd_pass(const float* W, unsigned char* WT, unsigned* cmax, int gw, int NGW, int lane) {
    asm volatile("" : "+v"(lane));
    const int n = lane & 31, hh = lane >> 5; const float sgh = hh ? -1.f : 1.f;
    constexpr int NB = D / 32, ITEMS = (FF / 64) * NB;
    for (int it = gw; it < ITEMS; it += NGW) { const int kb = it / NB, nb = it - kb * NB, k0 = 64 * kb, n0 = 32 * nb;
        const float* src = W + (size_t)(k0 + 32 * hh) * D + n0 + n;
        float v[32];
#pragma unroll
        for (int i = 0; i < 32; ++i) v[i] = __builtin_nontemporal_load(&src[(size_t)i * D]);
        fwht_regs<32>(v);
#pragma unroll
        for (int i = 0; i < 32; ++i) v[i] = fmaf(v[i], sgh, __shfl_xor(v[i], 32));
        if (PASS == 0) { float mx = 0.f;
#pragma unroll
            for (int i = 0; i < 32; ++i) mx = fmaxf(mx, fabsf(v[i]));
            mx = fmaxf(mx, __shfl_xor(mx, 32));
            if (hh == 0) atomicMax(cmax + n0 + n, __float_as_uint(mx)); }
        else { const float scale = 127.0f / fmaxf(__uint_as_float(cmax[n0 + n]), 1e-30f);
            const int slot = 16 * ((n >> 2) & 1) + 4 * (n >> 3) + (n & 3);
            unsigned char* blk = WT + ((size_t)(n0 >> 7) * (FF / 128) + (k0 >> 7)) * 16384;
#pragma unroll
            for (int cc = 0; cc < 2; ++cc) { u32x4 o;
#pragma unroll
                for (int q = 0; q < 4; ++q) o[q] = pack4_i8(v[16 * cc + 4 * q] * scale, v[16 * cc + 4 * q + 1] * scale, v[16 * cc + 4 * q + 2] * scale, v[16 * cc + 4 * q + 3] * scale);
                *(u32x4*)(blk + pg8::lds_byte((n0 & 127) + slot, ((k0 & 127) + 32 * hh + 16 * cc) >> 1)) = o; } }
    }
}
template <int SET> __device__ __forceinline__ void p0_weights(const Args& a, LAS unsigned char* lds, int gw, int NGW, int wave, int lane, const unsigned* wq) {
    asm volatile("" : "+v"(lane));
    LAS float* scr = (LAS float*)(lds + wave * 16384);
    unsigned char* ws = a.ws;
    constexpr int I_GU = (D / 64) * (FF / 32), I_DN = (FF / 64) * (D / 32), I_IN = (D / 64) * (NIN / 32), I_OUT = (D / 64) * (D / 32), I_BR = (1024 / 64) * (D / 32), I_PL = (256 / 64) * (256 / 32);
    constexpr int NITEMS = SET == 0 ? 4 * I_GU + I_DN + I_OUT + 2 * I_BR + 4 * I_PL : (SET == 1 ? I_IN : I_DN);
    for (int it = gw; it < NITEMS; it += NGW) {
        int r = it; const float* W; int K, N, mode = 0, q8 = 0  , d0 = -1, wslot = 0; bf16_t* WT;
        if (SET == 1) { W = KARG(const float*, win); K = D; N = NIN; WT = (bf16_t*)(ws + WS_WIN); const int col = 32 * (r % (NIN / 32));
            if (I8_IN) { if (col < (I8_POOL ? GA_OFF : POOL_OFF)) { q8 = 2; d0 = col; wslot = CM_WIN; } else if (col >= GA_OFF) { q8 = 2; d0 = col - GA_OFF; wslot = CM_WIN; WT = (bf16_t*)(ws + WS_WIN8); } }
            else if (col >= GA_OFF && col < GP_OFF) { q8 = 1; d0 = col - GA_OFF; WT = (bf16_t*)(ws + WS_WIN8); } }
        else if (SET == 2) { W = KARG(const float*, w2d); K = FF; N = D; WT = (bf16_t*)(ws + WS_WD2); const int col = 32 * (r % (D / 32)); if (col < 256 * F8_D2N) { q8 = 1; d0 = col; } }
        else if (r < I_GU) { W = KARG(const float*, w1g); K = D; N = FF; WT = (bf16_t*)(ws + WS_WGU1); mode = 1; if (I8_GU1) { q8 = 2; wslot = CM_W1G; } }
        else if ((r -= I_GU) < I_GU) { W = KARG(const float*, w1u); K = D; N = FF; WT = (bf16_t*)(ws + WS_WGU1); mode = 2; if (I8_GU1) { q8 = 2; wslot = CM_W1U; } }
        else if ((r -= I_GU) < I_GU) { W = KARG(const float*, w2g); K = D; N = FF; WT = (bf16_t*)(ws + WS_WGU2); mode = 1; if (I8_GU2) { q8 = 2; wslot = CM_W2G; } }
        else if ((r -= I_GU) < I_GU) { W = KARG(const float*, w2u); K = D; N = FF; WT = (bf16_t*)(ws + WS_WGU2); mode = 2; if (I8_GU2) { q8 = 2; wslot = CM_W2U; } }
        else if ((r -= I_GU) < I_DN) { if (I8_D1) continue; W = KARG(const float*, w1d); K = FF; N = D; WT = (bf16_t*)(ws + WS_WD1); }
        else if ((r -= I_DN) < I_OUT) { W = KARG(const float*, wout); K = D; N = D; WT = (bf16_t*)(ws + WS_WOUT); }
        else if ((r -= I_OUT) < I_BR) { W = KARG(const float*, wab); K = 1024; N = D; WT = (bf16_t*)(ws + WS_WBA); }
        else if ((r -= I_BR) < I_BR) { W = KARG(const float*, wpb); K = 1024; N = D; WT = (bf16_t*)(ws + WS_WBP); }
        else { r -= I_BR; const int g = r / I_PL; r -= g * I_PL; W = KARG(const float*, poolw) + (size_t)g * 65536; K = 256; N = 256; WT = (bf16_t*)(ws + WS_WPL) + (size_t)g * 65536; }
        if (q8) { const int nblk = N / 32, kb = r / nblk, nb = r % nblk, n0 = 32 * nb;
            if (mode == 1) d0 = (n0 >> 7) * 256 + (n0 & 127); else if (mode == 2) d0 = (n0 >> 7) * 256 + 128 + (n0 & 127);
            if (q8 == 2) continue;
            else transpose_item8<false>(W, K, N, (unsigned char*)WT, scr, kb, nb, d0, 64.f, nullptr, lane); }
        else transpose_item(W, K, N, WT, mode, scr, r, lane, (SET == 1 && I8_IN && POOL_FROM_H) ? KARG(const float*, nmpre) : nullptr);
    }
}

__device__ __forceinline__ void p0_norm(const float* x, const float* gain, bf16_t* xn, unsigned char* xq, float* rs, int gw, int NGW, int lane, unsigned* dctr = nullptr) {
    asm volatile("" : "+v"(lane));
    DYN_ROWS_BEGIN(dctr)
        const f32x4* xr = (const f32x4*)(x + (size_t)m * D) + lane; const f32x4* gr = (const f32x4*)gain + lane;
        f32x4 v[16]; float s = 0.f;
#pragma unroll
        for (int j = 0; j < 16; ++j) { v[j] = xr[64 * j]; s += (v[j][0] * v[j][0] + v[j][1] * v[j][1]) + (v[j][2] * v[j][2] + v[j][3] * v[j][3]); }
        const float rstd = 1.0f / sqrtf(wave_sum(s) * (1.0f / D) + RMS_EPS);
        float amax = 0.f;
#pragma unroll
        for (int j = 0; j < 16; ++j) { const f32x4 g = gr[64 * j]; v[j][0] *= rstd * g[0]; v[j][1] *= rstd * g[1]; v[j][2] *= rstd * g[2]; v[j][3] *= rstd * g[3];
            amax = fmaxf(fmaxf(amax, fmaxf(fabsf(v[j][0]), fabsf(v[j][1]))), fmaxf(fabsf(v[j][2]), fabsf(v[j][3]))); }
        if (xn) { u32x2* o = (u32x2*)(xn + (size_t)m * D) + lane;
#pragma unroll
            for (int j = 0; j < 16; ++j) { u32x2 w; w.x = cvt_pk_bf16(v[j][0], v[j][1]); w.y = cvt_pk_bf16(v[j][2], v[j][3]); o[64 * j] = w; } }
        if (xq) { amax = fmaxf(wave_max(amax), 1e-30f); const float qs = 127.0f / amax; if (lane == 0) rs[m] = amax * (1.0f / 127.f);
            unsigned* o = (unsigned*)(xq + (size_t)m * D) + lane;
#pragma unroll
            for (int j = 0; j < 16; ++j) o[64 * j] = pack4_i8(v[j][0] * qs, v[j][1] * qs, v[j][2] * qs, v[j][3] * qs); }
    DYN_ROWS_END()
}

template <bool BASE16, bool OUT16> __device__ __forceinline__ void norm_phase(LAS unsigned char* lds, const bf16_t* f, const void* base, void* hout, bf16_t* xn, unsigned char* xn8, float* rs, const float* gpost, const float* gpre, float coef, int gw, int NGW, int tid, float* rstd_out = nullptr, unsigned* dctr = nullptr) {
    asm volatile("" : "+v"(tid));
    const int lane = tid & 63;
    LAS f32x4* G1 = (LAS f32x4*)lds; LAS f32x4* G2 = (LAS f32x4*)(lds + 16384);
    for (int i = tid; i < D / 4; i += NTHREADS) { G1[i] = ((const f32x4*)gpost)[i]; if (xn || xn8) G2[i] = ((const f32x4*)gpre)[i]; }
    __syncthreads();
    DYN_ROWS_BEGIN(dctr)
        const u32x2* fr_ = (const u32x2*)(f + (size_t)m * D) + lane;
        u32x2 fw[16]; f32x4 v[16];
#pragma unroll
        for (int j = 0; j < 16; ++j) fw[j] = fr_[64 * j];
        if constexpr (BASE16) { const u32x2* br = (const u32x2*)((const bf16_t*)base + (size_t)m * D) + lane; u32x2 bw[16];
#pragma unroll
            for (int j = 0; j < 16; ++j) bw[j] = br[64 * j];
#pragma unroll
            for (int j = 0; j < 16; ++j) { v[j][0] = bf_lo(bw[j].x); v[j][1] = bf_hi(bw[j].x); v[j][2] = bf_lo(bw[j].y); v[j][3] = bf_hi(bw[j].y); } }
        else { const f32x4* br = (const f32x4*)((const float*)base + (size_t)m * D) + lane;
#pragma unroll
            for (int j = 0; j < 16; ++j) v[j] = br[64 * j]; }
        float s = 0.f;
#pragma unroll
        for (int j = 0; j < 16; ++j) { const float a0 = bf_lo(fw[j].x), a1 = bf_hi(fw[j].x), a2 = bf_lo(fw[j].y), a3 = bf_hi(fw[j].y); s += (a0 * a0 + a1 * a1) + (a2 * a2 + a3 * a3); }
        const float rstd = coef / sqrtf(wave_sum(s) * (1.0f / D) + RMS_EPS);
        float s2 = 0.f; f32x4* ho = (f32x4*)((float*)hout + (size_t)m * D) + lane; u32x2* ho16 = (u32x2*)((bf16_t*)hout + (size_t)m * D) + lane;
#pragma unroll
        for (int j = 0; j < 16; ++j) { const f32x4 g = G1[64 * j + lane]; f32x4 h;
            h[0] = v[j][0] + bf_lo(fw[j].x) * rstd * g[0]; h[1] = v[j][1] + bf_hi(fw[j].x) * rstd * g[1]; h[2] = v[j][2] + bf_lo(fw[j].y) * rstd * g[2]; h[3] = v[j][3] + bf_hi(fw[j].y) * rstd * g[3];
            v[j] = h; if constexpr (OUT16) { u32x2 w; w.x = cvt_pk_bf16(h[0], h[1]); w.y = cvt_pk_bf16(h[2], h[3]); ho16[64 * j] = w; } else ho[64 * j] = h; s2 += (h[0] * h[0] + h[1] * h[1]) + (h[2] * h[2] + h[3] * h[3]);
            if ((j & 3) == 3) __builtin_amdgcn_sched_barrier(0); }
        if (xn || xn8) {
            const float r2 = 1.0f / sqrtf(wave_sum(s2) * (1.0f / D) + RMS_EPS);
            if (rstd_out && lane == 0) rstd_out[m] = r2;
            float amax = 0.f;
#pragma unroll
            for (int j = 0; j < 16; ++j) { const f32x4 g = G2[64 * j + lane]; v[j][0] *= r2 * g[0]; v[j][1] *= r2 * g[1]; v[j][2] *= r2 * g[2]; v[j][3] *= r2 * g[3];
                amax = fmaxf(fmaxf(amax, fmaxf(fabsf(v[j][0]), fabsf(v[j][1]))), fmaxf(fabsf(v[j][2]), fabsf(v[j][3])));
                if ((j & 3) == 3) __builtin_amdgcn_sched_barrier(0); }
            if (xn) { u32x2* o = (u32x2*)(xn + (size_t)m * D) + lane;
#pragma unroll
                for (int j = 0; j < 16; ++j) { u32x2 w; w.x = cvt_pk_bf16(v[j][0], v[j][1]); w.y = cvt_pk_bf16(v[j][2], v[j][3]); o[64 * j] = w; } }
            if (xn8 && !rs) { unsigned* o = (unsigned*)(xn8 + (size_t)m * D) + lane;
#pragma unroll
                for (int j = 0; j < 16; ++j) o[64 * j] = cvt4_fp8(v[j][0], v[j][1], v[j][2], v[j][3]); }
            if (xn8 && rs) { amax = fmaxf(wave_max(amax), 1e-30f); const float qs = 127.0f / amax; if (lane == 0) rs[m] = amax * (1.0f / 127.f);
                unsigned* o = (unsigned*)(xn8 + (size_t)m * D) + lane;
#pragma unroll
                for (int j = 0; j < 16; ++j) o[64 * j] = pack4_i8(v[j][0] * qs, v[j][1] * qs, v[j][2] * qs, v[j][3] * qs); }
        }
    DYN_ROWS_END()
    __syncthreads();
}

template <int P> __device__ __forceinline__ void pool_delta_task(const bf16_t* proj, bf16_t* delta, int g, int mp, int lane) {
    const int m = 2 * mp + (lane >> 5), c = 8 * (lane & 31), t = m & (SEQ - 1);
    const bf16_t* zp = proj + (size_t)m * NIN + POOL_OFF + g * 256 + c;
    u32x4 w[P];
#pragma unroll
    for (int j = 0; j < P; ++j) w[j] = (j <= t) ? *(const u32x4*)(zp - (size_t)j * NIN) : (u32x4){0u, 0u, 0u, 0u};
    float s[8];
#pragma unroll
    for (int k = 0; k < 8; ++k) s[k] = 0.f;
#pragma unroll
    for (int j = 0; j < P; ++j) { s[0] += bf_lo(w[j].x); s[1] += bf_hi(w[j].x); s[2] += bf_lo(w[j].y); s[3] += bf_hi(w[j].y); s[4] += bf_lo(w[j].z); s[5] += bf_hi(w[j].z); s[6] += bf_lo(w[j].w); s[7] += bf_hi(w[j].w); }
    const int cnt = (t + 1) < P ? (t + 1) : P; const float ic = 1.0f / (float)cnt;
    u32x4 o; o.x = cvt_pk_bf16(s[0] * ic - bf_lo(w[0].x), s[1] * ic - bf_hi(w[0].x)); o.y = cvt_pk_bf16(s[2] * ic - bf_lo(w[0].y), s[3] * ic - bf_hi(w[0].y));
    o.z = cvt_pk_bf16(s[4] * ic - bf_lo(w[0].z), s[5] * ic - bf_hi(w[0].z)); o.w = cvt_pk_bf16(s[6] * ic - bf_lo(w[0].w), s[7] * ic - bf_hi(w[0].w));
    *(u32x4*)(delta + ((size_t)g * M + m) * 256 + c) = o;
}
__device__ __forceinline__ void pool_delta(const bf16_t* proj, bf16_t* delta, int gw, int NGW, int lane) {
    asm volatile("" : "+v"(lane));
    for (int task = gw; task < 2 * M; task += NGW) {
        const int g = task & 3, mp = task >> 2;
        if (g == 0) pool_delta_task<2>(proj, delta, 0, mp, lane);
        else if (g == 1) pool_delta_task<4>(proj, delta, 1, mp, lane);
        else if (g == 2) pool_delta_task<8>(proj, delta, 2, mp, lane);
        else pool_delta_task<16>(proj, delta, 3, mp, lane);
    }
}

namespace att {
__device__ __forceinline__ void attn_merge(const bf16_t* outg, const float* lse, bf16_t* attn, int gtid, int NT) {
    asm volatile("" : "+v"(gtid));
    for (int idx = gtid; idx < M * 128; idx += NT) {
        const int m = idx >> 7, c8 = (idx & 127) * 8, h = c8 >> 7;
        const float l0 = lse[(size_t)m * 8 + h], l1 = lse[((size_t)M + m) * 8 + h], l2 = lse[((size_t)2 * M + m) * 8 + h];
        const float mm = fmaxf(l0, fmaxf(l1, l2));
        float w0 = __expf(l0 - mm), w1 = __expf(l1 - mm), w2 = __expf(l2 - mm); const float inv = 1.0f / (w0 + w1 + w2); w0 *= inv; w1 *= inv; w2 *= inv;
        const u32x4 a = *(const u32x4*)(outg + (size_t)m * 1024 + c8), bq = *(const u32x4*)(outg + ((size_t)M + m) * 1024 + c8), c = *(const u32x4*)(outg + ((size_t)2 * M + m) * 1024 + c8);
        u32x4 o;
#pragma unroll
        for (int k = 0; k < 4; ++k) o[k] = cvt_pk_bf16(w0 * bf_lo(a[k]) + w1 * bf_lo(bq[k]) + w2 * bf_lo(c[k]), w0 * bf_hi(a[k]) + w1 * bf_hi(bq[k]) + w2 * bf_hi(c[k]));
        *(u32x4*)(attn + (size_t)m * 1024 + c8) = o;
    }
}
}


namespace att2 {
constexpr int VROW = 272, KBYTES = 32768, STG = KBYTES + 128 * VROW, N_UNITS = 3 * BATCH * 8 * 32;
static_assert(2 * STG <= MISC_OFF, "attention LDS");
struct Lane { int kR[2], kC[2]; unsigned ldsw; int koff, v_ch, v_kg, vcol, fr, fq, qbw, qi; };
struct UDec { const bf16_t* base; size_t rs; int qb, d, g, h, b, r; };
__device__ __forceinline__ UDec decode(const bf16_t* proj, int u) {
    UDec x; const int sub = u & 31; x.h = (u >> 5) & 7; x.b = (u >> 8) & 3; x.g = u >> 10;
    const int dsh = 2 * x.g, nbsh = 5 - dsh; x.d = 1 << dsh; x.qb = sub & ((1 << nbsh) - 1); x.r = sub >> nbsh;
    x.rs = (size_t)x.d * NIN; x.base = proj + ((size_t)x.b * SEQ + x.r) * NIN + x.g * 3072 + x.h * 128; return x;
}
__device__ __forceinline__ int first_half(int u) { const int g = u >> 10, nbsh = 5 - 2 * g; return ((u & 31) & ((1 << nbsh) - 1)) == 0 ? 1 : 0; }
template <int PAR> __device__ __forceinline__ void issue(LAS unsigned char* lds, const bf16_t* proj, int u, int half, const Lane& L, u32x4 (&vr)[4]) {
    const UDec x = decode(proj, u);
    const int i0 = 128 * x.qb - 128 * (1 - half);
    const bf16_t* kb = x.base + 1024 + (size_t)i0 * x.rs;
#pragma unroll
    for (int eh = 0; eh < 2; ++eh)
#pragma unroll
        for (int i = 0; i < 2; ++i)
            __builtin_amdgcn_global_load_lds((const unsigned*)(kb + 64 * eh + (size_t)L.kR[i] * x.rs + L.kC[i]), (LAS unsigned*)(lds + PAR * STG + eh * 16384 + L.ldsw + i * 8192), 16, 0, 0);
    const bf16_t* vp = x.base + 2048 + (size_t)(i0 + 4 * L.v_kg) * x.rs + 8 * L.v_ch;
#pragma unroll
    for (int c = 0; c < 4; ++c) vr[c] = *(const u32x4*)(vp + (size_t)c * x.rs);
}
template <int PAR> __device__ __forceinline__ void store_v(LAS unsigned char* lds, const Lane& L, const u32x4 (&vr)[4]) {
    LAS unsigned char* vdst = lds + PAR * STG + KBYTES + (8 * L.v_ch) * VROW + L.vcol;
#pragma unroll
    for (int wi = 0; wi < 4; ++wi) {
        u32x2 ev, od;
        ev.x = (vr[0][wi] & 0xffffu) | (vr[1][wi] << 16); ev.y = (vr[2][wi] & 0xffffu) | (vr[3][wi] << 16);
        od.x = (vr[0][wi] >> 16) | (vr[1][wi] & 0xffff0000u); od.y = (vr[2][wi] >> 16) | (vr[3][wi] & 0xffff0000u);
        *(LAS u32x2*)(vdst + (2 * wi) * VROW) = ev; *(LAS u32x2*)(vdst + (2 * wi + 1) * VROW) = od; }
}
__device__ __forceinline__ void load_q(const bf16_t* proj, int u, const Lane& L, bf16x8 (&q)[4]) {
    const UDec x = decode(proj, u);
    const bf16_t* qp = x.base + (size_t)(128 * x.qb + L.qi) * x.rs + 8 * L.fq;
#pragma unroll
    for (int ks = 0; ks < 4; ++ks) q[ks] = *(const bf16x8*)(qp + 32 * ks);
}
template <int PAR, int HALF, int QBW> __device__ __forceinline__ void compute(LAS unsigned char* lds, int u, const Lane& L, const bf16x8 (&qf)[4], float& mrun, float& lrun, f32x4 (&o)[8]) {
    const int g = u >> 10, h = (u >> 5) & 7, d = 1 << (2 * g);
    constexpr int KT0 = HALF ? 0 : QBW, KT1 = HALF ? QBW : 7;
    f32x4 s[8];
#pragma unroll
    for (int kt = KT0; kt <= KT1; ++kt) {
        s[kt] = (f32x4){0.f, 0.f, 0.f, 0.f};
#pragma unroll
        for (int ks = 0; ks < 4; ++ks) { const bf16x8 kf = *(const LAS bf16x8*)(lds + PAR * STG + (ks >> 1) * 16384 + L.koff + kt * 2048 + (ks & 1) * 1024);
            s[kt] = __builtin_amdgcn_mfma_f32_16x16x32_bf16(kf, qf[ks], s[kt], 0, 0, 0); }
        if ((kt - KT0) & 1) __builtin_amdgcn_sched_barrier(0);
    }
    const float slope = (g < 2) ? exp2f(-0.25f * (float)(g * 8 + h + 1)) : exp2f(-(4.5f + 0.5f * (float)h));
    const float sld = slope * (float)d * 1.4426950408889634f;
    int bi = 16 * QBW + L.fr + 128 * (1 - HALF) - 4 * L.fq; asm volatile("" : "+v"(bi));
    int dq = 4 * L.fq - L.fr; asm volatile("" : "+v"(dq));
    const float c0 = -sld * (float)bi;
    float mloc = -1e30f;
#pragma unroll
    for (int kt = KT0; kt <= KT1; ++kt) {
#pragma unroll
        for (int j = 0; j < 4; ++j) { float v = s[kt][j] * (0.08838834764831845f * 1.4426950408889634f) + (c0 + sld * (float)(16 * kt + j));
            if (kt == QBW) { const bool valid = HALF ? (dq + j <= 0) : (dq + j >= 0); v = valid ? v : -1e30f; }
            s[kt][j] = v; mloc = fmaxf(mloc, v); }
    }
    mloc = fmaxf(mloc, __shfl_xor(mloc, 16)); mloc = fmaxf(mloc, __shfl_xor(mloc, 32));
    const float mnew = fmaxf(mrun, mloc), alpha = __builtin_amdgcn_exp2f(mrun - mnew);
    float lsum = 0.f;
#pragma unroll
    for (int kt = KT0; kt <= KT1; ++kt)
#pragma unroll
        for (int j = 0; j < 4; ++j) { const float p = __builtin_amdgcn_exp2f(s[kt][j] - mnew); s[kt][j] = p; lsum += p; }
    lrun = lrun * alpha + lsum; mrun = mnew;
#pragma unroll
    for (int et = 0; et < 8; ++et) o[et] = o[et] * alpha;
#pragma unroll
    for (int ss = KT0 / 2; ss <= KT1 / 2; ++ss) {
        const bool l0 = (2 * ss >= KT0) && (2 * ss <= KT1), l1 = (2 * ss + 1 >= KT0) && (2 * ss + 1 <= KT1);
        u32x4 pw;
        pw.x = l0 ? cvt_pk_bf16(s[2 * ss][0], s[2 * ss][1]) : 0u; pw.y = l0 ? cvt_pk_bf16(s[2 * ss][2], s[2 * ss][3]) : 0u;
        pw.z = l1 ? cvt_pk_bf16(s[(2 * ss + 1) & 7][0], s[(2 * ss + 1) & 7][1]) : 0u; pw.w = l1 ? cvt_pk_bf16(s[(2 * ss + 1) & 7][2], s[(2 * ss + 1) & 7][3]) : 0u;
        const bf16x8 pf = __builtin_bit_cast(bf16x8, pw);
#pragma unroll
        for (int et = 0; et < 8; ++et) { const bf16x8 vf = *(const LAS bf16x8*)(lds + PAR * STG + KBYTES + (16 * et + L.fr) * VROW + 64 * ss + 16 * L.fq);
            o[et] = __builtin_amdgcn_mfma_f32_16x16x32_bf16(vf, pf, o[et], 0, 0, 0); }
        __builtin_amdgcn_sched_barrier(0);
    }
}
template <int PAR> __device__ __forceinline__ void compute_sel(LAS unsigned char* lds, int u, int half, const Lane& L, const bf16x8 (&qf)[4], float& mrun, float& lrun, f32x4 (&o)[8]) {
#define ATT_CASE(H, Q) case (H) * 8 + (Q): compute<PAR, H, Q>(lds, u, L, qf, mrun, lrun, o); break;
    switch (half * 8 + L.qbw) {
        ATT_CASE(0, 0) ATT_CASE(0, 1) ATT_CASE(0, 2) ATT_CASE(0, 3) ATT_CASE(0, 4) ATT_CASE(0, 5) ATT_CASE(0, 6) ATT_CASE(0, 7)
        ATT_CASE(1, 0) ATT_CASE(1, 1) ATT_CASE(1, 2) ATT_CASE(1, 3) ATT_CASE(1, 4) ATT_CASE(1, 5) ATT_CASE(1, 6) ATT_CASE(1, 7)
        default: break;
    }
#undef ATT_CASE
}
__device__ __forceinline__ void finalize(const bf16_t* proj, int u, const Lane& L, float mrun, float lrun, const f32x4 (&o)[8], bf16_t* outg, float* lse) {
    const UDec x = decode(proj, u);
    float l = lrun; l += __shfl_xor(l, 16); l += __shfl_xor(l, 32);
    const float inv = 1.0f / l;
    const size_t mrow = (size_t)x.g * M + (size_t)x.b * SEQ + (size_t)(128 * x.qb + L.qi) * x.d + x.r;
    bf16_t* op = outg + mrow * 1024 + x.h * 128 + 4 * L.fq;
#pragma unroll
    for (int et = 0; et < 8; ++et) { u32x2 w; w.x = cvt_pk_bf16(o[et][0] * inv, o[et][1] * inv); w.y = cvt_pk_bf16(o[et][2] * inv, o[et][3] * inv); *(u32x2*)(op + 16 * et) = w; }
    if (L.fq == 0) lse[mrow * 8 + x.h] = (mrun + __builtin_amdgcn_logf(l)) * 0.6931471805599453f;
}
template <int PAR> __device__ __forceinline__ bool step(LAS unsigned char* lds, const bf16_t* proj, bf16_t* outg, float* lse, int G, const Lane& L, int& u, int& half, bf16x8 (&qf)[4], float& mrun, float& lrun, f32x4 (&o)[8]) {
    int nu, nh; if (half == 0) { nu = u; nh = 1; } else { nu = u + G; nh = nu < N_UNITS ? first_half(nu) : 0; }
    const bool has_next = nu < N_UNITS, new_unit = has_next && (nu != u);
    u32x4 vr[4]; bf16x8 qn[4];
    if (has_next) issue<PAR ^ 1>(lds, proj, nu, nh, L, vr);
    if (new_unit) load_q(proj, nu, L, qn);
    __builtin_amdgcn_sched_barrier(0);
    compute_sel<PAR>(lds, u, half, L, qf, mrun, lrun, o);
    if (half == 1) { finalize(proj, u, L, mrun, lrun, o, outg, lse); mrun = -1e30f; lrun = 0.f;
#pragma unroll
        for (int et = 0; et < 8; ++et) o[et] = (f32x4){0.f, 0.f, 0.f, 0.f}; }
    __builtin_amdgcn_sched_barrier(0);
    if (has_next) store_v<PAR ^ 1>(lds, L, vr);
    if (new_unit) {
#pragma unroll
        for (int ks = 0; ks < 4; ++ks) qf[ks] = qn[ks]; }
    __builtin_amdgcn_s_waitcnt(0); asm volatile("" ::: "memory"); __builtin_amdgcn_s_barrier(); asm volatile("" ::: "memory");
    u = nu; half = nh;
    return has_next;
}
__device__ __forceinline__ void attn_phase(LAS unsigned char* lds, const bf16_t* proj, bf16_t* outg, float* lse, int vcu, int G) {
    int tid = threadIdx.x; asm volatile("" : "+v"(tid));
    const int lane = tid & 63, wid = __builtin_amdgcn_readfirstlane(tid >> 6);
    Lane L;
#pragma unroll
    for (int i = 0; i < 2; ++i) pg8::stage_rc(tid * 16 + i * 8192, L.kR[i], L.kC[i]);
    L.fr = lane & 15; L.fq = lane >> 4; L.ldsw = (unsigned)wid * 1024u; L.koff = pg8::lds_byte(L.fr, L.fq * 8);
    L.v_ch = (lane & 3) + 4 * ((lane >> 4) & 3); L.v_kg = ((lane >> 2) & 3) + 4 * wid;
    L.vcol = 64 * (wid >> 1) + 16 * ((lane >> 2) & 3) + 8 * (wid & 1);
    L.qbw = wid < 4 ? wid : 11 - wid; L.qi = 16 * L.qbw + L.fr;
    int u = vcu; if (u >= N_UNITS) return;
    int half = first_half(u);
    bf16x8 qf[4]; f32x4 o[8]; float mrun = -1e30f, lrun = 0.f;
#pragma unroll
    for (int et = 0; et < 8; ++et) o[et] = (f32x4){0.f, 0.f, 0.f, 0.f};
    { u32x4 vr[4]; issue<0>(lds, proj, u, half, L, vr); load_q(proj, u, L, qf); store_v<0>(lds, L, vr); }
    __builtin_amdgcn_s_waitcnt(0); asm volatile("" ::: "memory"); __builtin_amdgcn_s_barrier(); asm volatile("" ::: "memory");
    for (;;) {
        if (!step<0>(lds, proj, outg, lse, G, L, u, half, qf, mrun, lrun, o)) break;
        if (!step<1>(lds, proj, outg, lse, G, L, u, half, qf, mrun, lrun, o)) break;
    }
}
}

constexpr int NPHASE = 13;
__global__ void __launch_bounds__(NTHREADS, 2) mk_fwd(Args a) {
    extern __shared__ __attribute__((aligned(16))) unsigned char lds_raw[];
    LAS unsigned char* lds = (LAS unsigned char*)lds_raw;
    const int tid = threadIdx.x, lane = tid & 63, wave = __builtin_amdgcn_readfirstlane(tid >> 6);
    const int G = gridDim.x, bx = blockIdx.x;
    const int vcu = (G % 8 == 0) ? (bx % 8) * (G / 8) + bx / 8 : bx;
    const int gw = vcu * NWAVES + wave, NGW = G * NWAVES;
    unsigned char* ws = a.ws;
    unsigned* ctl = (unsigned*)(ws + WS_CTL);
    volatile LAS unsigned* MISC = (volatile LAS unsigned*)(lds + MISC_OFF);
    if (tid < 32) MISC[tid] = 0u;
    __syncthreads();
    XcdBarrier bar; bar.bar = ctl + CW_BAR; bar.x = 0; bar.st = nullptr;
    if (MK_ONE_LAUNCH) bar = xcd_barrier_post(ctl + CW_BAR, MISC + 8);
    const int lo = a.ph_lo, hi = a.ph_hi;
#ifdef DBG_ONLY
#define IN(k) ((k) == DBG_ONLY && lo <= (k) && (k) < hi)
#else
#define IN(k) (lo <= (k) && (k) < hi)
#endif
#define SEAM(k) do { if (MK_ONE_LAUNCH && IN(k) && IN((k) + 1)) xcd_barrier(bar); } while (0)

    bf16_t* XN = (bf16_t*)(ws + WS_XN); bf16_t* ACT = (bf16_t*)(ws + WS_ACT); bf16_t* Fb = (bf16_t*)(ws + WS_F); bf16_t* PROJ = (bf16_t*)(ws + WS_PROJ);
    bf16_t* ATT = (bf16_t*)(ws + WS_ATTN); bf16_t* DELTA = (bf16_t*)(ws + WS_DELTA); bf16_t* POOLED = (bf16_t*)(ws + WS_POOLED); bf16_t* MERGED = XN;

    unsigned* wq = ctl + CW_CMAX; const float* cmf = (const float*)wq;
    float* RS = (float*)(ws + WS_CTL + 512 * 1024);
    unsigned char* ACT8 = ws + WS_WGU1;
    bf16_t* H1 = (bf16_t*)(ws + WS_WGU1); bf16_t* H2 = (bf16_t*)(ws + WS_WIN);
    float* RSTD = RS + 2 * M;
    unsigned char* AQ = ws + WS_WGU1; float* RS2 = RS + M;
    unsigned char* XQ = ws + WS_T1;
    const bool tail_cvt = (G == 256);
    if (IN(0)) {
        p0_slabs<0>(a, lds, ctl, bx >> 1, G >> 1, bx & 1, tid);
        p0_slabs<1>(a, lds, ctl, bx >> 1, G >> 1, bx & 1, tid, 0, tail_cvt ? W_IN_P0_SLABS : 1 << 30);
        if (I8_D1) wd_pass<0>(KARG(const float*, w1d), nullptr, wq + CM_W1D, gw, NGW, lane);
        if (I8_D2 && !tail_cvt) wd_pass<0>(KARG(const float*, w2d), nullptr, wq + CM_W2D, gw, NGW, lane);
        p0_weights<0>(a, lds, gw, NGW, wave, lane, wq);
        if (!tail_cvt) { p0_weights<1>(a, lds, gw, NGW, wave, lane, wq); if (!I8_D2) p0_weights<2>(a, lds, gw, NGW, wave, lane, wq); }
        p0_norm(KARG(const float*, x), KARG(const float*, n1pre), I8_GU1 ? nullptr : XN, I8_GU1 ? XQ : nullptr, RS, gw, NGW, lane, ctl + CW_DYN); }
    SEAM(0);
    if (IN(1)) {
#if I8_GU1
        { pg8::PlainSched S; S.T.init(M, 2 * FF, G, bx, WGM_G); S.A = (const char*)XQ; S.B = (const char*)(ws + WS_WGU1); S.tstep = (size_t)256 * D;
          pg8::EpiSwiGLUI8<0> E{ACT, nullptr, FF, RS, cmf + CM_W1G, cmf + CM_W1U};
          pg8::gemm_phase<pg8::EpiSwiGLUI8<0>, pg8::PlainSched, PG8_ALIGN, PG8_SP2, 2>(lds, D / 2, S, E); }
#else
        { pg8::PlainSched S; S.T.init(M, 2 * FF, G, bx, WGM_G); S.A = (const char*)XN; S.B = (const char*)(ws + WS_WGU1); S.tstep = (size_t)256 * D * 2;
          pg8::EpiSwiGLU E{ACT, FF};
          pg8::gemm_phase<pg8::EpiSwiGLU, pg8::PlainSched, PG8_ALIGN, PG8_SP2>(lds, D, S, E); }
#endif
        if (tail_cvt && bx >= 128) { p0_slabs<1>(a, lds, ctl, (bx - 128) >> 1, 64, bx & 1, tid, W_IN_P0_SLABS); if (!(I8_IN && I8_POOL)) p0_weights<1>(a, lds, (bx - 128) * NWAVES + wave, 128 * NWAVES, wave, lane, wq); } }
    SEAM(1);
    if (IN(2)) {
#if I8_D1
        wd_pass<1>(KARG(const float*, w1d), ws + WS_WD1, wq + CM_W1D, gw, NGW, lane);
        actq_phase(ACT, AQ, RS2, gw, NGW, lane, ctl + CW_DYN + 2048);
        xcd_barrier(bar);
        { pg8::PlainSched S; S.T.init(M, D, G, bx, WGM_D); S.A = (const char*)AQ; S.B = (const char*)(ws + WS_WD1); S.tstep = (size_t)256 * FF;
          pg8::EpiBf16SigI8 E{Fb, D, 1 << 20, RS2, cmf + CM_W1D, 1.0f / (8.f * 127.f)};
          pg8::gemm_phase<pg8::EpiBf16SigI8, pg8::PlainSched, PG8_ALIGN, PG8_SP2, 2>(lds, FF / 2, S, E); }
#else
        { pg8::PlainSched S; S.T.init(M, D, G, bx, WGM_D); S.A = (const char*)ACT; S.B = (const char*)(ws + WS_WD1); S.tstep = (size_t)256 * FF * 2;
          pg8::EpiBf16 E{Fb, D, 1.0f};
          pg8::gemm_phase<pg8::EpiBf16, pg8::PlainSched, PG8_ALIGN, PG8_SP2>(lds, FF, S, E); }
#endif
    }
    SEAM(2);
    if (IN(3)) norm_phase<false, true>(lds, Fb, KARG(const float*, x), H1, (I8_IN && (I8_POOL || POOL_FROM_H)) ? nullptr : XN, XQ, I8_IN ? RS : nullptr, KARG(const float*, n1post), KARG(const float*, nmpre), 0.5f, gw, NGW, tid, (I8_IN && POOL_FROM_H) ? RSTD : nullptr, ctl + CW_DYN + 4096);
    SEAM(3);
    if (IN(4)) {
#if I8_IN
        { pg8::PlainSched S; S.T.init(M, I8_POOL ? GA_OFF : POOL_OFF, G, bx, WGM_G); S.A = (const char*)XQ; S.B = (const char*)(ws + WS_WIN); S.tstep = (size_t)256 * D;
          pg8::EpiBf16SigI8 E{PROJ, NIN, 1 << 20, RS, cmf + CM_WIN, 1.0f / 127.f};
          pg8::gemm_phase<pg8::EpiBf16SigI8, pg8::PlainSched, PG8_ALIGN, PG8_SP2, 2>(lds, D / 2, S, E); }
        if (!I8_POOL && POOL_FROM_H) { pg8::PlainSched S; S.T.init(M, GA_OFF - POOL_OFF, G, bx, WGM_G); S.A = (const char*)H1; S.B = (const char*)(ws + WS_WIN) + (size_t)POOL_OFF * D * 2; S.tstep = (size_t)256 * D * 2;
          pg8::EpiBf16Row E{PROJ + POOL_OFF, NIN, RSTD};
          pg8::gemm_phase<pg8::EpiBf16Row, pg8::PlainSched, PG8_ALIGN, PG8_SP2>(lds, D, S, E); }
        if (!I8_POOL && !POOL_FROM_H) { pg8::PlainSched S; S.T.init(M, GA_OFF - POOL_OFF, G, bx, WGM_G); S.A = (const char*)XN; S.B = (const char*)(ws + WS_WIN) + (size_t)POOL_OFF * D * 2; S.tstep = (size_t)256 * D * 2;
          pg8::EpiBf16Sig E{PROJ + POOL_OFF, NIN, 1 << 20, 1.0f};
          pg8::gemm_phase<pg8::EpiBf16Sig, pg8::PlainSched, PG8_ALIGN, PG8_SP2>(lds, D, S, E); }
        { pg8::PlainSched S; S.T.init(M, 2 * D, G, bx, WGM_G); S.A = (const char*)XQ; S.B = (const char*)(ws + WS_WIN8); S.tstep = (size_t)256 * D;
          pg8::EpiBf16SigI8 E{PROJ + GA_OFF, NIN, 0, RS, cmf + CM_WIN + GA_OFF, 1.0f / 127.f};
          pg8::gemm_phase<pg8::EpiBf16SigI8, pg8::PlainSched, PG8_ALIGN, PG8_SP2, 2>(lds, D / 2, S, E); }
#else
        { pg8::PlainSched S; S.T.init(M, GA_OFF, G, bx, WGM_G); S.A = (const char*)XN; S.B = (const char*)(ws + WS_WIN); S.tstep = (size_t)256 * D * 2;
          pg8::EpiBf16Sig E{PROJ, NIN, 1 << 20, 1.0f};
          pg8::gemm_phase<pg8::EpiBf16Sig, pg8::PlainSched, PG8_ALIGN, PG8_SP2>(lds, D, S, E); }
        { pg8::PlainSched S; S.T.init(M, D, G, bx, WGM_G); S.A = (const char*)XN; S.B = (const char*)(ws + WS_WIN) + (size_t)GP_OFF * D * 2; S.tstep = (size_t)256 * D * 2;
          pg8::EpiBf16Sig E{PROJ + GP_OFF, NIN, 0, 1.0f};
          pg8::gemm_phase<pg8::EpiBf16Sig, pg8::PlainSched, PG8_ALIGN, PG8_SP2>(lds, D, S, E); }
        { pg8::PlainSched S; S.T.init(M, D, G, bx, WGM_G); S.A = (const char*)XQ; S.B = (const char*)(ws + WS_WIN8); S.tstep = (size_t)256 * D;
          pg8::EpiBf16Sig E{PROJ + GA_OFF, NIN, 0, 1.0f / 64.f};
          pg8::gemm_phase<pg8::EpiBf16Sig, pg8::PlainSched, PG8_ALIGN, PG8_SP2, 1>(lds, D / 2, S, E); }
#endif
    }
    SEAM(4);
    if (IN(5)) { att2::attn_phase(lds, PROJ, (bf16_t*)(ws + WS_OUTG), (float*)(ws + WS_LSE), vcu, G); pool_delta(PROJ, DELTA, gw, NGW, lane); }
    SEAM(5);
    if (IN(6)) { att::attn_merge((const bf16_t*)(ws + WS_OUTG), (const float*)(ws + WS_LSE), ATT, vcu * NTHREADS + tid, G * NTHREADS);
        pg8::PoolSched S; S.T.init(M, 1024, G, bx); S.A = (const char*)DELTA; S.B = (const char*)(ws + WS_WPL); S.tstep = (size_t)256 * 256 * 2; S.gstride = (size_t)M * 256 * 2;
        pg8::EpiPool E{POOLED, 1024, KARG(const float*, poolscale)};
        pg8::gemm_phase<pg8::EpiPool, pg8::PoolSched, PG8_ALIGN, PG8_SP2>(lds, 256, S, E); }
    SEAM(6);
    if (IN(7)) { pg8::BranchSched S; S.T.init(M, D, G, bx); S.A0 = (const char*)ATT; S.B0 = (const char*)(ws + WS_WBA); S.A1 = (const char*)POOLED; S.B1 = (const char*)(ws + WS_WBP); S.tstep = (size_t)256 * 1024 * 2;
        pg8::EpiBranch E{MERGED, D, PROJ};
        pg8::gemm_phase<pg8::EpiBranch, pg8::BranchSched, PG8_ALIGN, PG8_SP2>(lds, 1024, S, E); }
    SEAM(7);
    if (IN(8)) { pg8::PlainSched S; S.T.init(M, D, G, bx); S.A = (const char*)MERGED; S.B = (const char*)(ws + WS_WOUT); S.tstep = (size_t)256 * D * 2;
        pg8::EpiBf16 E{Fb, D, 1.0f};
        pg8::gemm_phase<pg8::EpiBf16, pg8::PlainSched, PG8_ALIGN, PG8_SP2>(lds, D, S, E); }
    SEAM(8);
    if (IN(9)) norm_phase<true, true>(lds, Fb, H1, H2, I8_GU2 ? nullptr : XN, I8_GU2 ? XQ : nullptr, RS, KARG(const float*, nmpost), KARG(const float*, n2pre), 1.0f, gw, NGW, tid, nullptr, ctl + CW_DYN + 6144);
    SEAM(9);
    if (IN(10)) {
#if I8_GU2
        { pg8::PlainSched S; S.T.init(M, 2 * FF, G, bx, WGM_G); S.A = (const char*)XQ; S.B = (const char*)(ws + WS_WGU2); S.tstep = (size_t)256 * D;
          constexpr int OUT = F8_D2N == 0 ? 0 : (F8_D2N == 16 ? 1 : 2);
          pg8::EpiSwiGLUI8<OUT> E{ACT, F8_D2N == 16 ? (unsigned char*)ACT : ACT8, FF, RS, cmf + CM_W2G, cmf + CM_W2U};
          pg8::gemm_phase<pg8::EpiSwiGLUI8<OUT>, pg8::PlainSched, PG8_ALIGN, PG8_SP2, 2>(lds, D / 2, S, E); }
#elif F8_D2
        { pg8::PlainSched S; S.T.init(M, 2 * FF, G, bx, WGM_G); S.A = (const char*)XN; S.B = (const char*)(ws + WS_WGU2); S.tstep = (size_t)256 * D * 2;
          pg8::EpiSwiGLU8 E{(unsigned char*)ACT, FF};
          pg8::gemm_phase<pg8::EpiSwiGLU8, pg8::PlainSched, PG8_ALIGN, PG8_SP2>(lds, D, S, E); }
#else
        { pg8::PlainSched S; S.T.init(M, 2 * FF, G, bx, WGM_G); S.A = (const char*)XN; S.B = (const char*)(ws + WS_WGU2); S.tstep = (size_t)256 * D * 2;
          pg8::EpiSwiGLU E{ACT, FF};
          pg8::gemm_phase<pg8::EpiSwiGLU, pg8::PlainSched, PG8_ALIGN, PG8_SP2>(lds, D, S, E); }
#endif
        if (tail_cvt && bx >= 128) { if (I8_D2) wd_pass<0>(KARG(const float*, w2d), nullptr, wq + CM_W2D, (bx - 128) * NWAVES + wave, 128 * NWAVES, lane);
            else p0_weights<2>(a, lds, (bx - 128) * NWAVES + wave, 128 * NWAVES, wave, lane, wq); } }
    SEAM(10);
    if (IN(11)) {
#if I8_D2
        static_assert(F8_D2N == 0, "int8 FFN2 down excludes the fp8 split");
        wd_pass<1>(KARG(const float*, w2d), ws + WS_WD2, wq + CM_W2D, gw, NGW, lane);
        actq_phase(ACT, AQ, RS2, gw, NGW, lane, ctl + CW_DYN + 8192);
        xcd_barrier(bar);
        { pg8::PlainSched S; S.T.init(M, D, G, bx, WGM_D); S.A = (const char*)AQ; S.B = (const char*)(ws + WS_WD2); S.tstep = (size_t)256 * FF;
          pg8::EpiBf16SigI8 E{Fb, D, 1 << 20, RS2, cmf + CM_W2D, 1.0f / (8.f * 127.f)};
          pg8::gemm_phase<pg8::EpiBf16SigI8, pg8::PlainSched, PG8_ALIGN, PG8_SP2, 2>(lds, FF / 2, S, E); }
#else
        if (F8_D2N > 0) { pg8::PlainSched S; S.T.init(M, 256 * F8_D2N, G, bx, WGM_D); S.A = (const char*)(F8_D2N == 16 ? (unsigned char*)ACT : ACT8); S.B = (const char*)(ws + WS_WD2); S.tstep = (size_t)256 * FF;
            pg8::EpiBf16 E{Fb, D, 1.0f / 64.f};
            pg8::gemm_phase<pg8::EpiBf16, pg8::PlainSched, PG8_ALIGN, PG8_SP2, 1>(lds, FF / 2, S, E); }
        if (F8_D2N < 16) { pg8::PlainSched S; S.T.init(M, D - 256 * F8_D2N, G, bx, WGM_D); S.A = (const char*)ACT; S.B = (const char*)(ws + WS_WD2) + (size_t)256 * F8_D2N * FF * 2; S.tstep = (size_t)256 * FF * 2;
            pg8::EpiBf16 E{Fb + 256 * F8_D2N, D, 1.0f};
            pg8::gemm_phase<pg8::EpiBf16, pg8::PlainSched, PG8_ALIGN, PG8_SP2>(lds, FF, S, E); }
#endif
    }
    SEAM(11);
    if (IN(12)) norm_phase<true, false>(lds, Fb, H2, KARG(float*, out), nullptr, nullptr, nullptr, KARG(const float*, n2post), nullptr, 0.5f, gw, NGW, tid, nullptr, ctl + CW_DYN + 10240);
#undef IN
#undef SEAM
}

extern "C" void kernel_launch(void* const* d_in, const int* in_sizes, int n_in, void* d_out, int out_size, void* d_ws, size_t ws_size, hipStream_t stream) {
    static int grid = 0;
    if (grid == 0) {
        if (n_in != 19 || in_sizes[0] != M * D || out_size != M * D || ws_size < WS_END) { fprintf(stderr, "kernel_launch: unexpected shapes (n_in %d, in0 %d, out %d, ws %zu < %zu)\n", n_in, n_in > 0 ? in_sizes[0] : -1, out_size, ws_size, (size_t)WS_END); grid = -1; return; }
        int dev = 0, cus = 0, per_cu = 0;
        if (hipGetDevice(&dev) != hipSuccess || hipDeviceGetAttribute(&cus, hipDeviceAttributeMultiprocessorCount, dev) != hipSuccess) { grid = -1; return; }
        if (hipFuncSetAttribute((const void*)mk_fwd, hipFuncAttributeMaxDynamicSharedMemorySize, LDS_BYTES) != hipSuccess) { fprintf(stderr, "kernel_launch: hipFuncSetAttribute failed\n"); grid = -1; return; }
        if (hipOccupancyMaxActiveBlocksPerMultiprocessor(&per_cu, (const void*)mk_fwd, NTHREADS, LDS_BYTES) != hipSuccess || per_cu < 1) { fprintf(stderr, "kernel_launch: occupancy query says %d\n", per_cu); }
        (void)hipGetLastError();
        grid = cus;
    }
    if (grid < 0) return;
    (void)hipMemsetAsync((char*)d_ws + WS_CTL, 0, CTL_ZERO_BYTES, stream);
    Args a{};
    a.x = (const float*)d_in[0]; a.n1pre = (const float*)d_in[1]; a.n1post = (const float*)d_in[2]; a.w1g = (const float*)d_in[3]; a.w1u = (const float*)d_in[4]; a.w1d = (const float*)d_in[5];
    a.nmpre = (const float*)d_in[6]; a.nmpost = (const float*)d_in[7]; a.win = (const float*)d_in[8]; a.poolw = (const float*)d_in[9]; a.poolscale = (const float*)d_in[10];
    a.wab = (const float*)d_in[11]; a.wpb = (const float*)d_in[12]; a.wout = (const float*)d_in[13];
    a.n2pre = (const float*)d_in[14]; a.n2post = (const float*)d_in[15]; a.w2g = (const float*)d_in[16]; a.w2u = (const float*)d_in[17]; a.w2d = (const float*)d_in[18];
    a.out = (float*)d_out; a.ws = (unsigned char*)d_ws;
#if MK_ONE_LAUNCH
    a.ph_lo = 0; a.ph_hi = NPHASE;
    hipLaunchKernelGGL(mk_fwd, dim3(grid), dim3(NTHREADS), LDS_BYTES, stream, a);
#else
    for (int p = 0; p < NPHASE; ++p) { a.ph_lo = p; a.ph_hi = p + 1; hipLaunchKernelGGL(mk_fwd, dim3(grid), dim3(NTHREADS), LDS_BYTES, stream, a); }
#endif
}
```
